# Optimizing an MI355X kernel written in HIP

```python
import math
import jax, jax.numpy as jnp
from jax import lax
import numpy as np

D_MODEL = 1024
BATCH = 4
SEQ = 8192
DEPTH = 1

CHUNK = 64
EPS = 1e-6
DA_HEADS = 4
DA_HEAD_DIM = 64
DA_V_DIM = 2 * DA_HEAD_DIM
DA_QK_COLS = DA_HEADS * 2 * DA_HEAD_DIM
DA_WIDTH = DA_HEADS * DA_V_DIM
Q_BLOCK = 128
SG_GROUPS = 4
SG_BLOCK = 128
SG_GROUP_DIM = 128
SG_WIDTH = SG_GROUPS * SG_GROUP_DIM
N_BRANCHES = 2
IN_COLS = 3 * DA_QK_COLS // 1 - DA_QK_COLS + DA_WIDTH + 2 * SG_WIDTH + N_BRANCHES * D_MODEL
PEER_HEADS = 8
PEER_KEYS = 128
PEER_EXPERTS = PEER_KEYS * PEER_KEYS
PEER_KEY_DIM = 256
PEER_HALF = PEER_KEY_DIM // 2
PEER_TOPK = 16
PEER_TOK_BLOCK = 64

kernel_name = 'hybrid_diffattn_sgu_peer_adaln'


def rmsnorm(x, g):
    xf = x.astype(jnp.float32)
    y = xf * lax.rsqrt(jnp.mean(xf * xf, axis=-1, keepdims=True) + EPS)
    return (y * g.astype(jnp.float32)).astype(x.dtype)


def layernorm(x, g, b):
    xf = x.astype(jnp.float32)
    mu = jnp.mean(xf, axis=-1, keepdims=True)
    xc = xf - mu
    y = xc * lax.rsqrt(jnp.mean(xc * xc, axis=-1, keepdims=True) + EPS)
    return (y * g.astype(jnp.float32) + b.astype(jnp.float32)).astype(x.dtype)


def diff_attention(q, k, v, lam, lam_init, head_g):
    B, S = q.shape[0], q.shape[1]
    nblk = S // Q_BLOCK
    scale = DA_HEAD_DIM ** -0.5
    kt = jnp.transpose(k, (0, 2, 3, 1, 4))
    vt = jnp.transpose(v, (0, 2, 1, 3))
    qb = q.reshape(B, nblk, Q_BLOCK, DA_HEADS, 2, DA_HEAD_DIM).transpose(1, 0, 3, 4, 2, 5)
    key_chunk = jnp.arange(S) // CHUNK

    def block(args):
        qi, bi = args
        s = jnp.einsum('bhiqd,bhikd->bhiqk', qi, kt).astype(jnp.float32) * scale
        q_chunk = (bi * Q_BLOCK + jnp.arange(Q_BLOCK)) // CHUNK
        mask = key_chunk[None, :] <= q_chunk[:, None]
        p = jax.nn.softmax(jnp.where(mask, s, -jnp.inf), axis=-1)
        a = p[:, :, 0] - lam * p[:, :, 1]
        return jnp.einsum('bhqk,bhkv->bqhv', a.astype(vt.dtype), vt)

    o = lax.map(block, (qb, jnp.arange(nblk)))
    o = o.transpose(1, 0, 2, 3, 4).reshape(B, S, DA_HEADS, DA_V_DIM)
    o = rmsnorm(o, head_g) * (1.0 - lam_init)
    return o.reshape(B, S, DA_WIDTH)


def spatial_gating(u, sv, ln_g, ln_b, w_s, b_s):
    B, S = u.shape[0], u.shape[1]
    nb = S // SG_BLOCK
    sv = layernorm(sv, ln_g, ln_b)
    pos_chunk = jnp.arange(SG_BLOCK) // CHUNK
    mask = pos_chunk[:, None] >= pos_chunk[None, :]
    w = jnp.where(mask[None], w_s, 0.0)
    svb = sv.reshape(B, nb, SG_BLOCK, SG_GROUPS, SG_GROUP_DIM)
    mixed = jnp.einsum('gpq,bnqgc->bnpgc', w, svb) + b_s.T[None, None, :, :, None]
    return u * mixed.reshape(B, S, SG_WIDTH)


def peer(h, w_query, sub_keys, down, up):
    B, S, D = h.shape
    q = jnp.einsum('bsd,dk->bsk', h, w_query).reshape(B, S, PEER_HEADS, 2, PEER_HALF)
    sc = jnp.einsum('bshpd,hpnd->bshpn', q, sub_keys).astype(jnp.float32)
    s1, i1 = lax.top_k(sc[:, :, :, 0, :], PEER_TOPK)
    s2, i2 = lax.top_k(sc[:, :, :, 1, :], PEER_TOPK)
    cand = (s1[..., :, None] + s2[..., None, :]).reshape(B, S, PEER_HEADS, PEER_TOPK * PEER_TOPK)
    cidx = (i1[..., :, None] * PEER_KEYS + i2[..., None, :]).reshape(B, S, PEER_HEADS, PEER_TOPK * PEER_TOPK)
    top_s, pos = lax.top_k(cand, PEER_TOPK)
    eidx = jnp.take_along_axis(cidx, pos, axis=-1)
    g = jax.nn.softmax(top_s, axis=-1)
    nb = S // PEER_TOK_BLOCK
    hb = h.reshape(B, nb, PEER_TOK_BLOCK, D).transpose(1, 0, 2, 3)
    eb = eidx.reshape(B, nb, PEER_TOK_BLOCK, PEER_HEADS, PEER_TOPK).transpose(1, 0, 2, 3, 4)
    gb = g.reshape(B, nb, PEER_TOK_BLOCK, PEER_HEADS, PEER_TOPK).transpose(1, 0, 2, 3, 4)

    def block(args):
        hx, ex, gx = args
        u_e = jnp.take(down, ex, axis=0)
        a = jax.nn.gelu(jnp.einsum('btd,bthkd->bthk', hx, u_e).astype(jnp.float32))
        v_e = jnp.take(up, ex, axis=0)
        return jnp.einsum('bthk,bthkd->btd', (gx * a).astype(v_e.dtype), v_e)

    out = lax.map(block, (hb, eb, gb))
    return out.transpose(1, 0, 2, 3).reshape(B, S, D)


def setup_inputs(seed: int = 0) -> dict:
    key = jax.random.key(seed)
    ks = jax.random.split(key, 25)
    L, D = DEPTH, D_MODEL

    def n(k, shape, s):
        return jax.random.normal(k, shape, jnp.float32) * s

    return {
        'x': n(ks[0], (BATCH, SEQ, D), 1.0),
        'c': n(ks[1], (BATCH, D), 1.0),
        'w_ada': n(ks[2], (L, D, 6 * D), D ** -0.5),
        'b_ada': n(ks[3], (L, 6 * D), 0.02),
        'norm1_g': 1.0 + n(ks[4], (L, D), 0.02),
        'w_in': n(ks[5], (L, D, IN_COLS), D ** -0.5),
        'da_lambda_q1': n(ks[6], (L, DA_HEAD_DIM), 0.1),
        'da_lambda_k1': n(ks[7], (L, DA_HEAD_DIM), 0.1),
        'da_lambda_q2': n(ks[8], (L, DA_HEAD_DIM), 0.1),
        'da_lambda_k2': n(ks[9], (L, DA_HEAD_DIM), 0.1),
        'da_head_g': 1.0 + n(ks[10], (L, DA_V_DIM), 0.02),
        'sg_ln_g': 1.0 + n(ks[11], (L, SG_WIDTH), 0.02),
        'sg_ln_b': n(ks[12], (L, SG_WIDTH), 0.02),
        'sg_w': n(ks[13], (L, SG_GROUPS, SG_BLOCK, SG_BLOCK), SG_BLOCK ** -0.5),
        'sg_b': 1.0 + n(ks[14], (L, SG_GROUPS, SG_BLOCK), 0.1),
        'w_branch_a': n(ks[15], (L, DA_WIDTH, D), DA_WIDTH ** -0.5),
        'w_branch_b': n(ks[16], (L, SG_WIDTH, D), SG_WIDTH ** -0.5),
        'w_out': n(ks[17], (L, D, D), D ** -0.5),
        'norm2_g': 1.0 + n(ks[18], (L, D), 0.02),
        'peer_w_query': n(ks[19], (L, D, PEER_HEADS * PEER_KEY_DIM), D ** -0.5),
        'peer_sub_keys': n(ks[20], (L, PEER_HEADS, 2, PEER_KEYS, PEER_HALF), PEER_HALF ** -0.5),
        'peer_down': n(ks[21], (L, PEER_EXPERTS, D), D ** -0.5),
        'peer_up': n(ks[22], (L, PEER_EXPERTS, D), PEER_HEADS ** -0.5),
        'final_g': 1.0 + n(ks[23], (D,), 0.02),
    }


def reference(x, c, w_ada, b_ada, norm1_g, w_in, da_lambda_q1, da_lambda_k1, da_lambda_q2,
              da_lambda_k2, da_head_g, sg_ln_g, sg_ln_b, sg_w, sg_b, w_branch_a, w_branch_b,
              w_out, norm2_g, peer_w_query, peer_sub_keys, peer_down, peer_up, final_g):
    B, S, D = x.shape
    splits = [DA_QK_COLS, 2 * DA_QK_COLS, 2 * DA_QK_COLS + DA_WIDTH,
              2 * DA_QK_COLS + DA_WIDTH + SG_WIDTH, 2 * DA_QK_COLS + DA_WIDTH + 2 * SG_WIDTH]
    for l in range(DEPTH):
        mod = jnp.einsum('bd,de->be', jax.nn.silu(c), w_ada[l]) + b_ada[l]
        sh1, sc1, g1, sh2, sc2, g2 = jnp.split(mod[:, None, :], 6, axis=-1)

        h = rmsnorm(x, norm1_g[l]) * (1.0 + sc1) + sh1
        proj = jnp.einsum('bsd,de->bse', h, w_in[l])
        q, k, v, u, sv, gates = jnp.split(proj, splits, axis=-1)
        q = q.reshape(B, S, DA_HEADS, 2, DA_HEAD_DIM)
        k = k.reshape(B, S, DA_HEADS, 2, DA_HEAD_DIM)
        v = v.reshape(B, S, DA_HEADS, DA_V_DIM)
        lam_init = 0.8 - 0.6 * math.exp(-0.3 * l)
        lam = (jnp.exp(jnp.sum(da_lambda_q1[l].astype(jnp.float32) * da_lambda_k1[l].astype(jnp.float32)))
               - jnp.exp(jnp.sum(da_lambda_q2[l].astype(jnp.float32) * da_lambda_k2[l].astype(jnp.float32)))
               + lam_init)
        ya = diff_attention(q, k, v, lam, lam_init, da_head_g[l])
        yb = spatial_gating(jax.nn.gelu(u), jax.nn.gelu(sv), sg_ln_g[l], sg_ln_b[l], sg_w[l], sg_b[l])
        ga, gb = jnp.split(jax.nn.sigmoid(gates), N_BRANCHES, axis=-1)
        merged = (ga * jnp.einsum('bse,ed->bsd', ya, w_branch_a[l])
                  + gb * jnp.einsum('bse,ed->bsd', yb, w_branch_b[l]))
        x = x + g1 * jnp.einsum('bsd,de->bse', merged, w_out[l])

        h2 = rmsnorm(x, norm2_g[l]) * (1.0 + sc2) + sh2
        x = x + g2 * peer(h2, peer_w_query[l], peer_sub_keys[l], peer_down[l], peer_up[l])
    return rmsnorm(x, final_g)
```

```cpp
#include <hip/hip_runtime.h>
#include <hip/hip_cooperative_groups.h>
#include <stdint.h>
#include <stdio.h>
namespace cg = cooperative_groups;

typedef unsigned short bf16_t;

#define D_MODEL 1024
#define BATCH 4
#define SEQ 8192
#define NTOK (BATCH * SEQ)
#define IN_COLS 4608
#define EPS 1e-6f
#define QSCALE 0.18033688011112042f

__device__ __forceinline__ float bf2f(bf16_t v) { return __uint_as_float(((unsigned)v) << 16); }
typedef __bf16 bf16v2_t __attribute__((ext_vector_type(2)));
__device__ __forceinline__ bf16_t f2bf(float f) { return __builtin_bit_cast(unsigned short, (__bf16)f); }
__device__ __forceinline__ unsigned pack2(float a, float b) { bf16v2_t v; v[0] = (__bf16)a; v[1] = (__bf16)b; return __builtin_bit_cast(unsigned, v); }
__device__ __forceinline__ float gelu_tanh(float x) {
    const float z2 = 1.5957691216057308f * (x + 0.044715f * x * x * x);
    return x * __builtin_amdgcn_rcpf(1.0f + __expf(-z2));
}
__device__ __forceinline__ float sigmoidf_(float x) { return __builtin_amdgcn_rcpf(1.0f + __expf(-x)); }

constexpr size_t OFF_CTL   = 0;
constexpr size_t OFF_BAR   = 4096;
constexpr size_t OFF_MOD   = 4096 + 16384;
constexpr size_t OFF_STATS = OFF_MOD + 4 * 6144 * 4;
constexpr size_t OFF_WTIN  = OFF_STATS + (size_t)NTOK * 2 * 4;
constexpr size_t OFF_WTA   = OFF_WTIN + (size_t)IN_COLS * 1024 * 2;
constexpr size_t OFF_WTB   = OFF_WTA + (size_t)1024 * 512 * 2;
constexpr size_t OFF_WTOUT = OFF_WTB + (size_t)1024 * 512 * 2;
constexpr size_t OFF_WTQ   = OFF_WTOUT + (size_t)1024 * 1024 * 2;
constexpr size_t OFF_SUBK  = OFF_WTQ + (size_t)2048 * 1024 * 2;
constexpr size_t OFF_DOWN  = OFF_SUBK + (size_t)8 * 2 * 128 * 128 * 2;
constexpr size_t OFF_UP    = OFF_DOWN + (size_t)16384 * 1024;
constexpr size_t OFF_DSC   = OFF_UP + (size_t)16384 * 1024;
constexpr size_t OFF_USC   = OFF_DSC + (size_t)16384 * 4;
constexpr size_t OFF_H     = OFF_USC + (size_t)16384 * 4;
constexpr size_t OFF_Q     = OFF_H + (size_t)NTOK * 1024 * 2;
constexpr size_t OFF_K     = OFF_Q + (size_t)NTOK * 512 * 2;
constexpr size_t OFF_VT    = OFF_K + (size_t)NTOK * 512 * 2;
constexpr size_t OFF_U     = OFF_VT + (size_t)NTOK * 512 * 2;
constexpr size_t OFF_SV    = OFF_U + (size_t)NTOK * 512 * 2;
constexpr size_t OFF_GATES = OFF_SV + (size_t)NTOK * 512 * 2;
constexpr size_t OFF_YA    = OFF_GATES + (size_t)NTOK * 2048 * 2;
constexpr size_t OFF_YB    = OFF_YA + (size_t)NTOK * 512 * 2;
constexpr size_t OFF_END   = OFF_YB + (size_t)NTOK * 512 * 2;
constexpr size_t OFF_MERGED = OFF_Q;
constexpr size_t OFF_EIDX  = OFF_U;
constexpr size_t OFF_GW    = OFF_SV;
constexpr size_t OFF_HQ    = OFF_YA;
constexpr size_t OFF_HSC   = OFF_STATS;

extern __shared__ __attribute__((aligned(16))) char dyn_lds[];
using bf16x8 = __attribute__((ext_vector_type(8))) short;
using f32x4 = __attribute__((ext_vector_type(4))) float;
typedef float f32x2_t __attribute__((ext_vector_type(2)));
typedef __attribute__((address_space(3))) char* lds_ptr_t;
#define GEMM_LDS_BYTES 65536
#define SEL_LDS_BYTES 81920

__device__ __forceinline__ uint2 pack4(float a, float b, float c, float d) {
    uint2 r; r.x = pack2(a, b); r.y = pack2(c, d); return r;
}

__device__ __forceinline__ void g_load(const bf16_t* __restrict__ A, int lda, int m0, int k0, uint4 (&r)[4], int tid) {
    const int c = tid & 7, rr = tid >> 3;
#pragma unroll
    for (int i = 0; i < 4; ++i) r[i] = *(const uint4*)(A + (size_t)(m0 + rr + 32 * i) * lda + k0 + c * 8);
}
__device__ __forceinline__ void g_store(char* lds, const uint4 (&r)[4], int tid) {
    const int c = tid & 7, rr = tid >> 3;
#pragma unroll
    for (int i = 0; i < 4; ++i) { const int row = rr + 32 * i; *(uint4*)(lds + row * 128 + ((c ^ (row & 7)) << 4)) = r[i]; }
}
__device__ __forceinline__ void g_compute(const char* sA, const char* sB, f32x4 (&acc)[4][4], int wm, int wn, int lane) {
    const int lr = lane & 15, lq = lane >> 4;
#pragma unroll
    for (int ks = 0; ks < 2; ++ks) {
        bf16x8 a[4], b[4];
        const int sw = (((ks * 4 + lq) ^ (lr & 7)) << 4);
#pragma unroll
        for (int i = 0; i < 4; ++i) a[i] = *(const bf16x8*)(sA + (wm * 64 + i * 16 + lr) * 128 + sw);
#pragma unroll
        for (int j = 0; j < 4; ++j) b[j] = *(const bf16x8*)(sB + (wn * 64 + j * 16 + lr) * 128 + sw);
#pragma unroll
        for (int i = 0; i < 4; ++i)
#pragma unroll
            for (int j = 0; j < 4; ++j) acc[i][j] = __builtin_amdgcn_mfma_f32_16x16x32_bf16(b[j], a[i], acc[i][j], 0, 0, 0);
    }
}
__device__ __forceinline__ void g_dma(const bf16_t* __restrict__ A, int lda, int m0, int k0, char* lds_tile, int lane, int w) {
    const int rl = lane >> 3, pc = lane & 7;
#pragma unroll
    for (int i = 0; i < 4; ++i) {
        const int n = w * 4 + i; const int row = 8 * n + rl;
        __builtin_amdgcn_global_load_lds((const unsigned*)(A + (size_t)(m0 + row) * lda + k0 + ((pc ^ (row & 7)) << 3)),
                                         (__attribute__((address_space(3))) unsigned*)(lds_ptr_t)(lds_tile + n * 1024), 16, 0, 0);
    }
}
__device__ __forceinline__ void g_kloop(const bf16_t* __restrict__ A, int lda, const bf16_t* __restrict__ Bt, int ldb, int K, int m0, int n0,
                                        char* lds, f32x4 (&acc)[4][4], int tid) {
    const int lane = tid & 63, w = __builtin_amdgcn_readfirstlane(tid >> 6), wm = w >> 1, wn = w & 1;
    g_dma(A, lda, m0, 0, lds, lane, w); g_dma(Bt, ldb, n0, 0, lds + 16384, lane, w);
    asm volatile("s_waitcnt vmcnt(0)" ::: "memory");
    __syncthreads();
    const int nk = K >> 6;
    for (int kt = 0; kt < nk; ++kt) {
        char* cur = lds + (kt & 1) * 32768; char* nxt = lds + ((kt + 1) & 1) * 32768;
        if (kt + 1 < nk) { g_dma(A, lda, m0, (kt + 1) * 64, nxt, lane, w); g_dma(Bt, ldb, n0, (kt + 1) * 64, nxt + 16384, lane, w); }
        g_compute(cur, cur + 16384, acc, wm, wn, lane);
        asm volatile("s_waitcnt vmcnt(0)" ::: "memory");
        __syncthreads();
    }
}
__device__ __forceinline__ void g_zero(f32x4 (&acc)[4][4]) {
#pragma unroll
    for (int i = 0; i < 4; ++i)
#pragma unroll
        for (int j = 0; j < 4; ++j) acc[i][j] = f32x4{0.f, 0.f, 0.f, 0.f};
}
__device__ __forceinline__ void g_tilemap(int it, int nMt, int nNt, int& mt, int& nt, bool& valid) {
    const int G = gridDim.x, bid = blockIdx.x;
    if ((G & 7) == 0 && (nMt & 63) == 0) {
        const int x = bid & 7, slot = bid >> 3, nslot = G >> 3;
        const int u = it * nslot + slot;
        const int mPer = nMt >> 3;
        valid = u < mPer * nNt;
        const int SBN = (nNt % 9 == 0) ? 9 : ((nNt % 8 == 0) ? 8 : nNt);
        const int sbPerRow = nNt / SBN;
        const int sb = u / (8 * SBN), within = u % (8 * SBN);
        const int sbm = sb / sbPerRow, sbn = sb % sbPerRow;
        mt = x * mPer + sbm * 8 + within / SBN;
        nt = sbn * SBN + within % SBN;
    } else {
        const int t = it * G + bid;
        valid = t < nMt * nNt;
        mt = t / nNt; nt = t % nNt;
    }
}
#define G_EPI_LOOP(...) \
    { const int lane_ = tid & 63, w_ = tid >> 6, wm_ = w_ >> 1, wn_ = w_ & 1, lr_ = lane_ & 15, lq_ = lane_ >> 4; \
      _Pragma("unroll") for (int i = 0; i < 4; ++i) _Pragma("unroll") for (int j = 0; j < 4; ++j) { \
        const int m = m0 + wm_ * 64 + i * 16 + lr_; const int n = n0 + wn_ * 64 + j * 16 + lq_ * 4; const f32x4 v = acc[i][j]; __VA_ARGS__ } }


#define GW_STAGE 24576
__device__ __forceinline__ void gw_dma(const bf16_t* __restrict__ A, int lda, const bf16_t* __restrict__ Bt, int ldb, int m0, int n0, int k0, char* stage, int lane, int w) {
    const int rl = lane >> 2, pc = lane & 3;
    const int sc = (pc ^ ((-(rl >> 2)) & 3)) << 3;
#pragma unroll
    for (int i = 0; i < 2; ++i) {
        const int n = w * 2 + i;
        __builtin_amdgcn_global_load_lds((const unsigned*)(A + (size_t)(m0 + n * 16 + rl) * lda + k0 + sc),
                                         (__attribute__((address_space(3))) unsigned*)(lds_ptr_t)(stage + n * 1024), 16, 0, 0);
    }
#pragma unroll
    for (int i = 0; i < 4; ++i) {
        const int n = w * 4 + i;
        __builtin_amdgcn_global_load_lds((const unsigned*)(Bt + (size_t)(n0 + n * 16 + rl) * ldb + k0 + sc),
                                         (__attribute__((address_space(3))) unsigned*)(lds_ptr_t)(stage + 8192 + n * 1024), 16, 0, 0);
    }
}
__device__ __forceinline__ void gw_compute(const char* stage, f32x4 (&acc)[4][8], int wm, int wn, int lane) {
    const int lr = lane & 15, lq = lane >> 4;
    const int sw = (lq ^ ((-(lr >> 2)) & 3)) << 4;
    bf16x8 a[4], b[8];
#pragma unroll
    for (int i = 0; i < 4; ++i) a[i] = *(const bf16x8*)(stage + (wm * 64 + i * 16 + lr) * 64 + sw);
#pragma unroll
    for (int j = 0; j < 8; ++j) b[j] = *(const bf16x8*)(stage + 8192 + (wn * 128 + j * 16 + lr) * 64 + sw);
#pragma unroll
    for (int i = 0; i < 4; ++i)
#pragma unroll
        for (int j = 0; j < 8; ++j) acc[i][j] = __builtin_amdgcn_mfma_f32_16x16x32_bf16(b[j], a[i], acc[i][j], 0, 0, 0);
}
__device__ __forceinline__ void gw_kloop(const bf16_t* __restrict__ A, int lda, const bf16_t* __restrict__ Bt, int ldb, int K, int m0, int n0,
                                         char* lds, f32x4 (&acc)[4][8], int tid) {
    const int lane = tid & 63, w = __builtin_amdgcn_readfirstlane(tid >> 6), wm = w >> 1, wn = w & 1;
    const int nk = K >> 5;
    gw_dma(A, lda, Bt, ldb, m0, n0, 0, lds, lane, w);
    gw_dma(A, lda, Bt, ldb, m0, n0, 32, lds + GW_STAGE, lane, w);
    int cur = 0;
    for (int kt = 0; kt < nk; ++kt) {
        if (kt + 1 < nk) asm volatile("s_waitcnt vmcnt(6)" ::: "memory"); else asm volatile("s_waitcnt vmcnt(0)" ::: "memory");
        asm volatile("s_waitcnt lgkmcnt(0)" ::: "memory");
        __builtin_amdgcn_s_barrier();
        if (kt + 2 < nk) { int nx = cur + 2; if (nx >= 3) nx -= 3; gw_dma(A, lda, Bt, ldb, m0, n0, (kt + 2) * 32, lds + nx * GW_STAGE, lane, w); }
        gw_compute(lds + cur * GW_STAGE, acc, wm, wn, lane);
        cur = (cur == 2) ? 0 : cur + 1;
    }
    asm volatile("s_waitcnt lgkmcnt(0)" ::: "memory");
    __builtin_amdgcn_s_barrier();
}
__device__ __forceinline__ void gw_zero(f32x4 (&acc)[4][8]) {
#pragma unroll
    for (int i = 0; i < 4; ++i)
#pragma unroll
        for (int j = 0; j < 8; ++j) acc[i][j] = f32x4{0.f, 0.f, 0.f, 0.f};
}
#define GW_EPI_LOOP(...) \
    { const int lane_ = tid & 63, w_ = tid >> 6, wm_ = w_ >> 1, wn_ = w_ & 1, lr_ = lane_ & 15, lq_ = lane_ >> 4; \
      _Pragma("unroll") for (int i = 0; i < 4; ++i) _Pragma("unroll") for (int j = 0; j < 8; ++j) { \
        const int m = m0 + wm_ * 64 + i * 16 + lr_; const int n = n0 + wn_ * 128 + j * 16 + lq_ * 4; const f32x4 v = acc[i][j]; __VA_ARGS__ } }

__device__ __forceinline__ void phase_inproj(const bf16_t* __restrict__ H, const bf16_t* __restrict__ WTIN, bf16_t* Q, bf16_t* Kb, bf16_t* VT, bf16_t* U, bf16_t* SV, bf16_t* G, char* lds) {
    const int tid = threadIdx.x;
    const int nMt = NTOK / 128, nNt = IN_COLS / 256;
    for (int it = 0;; ++it) {
        int mt, nt; bool valid; g_tilemap(it, nMt, nNt, mt, nt, valid);
        if (!valid) break;
        const int m0 = mt * 128, n0 = nt * 256;
        f32x4 acc[4][8]; gw_zero(acc);
        gw_kloop(H, 1024, WTIN, 1024, 1024, m0, n0, lds, acc, tid);
        if (n0 < 512) { GW_EPI_LOOP( *(uint2*)(Q + (size_t)m * 512 + n) = pack4(v[0] * QSCALE, v[1] * QSCALE, v[2] * QSCALE, v[3] * QSCALE); ) }
        else if (n0 < 1024) { GW_EPI_LOOP( *(uint2*)(Kb + (size_t)m * 512 + n - 512) = pack4(v[0], v[1], v[2], v[3]); ) }
        else if (n0 < 1536) { GW_EPI_LOOP( *(uint2*)(VT + (size_t)m * 512 + n - 1024) = pack4(v[0], v[1], v[2], v[3]); ) }
        else if (n0 < 2048) { GW_EPI_LOOP( *(uint2*)(U + (size_t)m * 512 + n - 1536) = pack4(gelu_tanh(v[0]), gelu_tanh(v[1]), gelu_tanh(v[2]), gelu_tanh(v[3])); ) }
        else if (n0 < 2560) { GW_EPI_LOOP( *(uint2*)(SV + (size_t)m * 512 + n - 2048) = pack4(gelu_tanh(v[0]), gelu_tanh(v[1]), gelu_tanh(v[2]), gelu_tanh(v[3])); ) }
        else { GW_EPI_LOOP( *(uint2*)(G + (size_t)m * 2048 + n - 2560) = pack4(sigmoidf_(v[0]), sigmoidf_(v[1]), sigmoidf_(v[2]), sigmoidf_(v[3])); ) }
    }
}
__device__ __forceinline__ void phase_merged(const bf16_t* __restrict__ YA, const bf16_t* __restrict__ YB, const bf16_t* __restrict__ WTA, const bf16_t* __restrict__ WTB,
                             const bf16_t* __restrict__ G, bf16_t* MERGED, char* lds) {
    const int tid = threadIdx.x;
    const int nMt = NTOK / 128, nNt = 1024 / 128;
    for (int it = 0;; ++it) {
        int mt, nt; bool valid; g_tilemap(it, nMt, nNt, mt, nt, valid);
        if (!valid) break;
        const int m0 = mt * 128, n0 = nt * 128;
        f32x4 acc[4][4]; g_zero(acc);
        g_kloop(YB, 512, WTB, 512, 512, m0, n0, lds, acc, tid);
        { const int lane_ = tid & 63, w_ = tid >> 6, wm_ = w_ >> 1, wn_ = w_ & 1, lr_ = lane_ & 15, lq_ = lane_ >> 4;
#pragma unroll
          for (int i = 0; i < 4; ++i)
#pragma unroll
            for (int j = 0; j < 4; ++j) {
                const int m = m0 + wm_ * 64 + i * 16 + lr_; const int n = n0 + wn_ * 64 + j * 16 + lq_ * 4;
                const uint2 ga2 = *(const uint2*)(G + (size_t)m * 2048 + n);
                const uint2 gb2 = *(const uint2*)(G + (size_t)m * 2048 + 1024 + n);
                acc[i][j][0] *= __uint_as_float(gb2.x << 16) * __builtin_amdgcn_rcpf(fmaxf(__uint_as_float(ga2.x << 16), 1e-20f));
                acc[i][j][1] *= __uint_as_float(gb2.x & 0xffff0000u) * __builtin_amdgcn_rcpf(fmaxf(__uint_as_float(ga2.x & 0xffff0000u), 1e-20f));
                acc[i][j][2] *= __uint_as_float(gb2.y << 16) * __builtin_amdgcn_rcpf(fmaxf(__uint_as_float(ga2.y << 16), 1e-20f));
                acc[i][j][3] *= __uint_as_float(gb2.y & 0xffff0000u) * __builtin_amdgcn_rcpf(fmaxf(__uint_as_float(ga2.y & 0xffff0000u), 1e-20f));
            } }
        g_kloop(YA, 512, WTA, 512, 512, m0, n0, lds, acc, tid);
        G_EPI_LOOP( const uint2 ga2 = *(const uint2*)(G + (size_t)m * 2048 + n);
                    *(uint2*)(MERGED + (size_t)m * 1024 + n) = pack4(v[0] * fmaxf(__uint_as_float(ga2.x << 16), 1e-20f), v[1] * fmaxf(__uint_as_float(ga2.x & 0xffff0000u), 1e-20f),
                                                                      v[2] * fmaxf(__uint_as_float(ga2.y << 16), 1e-20f), v[3] * fmaxf(__uint_as_float(ga2.y & 0xffff0000u), 1e-20f)); )
    }
}
__device__ __forceinline__ void phase_outproj(const bf16_t* __restrict__ MERGED, const bf16_t* __restrict__ WTOUT, const float* __restrict__ x, const float* __restrict__ mod, float* x1, char* lds) {
    const int tid = threadIdx.x;
    const int nMt = NTOK / 128, nNt = 1024 / 256;
    for (int it = 0;; ++it) {
        int mt, nt; bool valid; g_tilemap(it, nMt, nNt, mt, nt, valid);
        if (!valid) break;
        const int m0 = mt * 128, n0 = nt * 256;
        f32x4 acc[4][8]; gw_zero(acc);
        gw_kloop(MERGED, 1024, WTOUT, 1024, 1024, m0, n0, lds, acc, tid);
        GW_EPI_LOOP( const int b = m / SEQ; const float4 g1 = *(const float4*)(mod + b * 6144 + 2048 + n);
                    const float4 xv = *(const float4*)(x + (size_t)m * 1024 + n);
                    float4 o; o.x = xv.x + g1.x * v[0]; o.y = xv.y + g1.y * v[1]; o.z = xv.z + g1.z * v[2]; o.w = xv.w + g1.w * v[3];
                    *(float4*)(x1 + (size_t)m * 1024 + n) = o; )
    }
}
__device__ __forceinline__ void phase_peerq(const bf16_t* __restrict__ H2, const bf16_t* __restrict__ WTQ, bf16_t* QP, char* lds) {
    const int tid = threadIdx.x;
    const int nMt = NTOK / 128, nNt = 2048 / 128;
    for (int it = 0;; ++it) {
        int mt, nt; bool valid; g_tilemap(it, nMt, nNt, mt, nt, valid);
        if (!valid) break;
        const int m0 = mt * 128, n0 = nt * 128;
        f32x4 acc[4][4]; g_zero(acc);
        g_kloop(H2, 1024, WTQ, 1024, 1024, m0, n0, lds, acc, tid);
        G_EPI_LOOP( *(uint2*)(QP + (size_t)m * 2048 + n) = pack4(v[0], v[1], v[2], v[3]); )
    }
}


using f32x16 = __attribute__((ext_vector_type(16))) float;
typedef short v4i16_t __attribute__((ext_vector_type(4)));
#define ATT_TILE 16384
#define ATT_LDS_BYTES (4 * ATT_TILE)

__device__ __forceinline__ void att_dma(const bf16_t* __restrict__ Kb, const bf16_t* __restrict__ V, int b, int h, int kt, char* kl, char* vl, int lane, int w) {
    const int pc = lane & 15, rl = lane >> 4;
#pragma unroll
    for (int i = 0; i < 4; ++i) {
        const int n = w * 4 + i; const int row = 4 * n + rl;
        const size_t rowoff = ((size_t)(b * SEQ + kt * 64 + row)) * 512 + h * 128;
        __builtin_amdgcn_global_load_lds((const unsigned*)(Kb + rowoff + ((pc ^ (row & 15)) << 3)), (__attribute__((address_space(3))) unsigned*)(lds_ptr_t)(kl + n * 1024), 16, 0, 0);
        __builtin_amdgcn_global_load_lds((const unsigned*)(V + rowoff + ((pc ^ ((row & 3) << 2)) << 3)), (__attribute__((address_space(3))) unsigned*)(lds_ptr_t)(vl + n * 1024), 16, 0, 0);
    }
}
__device__ __forceinline__ void att_item(int b, int h, int c, const bf16_t* __restrict__ Q, const bf16_t* __restrict__ Kb, const bf16_t* __restrict__ V,
                                         float lam, const float* __restrict__ head_g, bf16_t* __restrict__ YA, char* lds) {
    const int tid = threadIdx.x, lane = tid & 63;
    const int w = __builtin_amdgcn_readfirstlane(tid >> 6);
    const int i = w & 1, rq = w >> 1, r = lane & 31, hh = lane >> 5;
    const int tq = b * SEQ + c * 64 + rq * 32 + r;
    bf16x8 qf[4];
#pragma unroll
    for (int s = 0; s < 4; ++s) qf[s] = *(const bf16x8*)(Q + (size_t)tq * 512 + h * 128 + i * 64 + 16 * s + 8 * hh);
    f32x16 O[4];
#pragma unroll
    for (int d = 0; d < 4; ++d)
#pragma unroll
        for (int e = 0; e < 16; ++e) O[d][e] = 0.f;
    float m = -1e30f, l = 0.f;
    const int ntiles = c + 1;
    int vb[4];
    { const int li = lane & 15, g = lane >> 4, q = li >> 2, x = 2 * (g & 1) + ((li & 3) >> 1);
#pragma unroll
      for (int d = 0; d < 4; ++d) vb[d] = (4 * hh + q) * 256 + ((((d ^ q) << 2) | x) << 4) + 8 * (li & 1); }
    att_dma(Kb, V, b, h, 0, lds, lds + ATT_TILE, lane, w);
    asm volatile("s_waitcnt vmcnt(0)" ::: "memory");
    __syncthreads();
    for (int kt = 0; kt < ntiles; ++kt) {
        const char* kl = lds + (kt & 1) * (2 * ATT_TILE); const char* vl = kl + ATT_TILE;
        if (kt + 1 < ntiles) { char* nl = lds + ((kt + 1) & 1) * (2 * ATT_TILE); att_dma(Kb, V, b, h, kt + 1, nl, nl + ATT_TILE, lane, w); }
        f32x16 sacc[2];
        {
            bf16x8 kf[2][4];
#pragma unroll
            for (int k2 = 0; k2 < 2; ++k2)
#pragma unroll
                for (int s = 0; s < 4; ++s) {
                    const int krow = k2 * 32 + r; const int kch = i * 8 + 2 * s + hh;
                    kf[k2][s] = *(const bf16x8*)(kl + krow * 256 + ((kch ^ (krow & 15)) << 4));
                }
#pragma unroll
            for (int k2 = 0; k2 < 2; ++k2) {
#pragma unroll
                for (int e = 0; e < 16; ++e) sacc[k2][e] = 0.f;
#pragma unroll
                for (int s = 0; s < 4; ++s) sacc[k2] = __builtin_amdgcn_mfma_f32_32x32x16_bf16(kf[k2][s], qf[s], sacc[k2], 0, 0, 0);
            }
        }
        float mx = sacc[0][0];
#pragma unroll
        for (int e = 1; e < 16; ++e) mx = fmaxf(mx, sacc[0][e]);
#pragma unroll
        for (int e = 0; e < 16; ++e) mx = fmaxf(mx, sacc[1][e]);
        mx = fmaxf(mx, __shfl_xor(mx, 32));
        const float mn = fmaxf(m, mx);
        const float alpha = __builtin_amdgcn_exp2f(m - mn);
        m = mn;
        float ls = 0.f;
#pragma unroll
        for (int k2 = 0; k2 < 2; ++k2)
#pragma unroll
            for (int e = 0; e < 16; ++e) { const float p = __builtin_amdgcn_exp2f(sacc[k2][e] - mn); sacc[k2][e] = p; ls += p; }
        l = l * alpha + ls;
        if (__any(alpha != 1.0f)) {
#pragma unroll
            for (int d = 0; d < 4; ++d)
#pragma unroll
                for (int e = 0; e < 16; ++e) O[d][e] *= alpha;
        }
        bf16x8 pf[2][2];
#pragma unroll
        for (int k2 = 0; k2 < 2; ++k2)
#pragma unroll
            for (int s2 = 0; s2 < 2; ++s2) {
                union { uint4 u; bf16x8 v; } cp;
                cp.u = make_uint4(pack2(sacc[k2][8 * s2 + 0], sacc[k2][8 * s2 + 1]), pack2(sacc[k2][8 * s2 + 2], sacc[k2][8 * s2 + 3]),
                                  pack2(sacc[k2][8 * s2 + 4], sacc[k2][8 * s2 + 5]), pack2(sacc[k2][8 * s2 + 6], sacc[k2][8 * s2 + 7]));
                pf[k2][s2] = cp.v;
            }
#define ATT_VREAD(dst, st) { const lds_ptr_t vp_ = (lds_ptr_t)(vl + vb[(st) >> 2]); const int kb_ = (((st) >> 1) & 1) * 32 + ((st) & 1) * 16; \
            const v4i16_t lo_ = __builtin_amdgcn_ds_read_tr16_b64_v4i16((__attribute__((address_space(3))) v4i16_t*)(vp_ + kb_ * 256)); \
            const v4i16_t hi_ = __builtin_amdgcn_ds_read_tr16_b64_v4i16((__attribute__((address_space(3))) v4i16_t*)(vp_ + kb_ * 256 + 2048)); \
            dst = (bf16x8){lo_[0], lo_[1], lo_[2], lo_[3], hi_[0], hi_[1], hi_[2], hi_[3]}; }
        {
            bf16x8 vcur, vnxt;
            ATT_VREAD(vcur, 0)
#pragma unroll
            for (int st = 0; st < 16; ++st) {
                if (st + 1 < 16) ATT_VREAD(vnxt, st + 1)
                O[st >> 2] = __builtin_amdgcn_mfma_f32_32x32x16_bf16(vcur, pf[(st >> 1) & 1][st & 1], O[st >> 2], 0, 0, 0);
                vcur = vnxt;
            }
        }
        asm volatile("s_waitcnt vmcnt(0)" ::: "memory");
        __syncthreads();
    }
    const float ltot = l + __shfl_xor(l, 32);
    const float inv = 1.0f / ltot;
    float* ex = (float*)lds;
    if (i == 1) {
        const float sc = inv * lam;
#pragma unroll
        for (int d = 0; d < 4; ++d)
#pragma unroll
            for (int e = 0; e < 16; ++e) { const int dv = d * 32 + (e & 3) + 8 * (e >> 2) + 4 * hh; ex[(rq * 128 + dv) * 32 + r] = O[d][e] * sc; }
    }
    __syncthreads();
    if (i == 0) {
        float ss = 0.f;
#pragma unroll
        for (int d = 0; d < 4; ++d)
#pragma unroll
            for (int e = 0; e < 16; ++e) { const int dv = d * 32 + (e & 3) + 8 * (e >> 2) + 4 * hh; const float o = O[d][e] * inv - ex[(rq * 128 + dv) * 32 + r]; O[d][e] = o; ss += o * o; }
        ss += __shfl_xor(ss, 32);
        const float rn = rsqrtf(ss * (1.0f / 128.0f) + EPS) * 0.8f;
#pragma unroll
        for (int d = 0; d < 4; ++d)
#pragma unroll
            for (int g = 0; g < 4; ++g) {
                const int dv = d * 32 + 8 * g + 4 * hh;
                const float4 hg = *(const float4*)(head_g + dv);
                *(uint2*)(YA + (size_t)tq * 512 + h * 128 + dv) = pack4(O[d][4 * g] * rn * hg.x, O[d][4 * g + 1] * rn * hg.y, O[d][4 * g + 2] * rn * hg.z, O[d][4 * g + 3] * rn * hg.w);
            }
    }
    __syncthreads();
}
__device__ __forceinline__ void phase_attn(const bf16_t* __restrict__ Q, const bf16_t* __restrict__ Kb, const bf16_t* __restrict__ V, const float* __restrict__ ctl,
                           const float* __restrict__ head_g, bf16_t* __restrict__ YA, char* lds) {
    const float lam = ctl[0];
    const int G = gridDim.x, bid = blockIdx.x;
    if (G == 512) {
        const int x = bid & 7, slot = bid >> 3; const int ph = x + 8 * (slot & 1); const int s = slot >> 1;
#pragma unroll 1
        for (int it = 0; it < 4; ++it) {
            const int c = (it == 0) ? 127 - s : (it == 1) ? 64 + s : (it == 2) ? 63 - s : s;
            att_item(ph >> 2, ph & 3, c, Q, Kb, V, lam, head_g, YA, lds);
        }
    } else {
#pragma unroll 1
        for (int it = 0;; ++it) {
            const int rho = (it & 1) ? it * G + (G - 1 - bid) : it * G + bid;
            if (rho >= 2048) { if (it * G >= 2048) break; else continue; }
            const int c = 127 - (rho >> 4); const int ph = rho & 15;
            att_item(ph >> 2, ph & 3, c, Q, Kb, V, lam, head_g, YA, lds);
        }
    }
}


#define SGU_LDS_BYTES (65536 + 1024)
__device__ __forceinline__ void phase_sgu(const bf16_t* __restrict__ U, const bf16_t* __restrict__ SV, const float* __restrict__ ln_g, const float* __restrict__ ln_b,
                          const float* __restrict__ sg_w, const float* __restrict__ sg_b, bf16_t* __restrict__ YB, char* lds) {
    const int tid = threadIdx.x, lane = tid & 63, w = tid >> 6, wm = w >> 1, wn = w & 1, lr = lane & 15, lq = lane >> 4;
    float* st_mu = (float*)(lds + 65536); float* st_rs = st_mu + 128;
    char* Wl = lds; char* Sl = lds + 32768;
    for (int item = blockIdx.x; item < (NTOK / 128) * 4; item += gridDim.x) {
        const int g = item & 3, nb = item >> 2; const int t0 = nb * 128;
        for (int r0 = 0; r0 < 32; r0 += 8) {
            uint4 v8[8];
#pragma unroll
            for (int u = 0; u < 8; ++u) v8[u] = *(const uint4*)(SV + (size_t)(t0 + w * 32 + r0 + u) * 512 + lane * 8);
#pragma unroll
            for (int u = 0; u < 8; ++u) {
                const int row = w * 32 + r0 + u; const uint4 v = v8[u];
                float f[8] = {__uint_as_float(v.x << 16), __uint_as_float(v.x & 0xffff0000u), __uint_as_float(v.y << 16), __uint_as_float(v.y & 0xffff0000u),
                              __uint_as_float(v.z << 16), __uint_as_float(v.z & 0xffff0000u), __uint_as_float(v.w << 16), __uint_as_float(v.w & 0xffff0000u)};
                float s = 0.f;
#pragma unroll
                for (int j = 0; j < 8; ++j) s += f[j];
                for (int o = 32; o > 0; o >>= 1) s += __shfl_xor(s, o);
                const float mu = s * (1.0f / 512.0f);
                float q = 0.f;
#pragma unroll
                for (int j = 0; j < 8; ++j) { const float d = f[j] - mu; q += d * d; }
                for (int o = 32; o > 0; o >>= 1) q += __shfl_xor(q, o);
                if (lane == 0) { st_mu[row] = mu; st_rs[row] = rsqrtf(q * (1.0f / 512.0f) + EPS); }
            }
        }
        { const int c16 = tid & 15, r0 = tid >> 4;
#pragma unroll
          for (int i = 0; i < 8; ++i) {
              const int p = r0 + 16 * i;
              const float* wp = sg_w + ((size_t)g * 128 + p) * 128 + c16 * 8;
              float4 a = *(const float4*)wp, b = *(const float4*)(wp + 4);
              if (p < 64 && c16 >= 8) { a = make_float4(0.f, 0.f, 0.f, 0.f); b = a; }
              *(uint4*)(Wl + p * 256 + ((c16 ^ (p & 15)) << 4)) = make_uint4(pack2(a.x, a.y), pack2(a.z, a.w), pack2(b.x, b.y), pack2(b.z, b.w));
          } }
        __syncthreads();
        { const int pr = tid & 63;
#pragma unroll
          for (int it = 0; it < 4; ++it) {
              const int ch = (tid >> 6) + 4 * it;
              const int q0 = 2 * pr;
              const uint4 va = *(const uint4*)(SV + (size_t)(t0 + q0) * 512 + g * 128 + ch * 8);
              const uint4 vb = *(const uint4*)(SV + (size_t)(t0 + q0 + 1) * 512 + g * 128 + ch * 8);
              const float mua = st_mu[q0], rsa = st_rs[q0], mub = st_mu[q0 + 1], rsb = st_rs[q0 + 1];
              const unsigned ua[4] = {va.x, va.y, va.z, va.w}, ub[4] = {vb.x, vb.y, vb.z, vb.w};
#pragma unroll
              for (int e = 0; e < 8; ++e) {
                  const int c = ch * 8 + e;
                  const float lg = ln_g[g * 128 + c], lb = ln_b[g * 128 + c];
                  const float xa = (e & 1) ? __uint_as_float(ua[e >> 1] & 0xffff0000u) : __uint_as_float(ua[e >> 1] << 16);
                  const float xb = (e & 1) ? __uint_as_float(ub[e >> 1] & 0xffff0000u) : __uint_as_float(ub[e >> 1] << 16);
                  const float na = (xa - mua) * rsa * lg + lb, nb2 = (xb - mub) * rsb * lg + lb;
                  *(unsigned*)(Sl + c * 256 + (((q0 >> 3) ^ (c & 15)) << 4) + (q0 & 7) * 2) = pack2(na, nb2);
              }
          } }
        __syncthreads();
        f32x4 acc[4][4]; g_zero(acc);
        const int nks = (wm == 0) ? 2 : 4;
        for (int ks = 0; ks < nks; ++ks) {
            const int sw = (((ks * 4 + lq) ^ lr) << 4);
            bf16x8 a[4], b[4];
#pragma unroll
            for (int i = 0; i < 4; ++i) a[i] = *(const bf16x8*)(Wl + (wm * 64 + i * 16 + lr) * 256 + sw);
#pragma unroll
            for (int j = 0; j < 4; ++j) b[j] = *(const bf16x8*)(Sl + (wn * 64 + j * 16 + lr) * 256 + sw);
#pragma unroll
            for (int i = 0; i < 4; ++i)
#pragma unroll
                for (int j = 0; j < 4; ++j) acc[i][j] = __builtin_amdgcn_mfma_f32_16x16x32_bf16(b[j], a[i], acc[i][j], 0, 0, 0);
        }
#pragma unroll
        for (int i = 0; i < 4; ++i)
#pragma unroll
            for (int j = 0; j < 4; ++j) {
                const int p = wm * 64 + i * 16 + lr; const int c = wn * 64 + j * 16 + lq * 4;
                const float bias = sg_b[g * 128 + p];
                const size_t o = (size_t)(t0 + p) * 512 + g * 128 + c;
                const uint2 uu = *(const uint2*)(U + o);
                *(uint2*)(YB + o) = pack4(__uint_as_float(uu.x << 16) * (acc[i][j][0] + bias), __uint_as_float(uu.x & 0xffff0000u) * (acc[i][j][1] + bias),
                                          __uint_as_float(uu.y << 16) * (acc[i][j][2] + bias), __uint_as_float(uu.y & 0xffff0000u) * (acc[i][j][3] + bias));
            }
        __syncthreads();
    }
}

#define CE_DESC(a, b) { const unsigned t_ = (a) > (b) ? (a) : (b); b = (a) > (b) ? (b) : (a); a = t_; }
__device__ __forceinline__ unsigned f2key(float f) { const unsigned u = __float_as_uint(f); return (u & 0x80000000u) ? ~u : (u | 0x80000000u); }
__device__ __forceinline__ float key2f(unsigned k) { const unsigned u = (k & 0x80000000u) ? (k & 0x7fffffffu) : ~k; return __uint_as_float(u); }
template <int N> __device__ __forceinline__ void bitonic_sort_desc(unsigned (&a)[N]) {
#pragma unroll
    for (int k = 2; k <= N; k <<= 1)
#pragma unroll
        for (int j = k >> 1; j > 0; j >>= 1)
#pragma unroll
            for (int i = 0; i < N; ++i) {
                const int l = i ^ j;
                if (l > i) { if ((i & k) == 0) { CE_DESC(a[i], a[l]) } else { CE_DESC(a[l], a[i]) } }
            }
}
template <int N> __device__ __forceinline__ void bitonic_merge_desc(unsigned (&a)[N]) {
#pragma unroll
    for (int j = N >> 1; j > 0; j >>= 1)
#pragma unroll
        for (int i = 0; i < N; ++i) { const int l = i ^ j; if (l > i) { CE_DESC(a[i], a[l]) } }
}
__device__ __forceinline__ void merge_top16(unsigned (&a)[16], const unsigned (&b)[16]) {
#pragma unroll
    for (int i = 0; i < 16; ++i) a[i] = a[i] > b[15 - i] ? a[i] : b[15 - i];
    bitonic_merge_desc<16>(a);
}
__device__ __forceinline__ void xlane_merge_top16(unsigned (&a)[16], int xmask) {
    unsigned b[16];
#pragma unroll
    for (int i = 0; i < 16; ++i) b[i] = (unsigned)__shfl_xor((int)a[i], xmask);
    merge_top16(a, b);
}
__device__ __forceinline__ void phase_peer_select(const bf16_t* __restrict__ H2, const bf16_t* __restrict__ WTQ, const bf16_t* __restrict__ SUBK,
                                  int* __restrict__ EIDX, float* __restrict__ GW, char* lds) {
    const int tid = threadIdx.x, lane = tid & 63, w = tid >> 6, wm = w >> 1, wn = w & 1, lr = lane & 15, lq = lane >> 4;
    const int G = gridDim.x;
    for (int u = blockIdx.x; u < (NTOK / 128) * 8; u += G) {
        const int h = u & 7, mt = u >> 3; const int m0 = mt * 128;
        unsigned* Ll = (unsigned*)(lds + 65536);
#pragma unroll 1
        for (int p = 0; p < 2; ++p) {
            f32x4 acc[4][4]; g_zero(acc);
            g_kloop(H2, 1024, WTQ + (size_t)(h * 256 + p * 128) * 1024, 1024, 1024, m0, 0, lds, acc, tid);
#pragma unroll
            for (int i = 0; i < 4; ++i)
#pragma unroll
                for (int j = 0; j < 4; ++j) {
                    const int tok = wm * 64 + i * 16 + lr; const int d = wn * 64 + j * 16 + lq * 4;
                    *(uint2*)(lds + tok * 256 + (((d >> 3) ^ (tok & 15)) << 4) + (d & 7) * 2) = pack4(acc[i][j][0], acc[i][j][1], acc[i][j][2], acc[i][j][3]);
                }
            { const int c16 = tid & 15, r0 = tid >> 4; const bf16_t* kp = SUBK + (size_t)(h * 2 + p) * 128 * 128;
#pragma unroll
              for (int i = 0; i < 8; ++i) { const int row = r0 + 16 * i; *(uint4*)(lds + 32768 + row * 256 + ((c16 ^ (row & 15)) << 4)) = *(const uint4*)(kp + row * 128 + c16 * 8); } }
            __syncthreads();
            f32x4 sc[2][8];
#pragma unroll
            for (int tt = 0; tt < 2; ++tt)
#pragma unroll
                for (int kt = 0; kt < 8; ++kt) sc[tt][kt] = f32x4{0.f, 0.f, 0.f, 0.f};
#pragma unroll
            for (int ks = 0; ks < 4; ++ks) {
                const int sw = (((ks * 4 + lq) ^ lr) << 4);
                bf16x8 qb[2], ka[8];
#pragma unroll
                for (int tt = 0; tt < 2; ++tt) qb[tt] = *(const bf16x8*)(lds + (w * 32 + tt * 16 + lr) * 256 + sw);
#pragma unroll
                for (int kt = 0; kt < 8; ++kt) ka[kt] = *(const bf16x8*)(lds + 32768 + (kt * 16 + lr) * 256 + sw);
#pragma unroll
                for (int tt = 0; tt < 2; ++tt)
#pragma unroll
                    for (int kt = 0; kt < 8; ++kt) sc[tt][kt] = __builtin_amdgcn_mfma_f32_16x16x32_bf16(ka[kt], qb[tt], sc[tt][kt], 0, 0, 0);
            }
            __syncthreads();
#pragma unroll
            for (int tt = 0; tt < 2; ++tt) {
                __builtin_amdgcn_sched_barrier(0);
                unsigned lo[16], hi[16];
#pragma unroll
                for (int kt = 0; kt < 4; ++kt)
#pragma unroll
                    for (int r = 0; r < 4; ++r) {
                        lo[kt * 4 + r] = (f2key(sc[tt][kt][r]) & ~0x7Fu) | (unsigned)(127 - (kt * 16 + lq * 4 + r));
                        hi[kt * 4 + r] = (f2key(sc[tt][kt + 4][r]) & ~0x7Fu) | (unsigned)(127 - ((kt + 4) * 16 + lq * 4 + r));
                    }
                bitonic_sort_desc<16>(lo); bitonic_sort_desc<16>(hi);
                merge_top16(lo, hi);
                xlane_merge_top16(lo, 16); xlane_merge_top16(lo, 32);
                if (lq == 0) {
                    uint4* dst = (uint4*)(Ll + (w * 32 + tt * 16 + lr) * 32 + p * 16);
                    dst[0] = make_uint4(lo[0], lo[1], lo[2], lo[3]); dst[1] = make_uint4(lo[4], lo[5], lo[6], lo[7]);
                    dst[2] = make_uint4(lo[8], lo[9], lo[10], lo[11]); dst[3] = make_uint4(lo[12], lo[13], lo[14], lo[15]);
                }
            }
        }
        __syncthreads();
#pragma unroll
        for (int tt = 0; tt < 2; ++tt) {
            __builtin_amdgcn_sched_barrier(0);
            const int tokl = w * 32 + tt * 16 + lr;
            float v0[16], v1[16];
            { const uint4* sp = (const uint4*)(Ll + tokl * 32);
#pragma unroll
              for (int q = 0; q < 4; ++q) {
                  const uint4 a = sp[q], b = sp[4 + q];
                  v0[q * 4] = key2f(a.x & ~0x7Fu); v0[q * 4 + 1] = key2f(a.y & ~0x7Fu); v0[q * 4 + 2] = key2f(a.z & ~0x7Fu); v0[q * 4 + 3] = key2f(a.w & ~0x7Fu);
                  v1[q * 4] = key2f(b.x & ~0x7Fu); v1[q * 4 + 1] = key2f(b.y & ~0x7Fu); v1[q * 4 + 2] = key2f(b.z & ~0x7Fu); v1[q * 4 + 3] = key2f(b.w & ~0x7Fu);
              } }
            unsigned c2[16];
#pragma unroll
            for (int r = 0; r < 16; ++r) c2[r] = 0u;
#define CAND(slot, a, b) c2[slot] = (f2key(v0[a] + v1[b]) & ~0xFFu) | (unsigned)(255 - ((a) * 16 + (b)))
            if (lq == 0) {
                CAND(0, 0, 0); CAND(1, 0, 1); CAND(2, 0, 2); CAND(3, 0, 3); CAND(4, 0, 4); CAND(5, 0, 5); CAND(6, 0, 6); CAND(7, 0, 7);
                CAND(8, 0, 8); CAND(9, 0, 9); CAND(10, 0, 10); CAND(11, 0, 11); CAND(12, 0, 12); CAND(13, 0, 13); CAND(14, 0, 14); CAND(15, 0, 15);
            } else if (lq == 1) {
                CAND(0, 8, 0); CAND(1, 9, 0); CAND(2, 10, 0); CAND(3, 11, 0); CAND(4, 12, 0); CAND(5, 13, 0); CAND(6, 14, 0); CAND(7, 15, 0);
                CAND(8, 1, 0); CAND(9, 1, 1); CAND(10, 1, 2); CAND(11, 1, 3); CAND(12, 1, 4); CAND(13, 1, 5); CAND(14, 1, 6); CAND(15, 1, 7);
            } else if (lq == 2) {
                CAND(0, 2, 0); CAND(1, 2, 1); CAND(2, 2, 2); CAND(3, 2, 3); CAND(4, 2, 4); CAND(5, 3, 0); CAND(6, 3, 1); CAND(7, 3, 2);
                CAND(8, 3, 3); CAND(9, 4, 0); CAND(10, 4, 1); CAND(11, 4, 2); CAND(12, 5, 0); CAND(13, 5, 1);
            } else {
                CAND(0, 6, 0); CAND(1, 6, 1); CAND(2, 7, 0); CAND(3, 7, 1);
            }
#undef CAND
            bitonic_sort_desc<16>(c2);
            xlane_merge_top16(c2, 16); xlane_merge_top16(c2, 32);
            if (lq == 0) {
                float s[16]; int ei[16];
#pragma unroll
                for (int r = 0; r < 16; ++r) {
                    const unsigned code = 255u - (c2[r] & 0xFFu);
                    const unsigned k0 = Ll[tokl * 32 + (code >> 4)], k1 = Ll[tokl * 32 + 16 + (code & 15u)];
                    s[r] = key2f(k0 & ~0x7Fu) + key2f(k1 & ~0x7Fu);
                    ei[r] = (int)((127u - (k0 & 0x7Fu)) * 128u + (127u - (k1 & 0x7Fu)));
                }
                float mx = s[0];
#pragma unroll
                for (int r = 1; r < 16; ++r) mx = fmaxf(mx, s[r]);
                float sum = 0.f;
#pragma unroll
                for (int r = 0; r < 16; ++r) { s[r] = __expf(s[r] - mx); sum += s[r]; }
                const float inv = 1.0f / sum;
                const size_t o = ((size_t)(m0 + tokl) * 8 + h) * 16;
#pragma unroll
                for (int r = 0; r < 16; r += 4) {
                    *(int4*)(EIDX + o + r) = make_int4(ei[r], ei[r + 1], ei[r + 2], ei[r + 3]);
                    *(float4*)(GW + o + r) = make_float4(s[r] * inv, s[r + 1] * inv, s[r + 2] * inv, s[r + 3] * inv);
                }
            }
        }
        __syncthreads();
    }
}

#define DPP_ADD(r, ctrl) r += __builtin_bit_cast(float, __builtin_amdgcn_update_dpp(0, __builtin_bit_cast(int, r), ctrl, 0xf, 0xf, false))
__device__ __forceinline__ float dot8(const uint4& a, const uint4& b, float acc) {
    acc = __builtin_amdgcn_fdot2_f32_bf16(__builtin_bit_cast(bf16v2_t, a.x), __builtin_bit_cast(bf16v2_t, b.x), acc, false);
    acc = __builtin_amdgcn_fdot2_f32_bf16(__builtin_bit_cast(bf16v2_t, a.y), __builtin_bit_cast(bf16v2_t, b.y), acc, false);
    acc = __builtin_amdgcn_fdot2_f32_bf16(__builtin_bit_cast(bf16v2_t, a.z), __builtin_bit_cast(bf16v2_t, b.z), acc, false);
    acc = __builtin_amdgcn_fdot2_f32_bf16(__builtin_bit_cast(bf16v2_t, a.w), __builtin_bit_cast(bf16v2_t, b.w), acc, false);
    return acc;
}
#define PE_LDS_BYTES (65536 + 256)
__device__ __forceinline__ void phase_peer_expert(const unsigned char* __restrict__ HQ, const float* __restrict__ HSC, const int* __restrict__ EIDX, const float* __restrict__ GW,
                                  const unsigned char* __restrict__ DOWNQ, const unsigned char* __restrict__ UPQ, const float* __restrict__ DSC, const float* __restrict__ USC,
                                  const float* __restrict__ mod, const float* __restrict__ final_g, const float* x1src, float* __restrict__ X2, float* out, char* lds) {
    const int tid = threadIdx.x, lane = tid & 63, w = tid >> 6;
    const int r8 = lane >> 3, cp8 = lane & 7;
    int* eid_l = (int*)(lds + w * 16384);
    int* part_l = (int*)(lds + w * 16384 + 8192);
    float* w_l = (float*)part_l;
    float* ssq_l = (float*)(lds + 65536 + w * 64);
    const int nwaves = gridDim.x * 4;
    const int tpw = (NTOK + nwaves - 1) / nwaves;
    const int t_begin = (blockIdx.x * 4 + w) * tpw;
    for (int base = 0; base < tpw; base += 16) {
        const int t0 = t_begin + base;
        int nt = tpw - base; if (nt > 16) nt = 16; if (t0 + nt > NTOK) nt = NTOK - t0; if (nt < 0) nt = 0;
#pragma unroll 4
        for (int i = 0; i < nt; ++i) { eid_l[i * 128 + (lane & 7) * 16 + (lane >> 3)] = EIDX[(size_t)(t0 + i) * 128 + lane]; eid_l[i * 128 + (lane & 7) * 16 + 8 + (lane >> 3)] = EIDX[(size_t)(t0 + i) * 128 + 64 + lane];
                                       part_l[i * 128 + lane] = 0; part_l[i * 128 + 64 + lane] = 0; }
        if (lane < 16) ssq_l[lane] = 0.f;
        __syncthreads();
#pragma unroll 1
        for (int s = 0; s < 8; ++s) {
#pragma unroll 1
            for (int i = 0; i < nt; ++i) {
                const uint4 hq = *(const uint4*)(HQ + (size_t)(t0 + i) * 1024 + s * 128 + cp8 * 16);
                int ev[16];
#pragma unroll
                for (int q = 0; q < 4; ++q) { const int4 e4 = *(const int4*)(eid_l + i * 128 + r8 * 16 + q * 4); ev[q * 4] = e4.x; ev[q * 4 + 1] = e4.y; ev[q * 4 + 2] = e4.z; ev[q * 4 + 3] = e4.w; }
                uint4 dv[16];
#pragma unroll
                for (int j = 0; j < 16; ++j) dv[j] = *(const uint4*)(DOWNQ + (size_t)s * (16384 * 128) + (size_t)ev[j] * 128 + cp8 * 16);
                int res[16];
#pragma unroll
                for (int j = 0; j < 16; ++j) {
                    int sm = __builtin_amdgcn_sdot4((int)dv[j].x, (int)hq.x, 0, false);
                    sm = __builtin_amdgcn_sdot4((int)dv[j].y, (int)hq.y, sm, false);
                    sm = __builtin_amdgcn_sdot4((int)dv[j].z, (int)hq.z, sm, false);
                    sm = __builtin_amdgcn_sdot4((int)dv[j].w, (int)hq.w, sm, false);
                    sm += __builtin_amdgcn_update_dpp(0, sm, 0xB1, 0xf, 0xf, false);
                    sm += __builtin_amdgcn_update_dpp(0, sm, 0x4E, 0xf, 0xf, false);
                    sm += __builtin_amdgcn_update_dpp(0, sm, 0x141, 0xf, 0xf, false);
                    res[j] = sm;
                }
                if (cp8 == 0) {
                    int4* pp = (int4*)(part_l + i * 128 + r8 * 16);
#pragma unroll
                    for (int q = 0; q < 4; ++q) { int4 p4 = pp[q]; p4.x += res[q * 4]; p4.y += res[q * 4 + 1]; p4.z += res[q * 4 + 2]; p4.w += res[q * 4 + 3]; pp[q] = p4; }
                }
            }
        }
        __syncthreads();
#pragma unroll 4
        for (int i = 0; i < nt; ++i) {
            const float hs = HSC[t0 + i];
#pragma unroll
            for (int hf = 0; hf < 2; ++hf) {
                const int q = hf * 64 + lane; const int k = (q & 15) * 8 + (q >> 4); const int e = eid_l[i * 128 + q];
                const float a = (float)part_l[i * 128 + q] * hs * DSC[e];
                w_l[i * 128 + q] = GW[(size_t)(t0 + i) * 128 + k] * gelu_tanh(a) * USC[e];
            }
        }
        __syncthreads();
#pragma unroll 1
        for (int s = 0; s < 8; ++s) {
#pragma unroll 1
            for (int ib = 0; ib < nt; ib += 8) {
                const int il = (ib + r8 < nt) ? ib + r8 : nt - 1;
                const int t = t0 + il; const int b = t / SEQ;
                const int c0 = s * 128 + cp8 * 16;
                float4 xv4[4], g24[4];
#pragma unroll
                for (int q4 = 0; q4 < 4; ++q4) { xv4[q4] = *(const float4*)(x1src + (size_t)t * 1024 + c0 + q4 * 4); g24[q4] = *(const float4*)(mod + b * 6144 + 5120 + c0 + q4 * 4); }
                f32x2_t a2[8];
#pragma unroll
                for (int c = 0; c < 8; ++c) a2[c] = f32x2_t{0.f, 0.f};
                const unsigned char* ubase = UPQ + (size_t)s * (16384 * 128) + cp8 * 16;
#pragma unroll 1
                for (int q0 = 0; q0 < 128; q0 += 16) {
                    int ev[16]; float wv[16];
#pragma unroll
                    for (int q = 0; q < 4; ++q) {
                        const int4 e4 = *(const int4*)(eid_l + il * 128 + q0 + q * 4); ev[q * 4] = e4.x; ev[q * 4 + 1] = e4.y; ev[q * 4 + 2] = e4.z; ev[q * 4 + 3] = e4.w;
                        const float4 w4 = *(const float4*)(w_l + il * 128 + q0 + q * 4); wv[q * 4] = w4.x; wv[q * 4 + 1] = w4.y; wv[q * 4 + 2] = w4.z; wv[q * 4 + 3] = w4.w;
                    }
                    uint4 uv[16];
#pragma unroll
                    for (int j = 0; j < 16; ++j) uv[j] = *(const uint4*)(ubase + (size_t)ev[j] * 128);
#pragma unroll
                    for (int j = 0; j < 16; ++j) {
                        const f32x2_t wk2 = {wv[j], wv[j]};
                        const unsigned uu[4] = {uv[j].x, uv[j].y, uv[j].z, uv[j].w};
#pragma unroll
                        for (int q = 0; q < 4; ++q) {
                            a2[2 * q] = wk2 * __builtin_amdgcn_cvt_pk_f32_fp8((int)uu[q], false) + a2[2 * q];
                            a2[2 * q + 1] = wk2 * __builtin_amdgcn_cvt_pk_f32_fp8((int)uu[q], true) + a2[2 * q + 1];
                        }
                    }
                }
                float sq = 0.f;
#pragma unroll
                for (int q4 = 0; q4 < 4; ++q4) {
                    float4 r; r.x = xv4[q4].x + g24[q4].x * a2[2 * q4][0]; r.y = xv4[q4].y + g24[q4].y * a2[2 * q4][1];
                    r.z = xv4[q4].z + g24[q4].z * a2[2 * q4 + 1][0]; r.w = xv4[q4].w + g24[q4].w * a2[2 * q4 + 1][1];
                    sq += r.x * r.x + r.y * r.y + r.z * r.z + r.w * r.w;
                    if (ib + r8 < nt) *(float4*)(X2 + (size_t)t * 1024 + c0 + q4 * 4) = r;
                }
                sq += __builtin_bit_cast(float, __builtin_amdgcn_update_dpp(0, __builtin_bit_cast(int, sq), 0xB1, 0xf, 0xf, false));
                sq += __builtin_bit_cast(float, __builtin_amdgcn_update_dpp(0, __builtin_bit_cast(int, sq), 0x4E, 0xf, 0xf, false));
                sq += __builtin_bit_cast(float, __builtin_amdgcn_update_dpp(0, __builtin_bit_cast(int, sq), 0x141, 0xf, 0xf, false));
                if (cp8 == 0 && ib + r8 < nt) ssq_l[il] += sq;
            }
        }
        asm volatile("s_waitcnt vmcnt(0)" ::: "memory");
        __syncthreads();
#pragma unroll 4
        for (int i = 0; i < nt; ++i) {
            const int t = t0 + i;
            const float rn = rsqrtf(ssq_l[i] * (1.0f / 1024.0f) + EPS);
#pragma unroll
            for (int q4 = 0; q4 < 4; ++q4) {
                const int c = q4 * 256 + lane * 4;
                const float4 xv = *(const float4*)(X2 + (size_t)t * 1024 + c);
                const float4 fg = *(const float4*)(final_g + c);
                float4 r; r.x = xv.x * rn * fg.x; r.y = xv.y * rn * fg.y; r.z = xv.z * rn * fg.z; r.w = xv.w * rn * fg.w;
                *(float4*)(out + (size_t)t * 1024 + c) = r;
            }
        }
        __syncthreads();
    }
}


#define XB_TMO      128
#define XB_XCNT(j)  (256  + 64 * (j))
#define XB_XSUB(j)  (1280 + 64 * (j))
#define XB_XGEN(j)  (2304 + 64 * (j))
#define XB_TOP      3328
#define XB_TOPGEN   3392
#define XCD_BAR_WORDS 3456
#define XB_SPIN_CAP (1u << 22)
__device__ __forceinline__ unsigned xb_ld(unsigned* p)              { return __hip_atomic_load(p, __ATOMIC_RELAXED, __HIP_MEMORY_SCOPE_AGENT); }
__device__ __forceinline__ unsigned xb_add(unsigned* p, unsigned v) { return __hip_atomic_fetch_add(p, v, __ATOMIC_RELAXED, __HIP_MEMORY_SCOPE_AGENT); }
__device__ __forceinline__ unsigned xb_xcc_id() { return (unsigned)__builtin_amdgcn_s_getreg((3 << 11) | 20) & 0xFu; }
#define XB_SPIN(cond, bar) do { unsigned _sp = 0; while (cond) { __builtin_amdgcn_s_sleep(1); \
    if ((++_sp & 255u) == 0u) { if (xb_ld(&(bar)[XB_TMO])) break; if (_sp > XB_SPIN_CAP) { atomicAdd(&(bar)[XB_TMO], 1u); break; } } } } while (0)
struct XcdBarrier { unsigned* bar; unsigned x; unsigned nloc; unsigned nx; };
__device__ __forceinline__ void xcd_barrier_post(XcdBarrier& b, unsigned* bar) {
    b.bar = bar; b.x = xb_xcc_id(); b.nloc = 0u; b.nx = 0u;
    if (threadIdx.x == 0) (void)xb_add(&bar[XB_XCNT(b.x)], 1u);
}
__device__ __forceinline__ void xcd_barrier_complete(unsigned* bar, unsigned x, unsigned& nloc, unsigned& nx) {
    const unsigned G = gridDim.x;
    unsigned sum, cnt, mine, sp = 0u;
    for (;;) {
        sum = 0u; cnt = 0u; mine = 0u;
#pragma unroll
        for (unsigned j = 0; j < 16; ++j) { const unsigned c = xb_ld(&bar[XB_XCNT(j)]); sum += c; cnt += (c > 0u) ? 1u : 0u; mine = (j == x) ? c : mine; }
        if (sum == G) break;
        __builtin_amdgcn_s_sleep(1);
        if ((++sp & 255u) == 0u) { if (xb_ld(&bar[XB_TMO])) break; if (sp > XB_SPIN_CAP) { atomicAdd(&bar[XB_TMO], 1u); break; } }
    }
    nloc = mine > 0u ? mine : 1u; nx = cnt > 0u ? cnt : 1u;
}
__device__ __forceinline__ void xcd_barrier(XcdBarrier& b) {
    asm volatile("s_waitcnt vmcnt(0)" ::: "memory");
    __syncthreads();
    if (threadIdx.x == 0) {
        unsigned* bar = b.bar;
        __builtin_amdgcn_s_waitcnt(0);
        if (b.nloc == 0u) xcd_barrier_complete(bar, b.x, b.nloc, b.nx);
        const unsigned nloc = b.nloc, nx = b.nx;
        const unsigned old = xb_add(&bar[XB_XSUB(b.x)], 1u);
        const unsigned gen = old / nloc;
        if (old + 1u == (gen + 1u) * nloc) {
            __builtin_amdgcn_fence(__ATOMIC_RELEASE, "agent");
            asm volatile("s_waitcnt vmcnt(0)" ::: "memory");
            const unsigned og = xb_add(&bar[XB_TOP], 1u);
            const unsigned tg = og / nx;
            if (og + 1u == (tg + 1u) * nx) xb_add(&bar[XB_TOPGEN], 1u);
            else XB_SPIN(xb_ld(&bar[XB_TOPGEN]) == tg, bar);
            __builtin_amdgcn_fence(__ATOMIC_ACQUIRE, "agent");
            xb_add(&bar[XB_XGEN(b.x)], 1u);
            asm volatile("s_waitcnt vmcnt(0)" ::: "memory");
        } else {
            XB_SPIN(xb_ld(&bar[XB_XGEN(b.x)]) == gen, bar);
            __builtin_amdgcn_fence(__ATOMIC_ACQUIRE, "agent");
            asm volatile("s_waitcnt vmcnt(0)" ::: "memory");
        }
    }
    __syncthreads();
}

__device__ __forceinline__ void prep_convT(const float* __restrict__ srcp, bf16_t* __restrict__ dst, int K, int N, char* lds, int& cursor) {
    float (*tile)[32][33] = (float (*)[32][33])lds;
    const int tx = threadIdx.x & 31, ty = threadIdx.x >> 5;
    const int ntn = N / 32, ntiles = ntn * (K / 32);
    const int G = gridDim.x;
    const int first = ((int)blockIdx.x - cursor % G + G) % G;
    for (int t = first; t < ntiles; t += 4 * G) {
#pragma unroll
        for (int u = 0; u < 4; ++u) {
            const int tt = t + u * G;
            if (tt < ntiles) { const int n0 = (tt % ntn) * 32, k0 = (tt / ntn) * 32;
#pragma unroll
                for (int i = 0; i < 4; ++i) tile[u][ty + 8 * i][tx] = srcp[(size_t)(k0 + ty + 8 * i) * N + n0 + tx]; }
        }
        __syncthreads();
#pragma unroll
        for (int u = 0; u < 4; ++u) {
            const int tt = t + u * G;
            if (tt < ntiles) { const int n0 = (tt % ntn) * 32, k0 = (tt / ntn) * 32;
#pragma unroll
                for (int i = 0; i < 4; ++i) dst[(size_t)(n0 + ty + 8 * i) * K + k0 + tx] = f2bf(tile[u][tx][ty + 8 * i]); }
        }
        __syncthreads();
    }
    cursor += ntiles;
}
__device__ __forceinline__ void prep_conv(const float* __restrict__ srcp, bf16_t* __restrict__ dst, size_t n8) {
    for (size_t i = (size_t)blockIdx.x * blockDim.x + threadIdx.x; i < n8; i += (size_t)gridDim.x * blockDim.x) {
        const float4 a = *(const float4*)(srcp + i * 8), b = *(const float4*)(srcp + i * 8 + 4);
        uint4 o; o.x = pack2(a.x, a.y); o.y = pack2(a.z, a.w); o.z = pack2(b.x, b.y); o.w = pack2(b.z, b.w);
        *(uint4*)(dst + i * 8) = o;
    }
}
__device__ __forceinline__ void prep_ada(const float* __restrict__ c, const float* __restrict__ w_ada, const float* __restrict__ b_ada, float* __restrict__ mod, char* lds) {
    float* sc = (float*)lds;
    float* part = (float*)(lds + 16384);
    const int tid = threadIdx.x, col = tid & 63, kq = tid >> 6;
    const int G = gridDim.x;
    for (int item = (int)blockIdx.x - (G - 96 > 0 ? G - 96 : 0); item >= 0 && item < 96; item += G) {
        __syncthreads();
        for (int i = tid; i < 4096; i += 256) { const float v = c[i]; sc[i] = v * sigmoidf_(v); }
        __syncthreads();
        const int e = item * 64 + col;
        float a0 = 0.f, a1 = 0.f, a2 = 0.f, a3 = 0.f;
        for (int d = kq * 256; d < kq * 256 + 256; ++d) {
            const float wv = w_ada[(size_t)d * 6144 + e];
            a0 += sc[d] * wv; a1 += sc[1024 + d] * wv; a2 += sc[2048 + d] * wv; a3 += sc[3072 + d] * wv;
        }
        part[(kq * 4 + 0) * 64 + col] = a0; part[(kq * 4 + 1) * 64 + col] = a1; part[(kq * 4 + 2) * 64 + col] = a2; part[(kq * 4 + 3) * 64 + col] = a3;
        __syncthreads();
        { const int b = tid >> 6;
          const float s = part[(0 * 4 + b) * 64 + col] + part[(1 * 4 + b) * 64 + col] + part[(2 * 4 + b) * 64 + col] + part[(3 * 4 + b) * 64 + col];
          mod[b * 6144 + e] = s + b_ada[e]; }
    }
    if (G < 96) {
        for (int item = (int)blockIdx.x + G; item < 96; item += G) { (void)item; }
    }
}

__device__ __forceinline__ void prep_quant(const float* __restrict__ srcp, unsigned char* __restrict__ dst, float* __restrict__ scales, int rows, int off) {
    const int lane = threadIdx.x & 63, w = threadIdx.x >> 6;
    const int nwaves = gridDim.x * 4;
    for (int rb = (blockIdx.x * 4 + w) * 4; rb < rows; rb += nwaves * 4) {
        float4 v[4][4];
#pragma unroll
        for (int u = 0; u < 4; ++u)
#pragma unroll
            for (int j = 0; j < 4; ++j) v[u][j] = *(const float4*)(srcp + (size_t)(rb + u) * 1024 + lane * 16 + j * 4);
#pragma unroll
        for (int u = 0; u < 4; ++u) {
            const int r = rb + u;
            float am = 0.f;
#pragma unroll
            for (int j = 0; j < 4; ++j) am = fmaxf(am, fmaxf(fmaxf(fabsf(v[u][j].x), fabsf(v[u][j].y)), fmaxf(fabsf(v[u][j].z), fabsf(v[u][j].w))));
            for (int o = 32; o > 0; o >>= 1) am = fmaxf(am, __shfl_xor(am, o));
            unsigned o4[4];
            if (off < 0) {
                const float inv8 = am > 0.f ? 448.0f / am : 0.f;
                if (lane == 0) scales[r] = am > 0.f ? am * (1.0f / 448.0f) : 1.0f;
#pragma unroll
                for (int j = 0; j < 4; ++j) {
                    int p = 0;
                    p = __builtin_amdgcn_cvt_pk_fp8_f32(v[u][j].x * inv8, v[u][j].y * inv8, p, false);
                    p = __builtin_amdgcn_cvt_pk_fp8_f32(v[u][j].z * inv8, v[u][j].w * inv8, p, true);
                    o4[j] = (unsigned)p;
                }
            } else {
                const float inv = am > 0.f ? 127.0f / am : 0.f;
                if (lane == 0) scales[r] = am > 0.f ? am * (1.0f / 127.0f) : 1.0f;
#pragma unroll
                for (int j = 0; j < 4; ++j) {
                    const int q0 = __float2int_rn(v[u][j].x * inv) + off, q1 = __float2int_rn(v[u][j].y * inv) + off, q2 = __float2int_rn(v[u][j].z * inv) + off, q3 = __float2int_rn(v[u][j].w * inv) + off;
                    o4[j] = (unsigned)(q0 & 0xff) | ((unsigned)(q1 & 0xff) << 8) | ((unsigned)(q2 & 0xff) << 16) | ((unsigned)(q3 & 0xff) << 24);
                }
            }
            *(uint4*)(dst + (size_t)(lane >> 3) * ((size_t)rows * 128) + (size_t)r * 128 + (lane & 7) * 16) = make_uint4(o4[0], o4[1], o4[2], o4[3]);
        }
    }
}
template <bool QUANT>
__device__ __forceinline__ void phase_norm(const float* __restrict__ x, const float* __restrict__ g, const float* __restrict__ mod, int sh_off, int sc_off, bf16_t* __restrict__ H,
                                           unsigned char* __restrict__ HQ, float* __restrict__ HSC) {
    const int lane = threadIdx.x & 63, w = threadIdx.x >> 6;
    const int nwaves = gridDim.x * 4;
    for (int tb = (blockIdx.x * 4 + w) * 2; tb < NTOK; tb += nwaves * 2) {
        float4 v[2][4];
#pragma unroll
        for (int u = 0; u < 2; ++u)
#pragma unroll
            for (int j = 0; j < 4; ++j) v[u][j] = *(const float4*)(x + (size_t)(tb + u) * 1024 + j * 256 + lane * 4);
#pragma unroll
        for (int u = 0; u < 2; ++u) {
            const int t = tb + u; const int b = t / SEQ;
            float ss = 0.f;
#pragma unroll
            for (int j = 0; j < 4; ++j) ss += v[u][j].x * v[u][j].x + v[u][j].y * v[u][j].y + v[u][j].z * v[u][j].z + v[u][j].w * v[u][j].w;
            for (int o = 32; o > 0; o >>= 1) ss += __shfl_xor(ss, o);
            const float r = rsqrtf(ss * (1.0f / 1024.0f) + EPS);
            float am = 0.f;
#pragma unroll
            for (int j = 0; j < 4; ++j) {
                const int c = j * 256 + lane * 4;
                const float4 gg = *(const float4*)(g + c), sc = *(const float4*)(mod + b * 6144 + sc_off + c), sh = *(const float4*)(mod + b * 6144 + sh_off + c);
                float4& vv = v[u][j];
                vv.x = vv.x * r * gg.x * (1.0f + sc.x) + sh.x; vv.y = vv.y * r * gg.y * (1.0f + sc.y) + sh.y;
                vv.z = vv.z * r * gg.z * (1.0f + sc.z) + sh.z; vv.w = vv.w * r * gg.w * (1.0f + sc.w) + sh.w;
                *(uint2*)(H + (size_t)t * 1024 + c) = pack4(vv.x, vv.y, vv.z, vv.w);
                if (QUANT) am = fmaxf(am, fmaxf(fmaxf(fabsf(vv.x), fabsf(vv.y)), fmaxf(fabsf(vv.z), fabsf(vv.w))));
            }
            if (QUANT) {
                for (int o = 32; o > 0; o >>= 1) am = fmaxf(am, __shfl_xor(am, o));
                const float inv = am > 0.f ? 127.0f / am : 0.f;
                if (lane == 0) HSC[t] = am > 0.f ? am * (1.0f / 127.0f) : 1.0f;
#pragma unroll
                for (int j = 0; j < 4; ++j) {
                    const float4 vv = v[u][j];
                    const int q0 = __float2int_rn(vv.x * inv), q1 = __float2int_rn(vv.y * inv), q2 = __float2int_rn(vv.z * inv), q3 = __float2int_rn(vv.w * inv);
                    *(unsigned*)(HQ + (size_t)t * 1024 + j * 256 + lane * 4) = (unsigned)(q0 & 0xff) | ((unsigned)(q1 & 0xff) << 8) | ((unsigned)(q2 & 0xff) << 16) | ((unsigned)(q3 & 0xff) << 24);
                }
            }
        }
    }
}
struct MegaParams {
    const float* in[24];
    float* out;
    char* ws;
    int use_cg; int pad;
};
#define MEGA_LDS_BYTES 81920
#ifndef PROBE_DUP
#define PROBE_DUP 0
#endif
#define W_CTL   ((float*)(ws + OFF_CTL))
#define W_MOD   ((float*)(ws + OFF_MOD))
#define W_WTIN  ((bf16_t*)(ws + OFF_WTIN))
#define W_WTA   ((bf16_t*)(ws + OFF_WTA))
#define W_WTB   ((bf16_t*)(ws + OFF_WTB))
#define W_WTOUT ((bf16_t*)(ws + OFF_WTOUT))
#define W_WTQ   ((bf16_t*)(ws + OFF_WTQ))
#define W_SUBK  ((bf16_t*)(ws + OFF_SUBK))
#define W_DOWN  ((bf16_t*)(ws + OFF_DOWN))
#define W_UP    ((bf16_t*)(ws + OFF_UP))
#define W_H     ((bf16_t*)(ws + OFF_H))
#define W_Q     ((bf16_t*)(ws + OFF_Q))
#define W_K     ((bf16_t*)(ws + OFF_K))
#define W_V     ((bf16_t*)(ws + OFF_VT))
#define W_U     ((bf16_t*)(ws + OFF_U))
#define W_SV    ((bf16_t*)(ws + OFF_SV))
#define W_GATES ((bf16_t*)(ws + OFF_GATES))
#define W_YA    ((bf16_t*)(ws + OFF_YA))
#define W_YB    ((bf16_t*)(ws + OFF_YB))
#define W_MERGED ((bf16_t*)(ws + OFF_MERGED))
#define W_EIDX  ((int*)(ws + OFF_EIDX))
#define W_GW    ((float*)(ws + OFF_GW))
__global__ __launch_bounds__(256, 2) void k_mega(MegaParams P) {
    cg::grid_group grid = cg::this_grid();
    char* lds = dyn_lds; char* ws = P.ws;
    const float* x = P.in[0];
    XcdBarrier xb; xcd_barrier_post(xb, (unsigned*)(ws + OFF_BAR));
    prep_ada(P.in[1], P.in[2], P.in[3], W_MOD, lds);
    if (blockIdx.x == 0 && threadIdx.x == 0) {
        float s1 = 0.f, s2 = 0.f;
        for (int i = 0; i < 64; ++i) { s1 += P.in[6][i] * P.in[7][i]; s2 += P.in[8][i] * P.in[9][i]; }
        W_CTL[0] = __expf(s1) - __expf(s2) + 0.2f;
    }
    { int cursor = 0;
      __syncthreads();
      prep_convT(P.in[5], W_WTIN, 1024, IN_COLS, lds, cursor);
      prep_convT(P.in[15], W_WTA, 512, 1024, lds, cursor);
      prep_convT(P.in[16], W_WTB, 512, 1024, lds, cursor);
      prep_convT(P.in[17], W_WTOUT, 1024, 1024, lds, cursor);
      prep_convT(P.in[19], W_WTQ, 1024, 2048, lds, cursor); }
    prep_conv(P.in[20], W_SUBK, (size_t)8 * 2 * 128 * 128 / 8);
    prep_quant(P.in[21], (unsigned char*)(ws + OFF_DOWN), (float*)(ws + OFF_DSC), 16384, 0);
    prep_quant(P.in[22], (unsigned char*)(ws + OFF_UP), (float*)(ws + OFF_USC), 16384, -1);
    if (P.use_cg) grid.sync(); else xcd_barrier(xb);
    phase_norm<false>(x, P.in[4], W_MOD, 0, 1024, W_H, nullptr, nullptr);
    xcd_barrier(xb);
#if PROBE_DUP == 2
    phase_inproj(W_H, W_WTIN, W_Q, W_K, W_V, W_U, W_SV, W_GATES, lds);
#endif
    phase_inproj(W_H, W_WTIN, W_Q, W_K, W_V, W_U, W_SV, W_GATES, lds);
    xcd_barrier(xb);
#if PROBE_DUP == 3
    phase_attn(W_Q, W_K, W_V, W_CTL, P.in[10], W_YA, lds);
#endif
    phase_attn(W_Q, W_K, W_V, W_CTL, P.in[10], W_YA, lds);
#if PROBE_DUP == 4
    phase_sgu(W_U, W_SV, P.in[11], P.in[12], P.in[13], P.in[14], W_YB, lds);
#endif
    phase_sgu(W_U, W_SV, P.in[11], P.in[12], P.in[13], P.in[14], W_YB, lds);
    xcd_barrier(xb);
#if PROBE_DUP == 5
    phase_merged(W_YA, W_YB, W_WTA, W_WTB, W_GATES, W_MERGED, lds);
#endif
    phase_merged(W_YA, W_YB, W_WTA, W_WTB, W_GATES, W_MERGED, lds);
    xcd_barrier(xb);
#if PROBE_DUP == 6
    phase_outproj(W_MERGED, W_WTOUT, x, W_MOD, P.out, lds);
#endif
    phase_outproj(W_MERGED, W_WTOUT, x, W_MOD, P.out, lds);
    xcd_barrier(xb);
    phase_norm<true>(P.out, P.in[18], W_MOD, 3072, 4096, W_H, (unsigned char*)(ws + OFF_HQ), (float*)(ws + OFF_HSC));
    xcd_barrier(xb);
#if PROBE_DUP == 8
    phase_peer_select(W_H, W_WTQ, W_SUBK, W_EIDX, W_GW, lds);
#endif
    phase_peer_select(W_H, W_WTQ, W_SUBK, W_EIDX, W_GW, lds);
    xcd_barrier(xb);
    phase_peer_expert((const unsigned char*)(ws + OFF_HQ), (const float*)(ws + OFF_HSC), W_EIDX, W_GW, (const unsigned char*)(ws + OFF_DOWN), (const unsigned char*)(ws + OFF_UP), (const float*)(ws + OFF_DSC), (const float*)(ws + OFF_USC), W_MOD, P.in[23], P.out, (float*)(ws + OFF_GATES), P.out, lds);
}

extern "C" void kernel_launch(void* const* d_in, const int* in_sizes, int n_in, void* d_out, int out_size, void* d_ws, size_t ws_size, hipStream_t stream) {
    if (ws_size < OFF_END || n_in < 24) return;
    static int grid_blocks = 0;
    if (!grid_blocks) {
        int dev = 0, cus = 0, per_cu = 0;
        hipGetDevice(&dev);
        hipDeviceGetAttribute(&cus, hipDeviceAttributeMultiprocessorCount, dev);
        hipFuncSetAttribute((const void*)k_mega, hipFuncAttributeMaxDynamicSharedMemorySize, MEGA_LDS_BYTES);
        hipOccupancyMaxActiveBlocksPerMultiprocessor(&per_cu, k_mega, 256, MEGA_LDS_BYTES);
        if (per_cu > 2) per_cu = 2;
        if (per_cu < 1) per_cu = 1;
        grid_blocks = cus * per_cu;
    }
    MegaParams P{};
    for (int i = 0; i < 24; ++i) P.in[i] = (const float*)d_in[i];
    P.out = (float*)d_out; P.ws = (char*)d_ws;
    hipMemsetAsync((char*)d_ws + OFF_BAR, 0, XCD_BAR_WORDS * 4, stream);
    void* args[] = {&P};
    hipError_t e = hipLaunchCooperativeKernel((void*)k_mega, dim3(grid_blocks), dim3(256), args, MEGA_LDS_BYTES, stream);
    if (e != hipSuccess) fprintf(stderr, "cooperative launch failed: %s (grid %d)\n", hipGetErrorString(e), grid_blocks);
}
```

```cpp
#include <hip/hip_runtime.h>
#include <hip/hip_cooperative_groups.h>
#include <stdint.h>
#include <stdio.h>
namespace cg = cooperative_groups;

typedef unsigned short bf16_t;

#define D_MODEL 1024
#define BATCH 4
#define SEQ 8192
#define NTOK (BATCH * SEQ)
#define IN_COLS 4608
#define EPS 1e-6f
#define QSCALE 0.18033688011112042f

__device__ __forceinline__ float bf2f(bf16_t v) { return __uint_as_float(((unsigned)v) << 16); }
typedef __bf16 bf16v2_t __attribute__((ext_vector_type(2)));
__device__ __forceinline__ bf16_t f2bf(float f) { return __builtin_bit_cast(unsigned short, (__bf16)f); }
__device__ __forceinline__ unsigned pack2(float a, float b) { bf16v2_t v; v[0] = (__bf16)a; v[1] = (__bf16)b; return __builtin_bit_cast(unsigned, v); }
__device__ __forceinline__ float gelu_tanh(float x) {
    const float z2 = 1.5957691216057308f * (x + 0.044715f * x * x * x);
    return x * __builtin_amdgcn_rcpf(1.0f + __expf(-z2));
}
__device__ __forceinline__ float sigmoidf_(float x) { return __builtin_amdgcn_rcpf(1.0f + __expf(-x)); }

constexpr size_t OFF_CTL   = 0;
constexpr size_t OFF_BAR   = 4096;
constexpr size_t OFF_MOD   = 4096 + 16384;
constexpr size_t OFF_STATS = OFF_MOD + 4 * 6144 * 4;
constexpr size_t OFF_WTIN  = OFF_STATS + (size_t)NTOK * 2 * 4;
constexpr size_t OFF_WTA   = OFF_WTIN + (size_t)IN_COLS * 1024 * 2;
constexpr size_t OFF_WTB   = OFF_WTA + (size_t)1024 * 512 * 2;
constexpr size_t OFF_WTOUT = OFF_WTB + (size_t)1024 * 512 * 2;
constexpr size_t OFF_WTQ   = OFF_WTOUT + (size_t)1024 * 1024 * 2;
constexpr size_t OFF_SUBK  = OFF_WTQ + (size_t)2048 * 1024 * 2;
constexpr size_t OFF_DOWN  = OFF_SUBK + (size_t)8 * 2 * 128 * 128 * 2;
constexpr size_t OFF_UP    = OFF_DOWN + (size_t)16384 * 1024;
constexpr size_t OFF_DSC   = OFF_UP + (size_t)16384 * 1024;
constexpr size_t OFF_USC   = OFF_DSC + (size_t)16384 * 4;
constexpr size_t OFF_H     = OFF_USC + (size_t)16384 * 4;
constexpr size_t OFF_Q     = OFF_H + (size_t)NTOK * 1024 * 2;
constexpr size_t OFF_K     = OFF_Q + (size_t)NTOK * 512 * 2;
constexpr size_t OFF_VT    = OFF_K + (size_t)NTOK * 512 * 2;
constexpr size_t OFF_U     = OFF_VT + (size_t)NTOK * 512 * 2;
constexpr size_t OFF_SV    = OFF_U + (size_t)NTOK * 512 * 2;
constexpr size_t OFF_GATES = OFF_SV + (size_t)NTOK * 512 * 2;
constexpr size_t OFF_YA    = OFF_GATES + (size_t)NTOK * 2048 * 2;
constexpr size_t OFF_YB    = OFF_YA + (size_t)NTOK * 512 * 2;
constexpr size_t OFF_END   = OFF_YB + (size_t)NTOK * 512 * 2;
constexpr size_t OFF_MERGED = OFF_Q;
constexpr size_t OFF_EIDX  = OFF_U;
constexpr size_t OFF_GW    = OFF_SV;
constexpr size_t OFF_HQ    = OFF_YA;
constexpr size_t OFF_HSC   = OFF_STATS;

extern __shared__ __attribute__((aligned(16))) char dyn_lds[];
using bf16x8 = __attribute__((ext_vector_type(8))) short;
using f32x4 = __attribute__((ext_vector_type(4))) float;
typedef float f32x2_t __attribute__((ext_vector_type(2)));
typedef __attribute__((address_space(3))) char* lds_ptr_t;
#define GEMM_LDS_BYTES 65536
#define SEL_LDS_BYTES 81920

__device__ __forceinline__ uint2 pack4(float a, float b, float c, float d) {
    uint2 r; r.x = pack2(a, b); r.y = pack2(c, d); return r;
}

__device__ __forceinline__ void g_load(const bf16_t* __restrict__ A, int lda, int m0, int k0, uint4 (&r)[4], int tid) {
    const int c = tid & 7, rr = tid >> 3;
#pragma unroll
    for (int i = 0; i < 4; ++i) r[i] = *(const uint4*)(A + (size_t)(m0 + rr + 32 * i) * lda + k0 + c * 8);
}
__device__ __forceinline__ void g_store(char* lds, const uint4 (&r)[4], int tid) {
    const int c = tid & 7, rr = tid >> 3;
#pragma unroll
    for (int i = 0; i < 4; ++i) { const int row = rr + 32 * i; *(uint4*)(lds + row * 128 + ((c ^ (row & 7)) << 4)) = r[i]; }
}
__device__ __forceinline__ void g_compute(const char* sA, const char* sB, f32x4 (&acc)[4][4], int wm, int wn, int lane) {
    const int lr = lane & 15, lq = lane >> 4;
#pragma unroll
    for (int ks = 0; ks < 2; ++ks) {
        bf16x8 a[4], b[4];
        const int sw = (((ks * 4 + lq) ^ (lr & 7)) << 4);
#pragma unroll
        for (int i = 0; i < 4; ++i) a[i] = *(const bf16x8*)(sA + (wm * 64 + i * 16 + lr) * 128 + sw);
#pragma unroll
        for (int j = 0; j < 4; ++j) b[j] = *(const bf16x8*)(sB + (wn * 64 + j * 16 + lr) * 128 + sw);
#pragma unroll
        for (int i = 0; i < 4; ++i)
#pragma unroll
            for (int j = 0; j < 4; ++j) acc[i][j] = __builtin_amdgcn_mfma_f32_16x16x32_bf16(b[j], a[i], acc[i][j], 0, 0, 0);
    }
}
__device__ __forceinline__ void g_dma(const bf16_t* __restrict__ A, int lda, int m0, int k0, char* lds_tile, int lane, int w) {
    const int rl = lane >> 3, pc = lane & 7;
#pragma unroll
    for (int i = 0; i < 4; ++i) {
        const int n = w * 4 + i; const int row = 8 * n + rl;
        __builtin_amdgcn_global_load_lds((const unsigned*)(A + (size_t)(m0 + row) * lda + k0 + ((pc ^ (row & 7)) << 3)),
                                         (__attribute__((address_space(3))) unsigned*)(lds_ptr_t)(lds_tile + n * 1024), 16, 0, 0);
    }
}
__device__ __forceinline__ void g_kloop(const bf16_t* __restrict__ A, int lda, const bf16_t* __restrict__ Bt, int ldb, int K, int m0, int n0,
                                        char* lds, f32x4 (&acc)[4][4], int tid) {
    const int lane = tid & 63, w = __builtin_amdgcn_readfirstlane(tid >> 6), wm = w >> 1, wn = w & 1;
    g_dma(A, lda, m0, 0, lds, lane, w); g_dma(Bt, ldb, n0, 0, lds + 16384, lane, w);
    asm volatile("s_waitcnt vmcnt(0)" ::: "memory");
    __syncthreads();
    const int nk = K >> 6;
    for (int kt = 0; kt < nk; ++kt) {
        char* cur = lds + (kt & 1) * 32768; char* nxt = lds + ((kt + 1) & 1) * 32768;
        if (kt + 1 < nk) { g_dma(A, lda, m0, (kt + 1) * 64, nxt, lane, w); g_dma(Bt, ldb, n0, (kt + 1) * 64, nxt + 16384, lane, w); }
        g_compute(cur, cur + 16384, acc, wm, wn, lane);
        asm volatile("s_waitcnt vmcnt(0)" ::: "memory");
        __syncthreads();
    }
}
__device__ __forceinline__ void g_zero(f32x4 (&acc)[4][4]) {
#pragma unroll
    for (int i = 0; i < 4; ++i)
#pragma unroll
        for (int j = 0; j < 4; ++j) acc[i][j] = f32x4{0.f, 0.f, 0.f, 0.f};
}
__device__ __forceinline__ void g_tilemap(int it, int nMt, int nNt, int& mt, int& nt, bool& valid) {
    const int G = gridDim.x, bid = blockIdx.x;
    if ((G & 7) == 0 && (nMt & 63) == 0) {
        const int x = bid & 7, slot = bid >> 3, nslot = G >> 3;
        const int u = it * nslot + slot;
        const int mPer = nMt >> 3;
        valid = u < mPer * nNt;
        const int SBN = (nNt % 9 == 0) ? 9 : ((nNt % 8 == 0) ? 8 : nNt);
        const int sbPerRow = nNt / SBN;
        const int sb = u / (8 * SBN), within = u % (8 * SBN);
        const int sbm = sb / sbPerRow, sbn = sb % sbPerRow;
        mt = x * mPer + sbm * 8 + within / SBN;
        nt = sbn * SBN + within % SBN;
    } else {
        const int t = it * G + bid;
        valid = t < nMt * nNt;
        mt = t / nNt; nt = t % nNt;
    }
}
#define G_EPI_LOOP(...) \
    { const int lane_ = tid & 63, w_ = tid >> 6, wm_ = w_ >> 1, wn_ = w_ & 1, lr_ = lane_ & 15, lq_ = lane_ >> 4; \
      _Pragma("unroll") for (int i = 0; i < 4; ++i) _Pragma("unroll") for (int j = 0; j < 4; ++j) { \
        const int m = m0 + wm_ * 64 + i * 16 + lr_; const int n = n0 + wn_ * 64 + j * 16 + lq_ * 4; const f32x4 v = acc[i][j]; __VA_ARGS__ } }


#define GW_STAGE 24576
__device__ __forceinline__ void gw_dma(const bf16_t* __restrict__ A, int lda, const bf16_t* __restrict__ Bt, int ldb, int m0, int n0, int k0, char* stage, int lane, int w) {
    const int rl = lane >> 2, pc = lane & 3;
    const int sc = (pc ^ ((-(rl >> 2)) & 3)) << 3;
#pragma unroll
    for (int i = 0; i < 2; ++i) {
        const int n = w * 2 + i;
        __builtin_amdgcn_global_load_lds((const unsigned*)(A + (size_t)(m0 + n * 16 + rl) * lda + k0 + sc),
                                         (__attribute__((address_space(3))) unsigned*)(lds_ptr_t)(stage + n * 1024), 16, 0, 0);
    }
#pragma unroll
    for (int i = 0; i < 4; ++i) {
        const int n = w * 4 + i;
        __builtin_amdgcn_global_load_lds((const unsigned*)(Bt + (size_t)(n0 + n * 16 + rl) * ldb + k0 + sc),
                                         (__attribute__((address_space(3))) unsigned*)(lds_ptr_t)(stage + 8192 + n * 1024), 16, 0, 0);
    }
}
__device__ __forceinline__ void gw_compute(const char* stage, f32x4 (&acc)[4][8], int wm, int wn, int lane) {
    const int lr = lane & 15, lq = lane >> 4;
    const int sw = (lq ^ ((-(lr >> 2)) & 3)) << 4;
    bf16x8 a[4], b[8];
#pragma unroll
    for (int i = 0; i < 4; ++i) a[i] = *(const bf16x8*)(stage + (wm * 64 + i * 16 + lr) * 64 + sw);
#pragma unroll
    for (int j = 0; j < 8; ++j) b[j] = *(const bf16x8*)(stage + 8192 + (wn * 128 + j * 16 + lr) * 64 + sw);
#pragma unroll
    for (int i = 0; i < 4; ++i)
#pragma unroll
        for (int j = 0; j < 8; ++j) acc[i][j] = __builtin_amdgcn_mfma_f32_16x16x32_bf16(b[j], a[i], acc[i][j], 0, 0, 0);
}
__device__ __forceinline__ void gw_kloop(const bf16_t* __restrict__ A, int lda, const bf16_t* __restrict__ Bt, int ldb, int K, int m0, int n0,
                                         char* lds, f32x4 (&acc)[4][8], int tid) {
    const int lane = tid & 63, w = __builtin_amdgcn_readfirstlane(tid >> 6), wm = w >> 1, wn = w & 1;
    const int nk = K >> 5;
    gw_dma(A, lda, Bt, ldb, m0, n0, 0, lds, lane, w);
    gw_dma(A, lda, Bt, ldb, m0, n0, 32, lds + GW_STAGE, lane, w);
    int cur = 0;
    for (int kt = 0; kt < nk; ++kt) {
        if (kt + 1 < nk) asm volatile("s_waitcnt vmcnt(6)" ::: "memory"); else asm volatile("s_waitcnt vmcnt(0)" ::: "memory");
        asm volatile("s_waitcnt lgkmcnt(0)" ::: "memory");
        __builtin_amdgcn_s_barrier();
        if (kt + 2 < nk) { int nx = cur + 2; if (nx >= 3) nx -= 3; gw_dma(A, lda, Bt, ldb, m0, n0, (kt + 2) * 32, lds + nx * GW_STAGE, lane, w); }
        gw_compute(lds + cur * GW_STAGE, acc, wm, wn, lane);
        cur = (cur == 2) ? 0 : cur + 1;
    }
    asm volatile("s_waitcnt lgkmcnt(0)" ::: "memory");
    __builtin_amdgcn_s_barrier();
}
__device__ __forceinline__ void gw_zero(f32x4 (&acc)[4][8]) {
#pragma unroll
    for (int i = 0; i < 4; ++i)
#pragma unroll
        for (int j = 0; j < 8; ++j) acc[i][j] = f32x4{0.f, 0.f, 0.f, 0.f};
}
#define GW_EPI_LOOP(...) \
    { const int lane_ = tid & 63, w_ = tid >> 6, wm_ = w_ >> 1, wn_ = w_ & 1, lr_ = lane_ & 15, lq_ = lane_ >> 4; \
      _Pragma("unroll") for (int i = 0; i < 4; ++i) _Pragma("unroll") for (int j = 0; j < 8; ++j) { \
        const int m = m0 + wm_ * 64 + i * 16 + lr_; const int n = n0 + wn_ * 128 + j * 16 + lq_ * 4; const f32x4 v = acc[i][j]; __VA_ARGS__ } }

__device__ __forceinline__ void phase_inproj(const bf16_t* __restrict__ H, const bf16_t* __restrict__ WTIN, bf16_t* Q, bf16_t* Kb, bf16_t* VT, bf16_t* U, bf16_t* SV, bf16_t* G, char* lds) {
    const int tid = threadIdx.x;
    const int nMt = NTOK / 128, nNt = IN_COLS / 256;
    for (int it = 0;; ++it) {
        int mt, nt; bool valid; g_tilemap(it, nMt, nNt, mt, nt, valid);
        if (!valid) break;
        const int m0 = mt * 128, n0 = nt * 256;
        f32x4 acc[4][8]; gw_zero(acc);
        gw_kloop(H, 1024, WTIN, 1024, 1024, m0, n0, lds, acc, tid);
        if (n0 < 512) { GW_EPI_LOOP( *(uint2*)(Q + (size_t)m * 512 + n) = pack4(v[0] * QSCALE, v[1] * QSCALE, v[2] * QSCALE, v[3] * QSCALE); ) }
        else if (n0 < 1024) { GW_EPI_LOOP( *(uint2*)(Kb + (size_t)m * 512 + n - 512) = pack4(v[0], v[1], v[2], v[3]); ) }
        else if (n0 < 1536) { GW_EPI_LOOP( *(uint2*)(VT + (size_t)m * 512 + n - 1024) = pack4(v[0], v[1], v[2], v[3]); ) }
        else if (n0 < 2048) { GW_EPI_LOOP( *(uint2*)(U + (size_t)m * 512 + n - 1536) = pack4(gelu_tanh(v[0]), gelu_tanh(v[1]), gelu_tanh(v[2]), gelu_tanh(v[3])); ) }
        else if (n0 < 2560) { GW_EPI_LOOP( *(uint2*)(SV + (size_t)m * 512 + n - 2048) = pack4(gelu_tanh(v[0]), gelu_tanh(v[1]), gelu_tanh(v[2]), gelu_tanh(v[3])); ) }
        else { GW_EPI_LOOP( *(uint2*)(G + (size_t)m * 2048 + n - 2560) = pack4(sigmoidf_(v[0]), sigmoidf_(v[1]), sigmoidf_(v[2]), sigmoidf_(v[3])); ) }
    }
}
__device__ __forceinline__ void phase_merged(const bf16_t* __restrict__ YA, const bf16_t* __restrict__ YB, const bf16_t* __restrict__ WTA, const bf16_t* __restrict__ WTB,
                             const bf16_t* __restrict__ G, bf16_t* MERGED, char* lds) {
    const int tid = threadIdx.x;
    const int nMt = NTOK / 128, nNt = 1024 / 128;
    for (int it = 0;; ++it) {
        int mt, nt; bool valid; g_tilemap(it, nMt, nNt, mt, nt, valid);
        if (!valid) break;
        const int m0 = mt * 128, n0 = nt * 128;
        f32x4 acc[4][4]; g_zero(acc);
        g_kloop(YB, 512, WTB, 512, 512, m0, n0, lds, acc, tid);
        { const int lane_ = tid & 63, w_ = tid >> 6, wm_ = w_ >> 1, wn_ = w_ & 1, lr_ = lane_ & 15, lq_ = lane_ >> 4;
#pragma unroll
          for (int i = 0; i < 4; ++i)
#pragma unroll
            for (int j = 0; j < 4; ++j) {
                const int m = m0 + wm_ * 64 + i * 16 + lr_; const int n = n0 + wn_ * 64 + j * 16 + lq_ * 4;
                const uint2 ga2 = *(const uint2*)(G + (size_t)m * 2048 + n);
                const uint2 gb2 = *(const uint2*)(G + (size_t)m * 2048 + 1024 + n);
                acc[i][j][0] *= __uint_as_float(gb2.x << 16) * __builtin_amdgcn_rcpf(fmaxf(__uint_as_float(ga2.x << 16), 1e-20f));
                acc[i][j][1] *= __uint_as_float(gb2.x & 0xffff0000u) * __builtin_amdgcn_rcpf(fmaxf(__uint_as_float(ga2.x & 0xffff0000u), 1e-20f));
                acc[i][j][2] *= __uint_as_float(gb2.y << 16) * __builtin_amdgcn_rcpf(fmaxf(__uint_as_float(ga2.y << 16), 1e-20f));
                acc[i][j][3] *= __uint_as_float(gb2.y & 0xffff0000u) * __builtin_amdgcn_rcpf(fmaxf(__uint_as_float(ga2.y & 0xffff0000u), 1e-20f));
            } }
        g_kloop(YA, 512, WTA, 512, 512, m0, n0, lds, acc, tid);
        G_EPI_LOOP( const uint2 ga2 = *(const uint2*)(G + (size_t)m * 2048 + n);
                    *(uint2*)(MERGED + (size_t)m * 1024 + n) = pack4(v[0] * fmaxf(__uint_as_float(ga2.x << 16), 1e-20f), v[1] * fmaxf(__uint_as_float(ga2.x & 0xffff0000u), 1e-20f),
                                                                      v[2] * fmaxf(__uint_as_float(ga2.y << 16), 1e-20f), v[3] * fmaxf(__uint_as_float(ga2.y & 0xffff0000u), 1e-20f)); )
    }
}
__device__ __forceinline__ void phase_outproj(const bf16_t* __restrict__ MERGED, const bf16_t* __restrict__ WTOUT, const float* __restrict__ x, const float* __restrict__ mod, float* x1, char* lds) {
    const int tid = threadIdx.x;
    const int nMt = NTOK / 128, nNt = 1024 / 256;
    for (int it = 0;; ++it) {
        int mt, nt; bool valid; g_tilemap(it, nMt, nNt, mt, nt, valid);
        if (!valid) break;
        const int m0 = mt * 128, n0 = nt * 256;
        f32x4 acc[4][8]; gw_zero(acc);
        gw_kloop(MERGED, 1024, WTOUT, 1024, 1024, m0, n0, lds, acc, tid);
        GW_EPI_LOOP( const int b = m / SEQ; const float4 g1 = *(const float4*)(mod + b * 6144 + 2048 + n);
                    const float4 xv = *(const float4*)(x + (size_t)m * 1024 + n);
                    float4 o; o.x = xv.x + g1.x * v[0]; o.y = xv.y + g1.y * v[1]; o.z = xv.z + g1.z * v[2]; o.w = xv.w + g1.w * v[3];
                    *(float4*)(x1 + (size_t)m * 1024 + n) = o; )
    }
}
__device__ __forceinline__ void phase_peerq(const bf16_t* __restrict__ H2, const bf16_t* __restrict__ WTQ, bf16_t* QP, char* lds) {
    const int tid = threadIdx.x;
    const int nMt = NTOK / 128, nNt = 2048 / 128;
    for (int it = 0;; ++it) {
        int mt, nt; bool valid; g_tilemap(it, nMt, nNt, mt, nt, valid);
        if (!valid) break;
        const int m0 = mt * 128, n0 = nt * 128;
        f32x4 acc[4][4]; g_zero(acc);
        g_kloop(H2, 1024, WTQ, 1024, 1024, m0, n0, lds, acc, tid);
        G_EPI_LOOP( *(uint2*)(QP + (size_t)m * 2048 + n) = pack4(v[0], v[1], v[2], v[3]); )
    }
}


using f32x16 = __attribute__((ext_vector_type(16))) float;
typedef short v4i16_t __attribute__((ext_vector_type(4)));
#define ATT_TILE 16384
#define ATT_LDS_BYTES (4 * ATT_TILE)

__device__ __forceinline__ void att_dma(const bf16_t* __restrict__ Kb, const bf16_t* __restrict__ V, int b, int h, int kt, char* kl, char* vl, int lane, int w) {
    const int pc = lane & 15, rl = lane >> 4;
#pragma unroll
    for (int i = 0; i < 4; ++i) {
        const int n = w * 4 + i; const int row = 4 * n + rl;
        const size_t rowoff = ((size_t)(b * SEQ + kt * 64 + row)) * 512 + h * 128;
        __builtin_amdgcn_global_load_lds((const unsigned*)(Kb + rowoff + ((pc ^ (row & 15)) << 3)), (__attribute__((address_space(3))) unsigned*)(lds_ptr_t)(kl + n * 1024), 16, 0, 0);
        __builtin_amdgcn_global_load_lds((const unsigned*)(V + rowoff + ((pc ^ ((row & 3) << 2)) << 3)), (__attribute__((address_space(3))) unsigned*)(lds_ptr_t)(vl + n * 1024), 16, 0, 0);
    }
}
__device__ __forceinline__ void att_item(int b, int h, int c, const bf16_t* __restrict__ Q, const bf16_t* __restrict__ Kb, const bf16_t* __restrict__ V,
                                         float lam, const float* __restrict__ head_g, bf16_t* __restrict__ YA, char* lds) {
    const int tid = threadIdx.x, lane = tid & 63;
    const int w = __builtin_amdgcn_readfirstlane(tid >> 6);
    const int i = w & 1, rq = w >> 1, r = lane & 31, hh = lane >> 5;
    const int tq = b * SEQ + c * 64 + rq * 32 + r;
    bf16x8 qf[4];
#pragma unroll
    for (int s = 0; s < 4; ++s) qf[s] = *(const bf16x8*)(Q + (size_t)tq * 512 + h * 128 + i * 64 + 16 * s + 8 * hh);
    f32x16 O[4];
#pragma unroll
    for (int d = 0; d < 4; ++d)
#pragma unroll
        for (int e = 0; e < 16; ++e) O[d][e] = 0.f;
    float m = -1e30f, l = 0.f;
    const int ntiles = c + 1;
    int vb[4];
    { const int li = lane & 15, g = lane >> 4, q = li >> 2, x = 2 * (g & 1) + ((li & 3) >> 1);
#pragma unroll
      for (int d = 0; d < 4; ++d) vb[d] = (4 * hh + q) * 256 + ((((d ^ q) << 2) | x) << 4) + 8 * (li & 1); }
    att_dma(Kb, V, b, h, 0, lds, lds + ATT_TILE, lane, w);
    asm volatile("s_waitcnt vmcnt(0)" ::: "memory");
    __syncthreads();
    for (int kt = 0; kt < ntiles; ++kt) {
        const char* kl = lds + (kt & 1) * (2 * ATT_TILE); const char* vl = kl + ATT_TILE;
        if (kt + 1 < ntiles) { char* nl = lds + ((kt + 1) & 1) * (2 * ATT_TILE); att_dma(Kb, V, b, h, kt + 1, nl, nl + ATT_TILE, lane, w); }
        f32x16 sacc[2];
        {
            bf16x8 kf[2][4];
#pragma unroll
            for (int k2 = 0; k2 < 2; ++k2)
#pragma unroll
                for (int s = 0; s < 4; ++s) {
                    const int krow = k2 * 32 + r; const int kch = i * 8 + 2 * s + hh;
                    kf[k2][s] = *(const bf16x8*)(kl + krow * 256 + ((kch ^ (krow & 15)) << 4));
                }
#pragma unroll
            for (int k2 = 0; k2 < 2; ++k2) {
#pragma unroll
                for (int e = 0; e < 16; ++e) sacc[k2][e] = 0.f;
#pragma unroll
                for (int s = 0; s < 4; ++s) sacc[k2] = __builtin_amdgcn_mfma_f32_32x32x16_bf16(kf[k2][s], qf[s], sacc[k2], 0, 0, 0);
            }
        }
        float mx = sacc[0][0];
#pragma unroll
        for (int e = 1; e < 16; ++e) mx = fmaxf(mx, sacc[0][e]);
#pragma unroll
        for (int e = 0; e < 16; ++e) mx = fmaxf(mx, sacc[1][e]);
        mx = fmaxf(mx, __shfl_xor(mx, 32));
        const float mn = fmaxf(m, mx);
        const float alpha = __builtin_amdgcn_exp2f(m - mn);
        m = mn;
        float ls = 0.f;
#pragma unroll
        for (int k2 = 0; k2 < 2; ++k2)
#pragma unroll
            for (int e = 0; e < 16; ++e) { const float p = __builtin_amdgcn_exp2f(sacc[k2][e] - mn); sacc[k2][e] = p; ls += p; }
        l = l * alpha + ls;
        if (__any(alpha != 1.0f)) {
#pragma unroll
            for (int d = 0; d < 4; ++d)
#pragma unroll
                for (int e = 0; e < 16; ++e) O[d][e] *= alpha;
        }
        bf16x8 pf[2][2];
#pragma unroll
        for (int k2 = 0; k2 < 2; ++k2)
#pragma unroll
            for (int s2 = 0; s2 < 2; ++s2) {
                union { uint4 u; bf16x8 v; } cp;
                cp.u = make_uint4(pack2(sacc[k2][8 * s2 + 0], sacc[k2][8 * s2 + 1]), pack2(sacc[k2][8 * s2 + 2], sacc[k2][8 * s2 + 3]),
                                  pack2(sacc[k2][8 * s2 + 4], sacc[k2][8 * s2 + 5]), pack2(sacc[k2][8 * s2 + 6], sacc[k2][8 * s2 + 7]));
                pf[k2][s2] = cp.v;
            }
#define ATT_VREAD(dst, st) { const lds_ptr_t vp_ = (lds_ptr_t)(vl + vb[(st) >> 2]); const int kb_ = (((st) >> 1) & 1) * 32 + ((st) & 1) * 16; \
            const v4i16_t lo_ = __builtin_amdgcn_ds_read_tr16_b64_v4i16((__attribute__((address_space(3))) v4i16_t*)(vp_ + kb_ * 256)); \
            const v4i16_t hi_ = __builtin_amdgcn_ds_read_tr16_b64_v4i16((__attribute__((address_space(3))) v4i16_t*)(vp_ + kb_ * 256 + 2048)); \
            dst = (bf16x8){lo_[0], lo_[1], lo_[2], lo_[3], hi_[0], hi_[1], hi_[2], hi_[3]}; }
        {
            bf16x8 vcur, vnxt;
            ATT_VREAD(vcur, 0)
#pragma unroll
            for (int st = 0; st < 16; ++st) {
                if (st + 1 < 16) ATT_VREAD(vnxt, st + 1)
                O[st >> 2] = __builtin_amdgcn_mfma_f32_32x32x16_bf16(vcur, pf[(st >> 1) & 1][st & 1], O[st >> 2], 0, 0, 0);
                vcur = vnxt;
            }
        }
        asm volatile("s_waitcnt vmcnt(0)" ::: "memory");
        __syncthreads();
    }
    const float ltot = l + __shfl_xor(l, 32);
    const float inv = 1.0f / ltot;
    float* ex = (float*)lds;
    if (i == 1) {
        const float sc = inv * lam;
#pragma unroll
        for (int d = 0; d < 4; ++d)
#pragma unroll
            for (int e = 0; e < 16; ++e) { const int dv = d * 32 + (e & 3) + 8 * (e >> 2) + 4 * hh; ex[(rq * 128 + dv) * 32 + r] = O[d][e] * sc; }
    }
    __syncthreads();
    if (i == 0) {
        float ss = 0.f;
#pragma unroll
        for (int d = 0; d < 4; ++d)
#pragma unroll
            for (int e = 0; e < 16; ++e) { const int dv = d * 32 + (e & 3) + 8 * (e >> 2) + 4 * hh; const float o = O[d][e] * inv - ex[(rq * 128 + dv) * 32 + r]; O[d][e] = o; ss += o * o; }
        ss += __shfl_xor(ss, 32);
        const float rn = rsqrtf(ss * (1.0f / 128.0f) + EPS) * 0.8f;
#pragma unroll
        for (int d = 0; d < 4; ++d)
#pragma unroll
            for (int g = 0; g < 4; ++g) {
                const int dv = d * 32 + 8 * g + 4 * hh;
                const float4 hg = *(const float4*)(head_g + dv);
                *(uint2*)(YA + (size_t)tq * 512 + h * 128 + dv) = pack4(O[d][4 * g] * rn * hg.x, O[d][4 * g + 1] * rn * hg.y, O[d][4 * g + 2] * rn * hg.z, O[d][4 * g + 3] * rn * hg.w);
            }
    }
    __syncthreads();
}
__device__ __forceinline__ void phase_attn(const bf16_t* __restrict__ Q, const bf16_t* __restrict__ Kb, const bf16_t* __restrict__ V, const float* __restrict__ ctl,
                           const float* __restrict__ head_g, bf16_t* __restrict__ YA, char* lds) {
    const float lam = ctl[0];
    const int G = gridDim.x, bid = blockIdx.x;
    if (G == 512) {
        const int x = bid & 7, slot = bid >> 3; const int ph = x + 8 * (slot & 1); const int s = slot >> 1;
#pragma unroll 1
        for (int it = 0; it < 4; ++it) {
            const int c = (it == 0) ? 127 - s : (it == 1) ? 64 + s : (it == 2) ? 63 - s : s;
            att_item(ph >> 2, ph & 3, c, Q, Kb, V, lam, head_g, YA, lds);
        }
    } else {
#pragma unroll 1
        for (int it = 0;; ++it) {
            const int rho = (it & 1) ? it * G + (G - 1 - bid) : it * G + bid;
            if (rho >= 2048) { if (it * G >= 2048) break; else continue; }
            const int c = 127 - (rho >> 4); const int ph = rho & 15;
            att_item(ph >> 2, ph & 3, c, Q, Kb, V, lam, head_g, YA, lds);
        }
    }
}


#define SGU_LDS_BYTES (65536 + 1024)
__device__ __forceinline__ void phase_sgu(const bf16_t* __restrict__ U, const bf16_t* __restrict__ SV, const float* __restrict__ ln_g, const float* __restrict__ ln_b,
                          const float* __restrict__ sg_w, const float* __restrict__ sg_b, bf16_t* __restrict__ YB, char* lds) {
    const int tid = threadIdx.x, lane = tid & 63, w = tid >> 6, wm = w >> 1, wn = w & 1, lr = lane & 15, lq = lane >> 4;
    float* st_mu = (float*)(lds + 65536); float* st_rs = st_mu + 128;
    char* Wl = lds; char* Sl = lds + 32768;
    for (int item = blockIdx.x; item < (NTOK / 128) * 4; item += gridDim.x) {
        const int g = item & 3, nb = item >> 2; const int t0 = nb * 128;
        for (int r0 = 0; r0 < 32; r0 += 8) {
            uint4 v8[8];
#pragma unroll
            for (int u = 0; u < 8; ++u) v8[u] = *(const uint4*)(SV + (size_t)(t0 + w * 32 + r0 + u) * 512 + lane * 8);
#pragma unroll
            for (int u = 0; u < 8; ++u) {
                const int row = w * 32 + r0 + u; const uint4 v = v8[u];
                float f[8] = {__uint_as_float(v.x << 16), __uint_as_float(v.x & 0xffff0000u), __uint_as_float(v.y << 16), __uint_as_float(v.y & 0xffff0000u),
                              __uint_as_float(v.z << 16), __uint_as_float(v.z & 0xffff0000u), __uint_as_float(v.w << 16), __uint_as_float(v.w & 0xffff0000u)};
                float s = 0.f;
#pragma unroll
                for (int j = 0; j < 8; ++j) s += f[j];
                for (int o = 32; o > 0; o >>= 1) s += __shfl_xor(s, o);
                const float mu = s * (1.0f / 512.0f);
                float q = 0.f;
#pragma unroll
                for (int j = 0; j < 8; ++j) { const float d = f[j] - mu; q += d * d; }
                for (int o = 32; o > 0; o >>= 1) q += __shfl_xor(q, o);
                if (lane == 0) { st_mu[row] = mu; st_rs[row] = rsqrtf(q * (1.0f / 512.0f) + EPS); }
            }
        }
        { const int c16 = tid & 15, r0 = tid >> 4;
#pragma unroll
          for (int i = 0; i < 8; ++i) {
              const int p = r0 + 16 * i;
              const float* wp = sg_w + ((size_t)g * 128 + p) * 128 + c16 * 8;
              float4 a = *(const float4*)wp, b = *(const float4*)(wp + 4);
              if (p < 64 && c16 >= 8) { a = make_float4(0.f, 0.f, 0.f, 0.f); b = a; }
              *(uint4*)(Wl + p * 256 + ((c16 ^ (p & 15)) << 4)) = make_uint4(pack2(a.x, a.y), pack2(a.z, a.w), pack2(b.x, b.y), pack2(b.z, b.w));
          } }
        __syncthreads();
        { const int pr = tid & 63;
#pragma unroll
          for (int it = 0; it < 4; ++it) {
              const int ch = (tid >> 6) + 4 * it;
              const int q0 = 2 * pr;
              const uint4 va = *(const uint4*)(SV + (size_t)(t0 + q0) * 512 + g * 128 + ch * 8);
              const uint4 vb = *(const uint4*)(SV + (size_t)(t0 + q0 + 1) * 512 + g * 128 + ch * 8);
              const float mua = st_mu[q0], rsa = st_rs[q0], mub = st_mu[q0 + 1], rsb = st_rs[q0 + 1];
              const unsigned ua[4] = {va.x, va.y, va.z, va.w}, ub[4] = {vb.x, vb.y, vb.z, vb.w};
#pragma unroll
              for (int e = 0; e < 8; ++e) {
                  const int c = ch * 8 + e;
                  const float lg = ln_g[g * 128 + c], lb = ln_b[g * 128 + c];
                  const float xa = (e & 1) ? __uint_as_float(ua[e >> 1] & 0xffff0000u) : __uint_as_float(ua[e >> 1] << 16);
                  const float xb = (e & 1) ? __uint_as_float(ub[e >> 1] & 0xffff0000u) : __uint_as_float(ub[e >> 1] << 16);
                  const float na = (xa - mua) * rsa * lg + lb, nb2 = (xb - mub) * rsb * lg + lb;
                  *(unsigned*)(Sl + c * 256 + (((q0 >> 3) ^ (c & 15)) << 4) + (q0 & 7) * 2) = pack2(na, nb2);
              }
          } }
        __syncthreads();
        f32x4 acc[4][4]; g_zero(acc);
        const int nks = (wm == 0) ? 2 : 4;
        for (int ks = 0; ks < nks; ++ks) {
            const int sw = (((ks * 4 + lq) ^ lr) << 4);
            bf16x8 a[4], b[4];
#pragma unroll
            for (int i = 0; i < 4; ++i) a[i] = *(const bf16x8*)(Wl + (wm * 64 + i * 16 + lr) * 256 + sw);
#pragma unroll
            for (int j = 0; j < 4; ++j) b[j] = *(const bf16x8*)(Sl + (wn * 64 + j * 16 + lr) * 256 + sw);
#pragma unroll
            for (int i = 0; i < 4; ++i)
#pragma unroll
                for (int j = 0; j < 4; ++j) acc[i][j] = __builtin_amdgcn_mfma_f32_16x16x32_bf16(b[j], a[i], acc[i][j], 0, 0, 0);
        }
#pragma unroll
        for (int i = 0; i < 4; ++i)
#pragma unroll
            for (int j = 0; j < 4; ++j) {
                const int p = wm * 64 + i * 16 + lr; const int c = wn * 64 + j * 16 + lq * 4;
                const float bias = sg_b[g * 128 + p];
                const size_t o = (size_t)(t0 + p) * 512 + g * 128 + c;
                const uint2 uu = *(const uint2*)(U + o);
                *(uint2*)(YB + o) = pack4(__uint_as_float(uu.x << 16) * (acc[i][j][0] + bias), __uint_as_float(uu.x & 0xffff0000u) * (acc[i][j][1] + bias),
                                          __uint_as_float(uu.y << 16) * (acc[i][j][2] + bias), __uint_as_float(uu.y & 0xffff0000u) * (acc[i][j][3] + bias));
            }
        __syncthreads();
    }
}

#define CE_DESC(a, b) { const unsigned t_ = (a) > (b) ? (a) : (b); b = (a) > (b) ? (b) : (a); a = t_; }
__device__ __forceinline__ unsigned f2key(float f) { const unsigned u = __float_as_uint(f); return (u & 0x80000000u) ? ~u : (u | 0x80000000u); }
__device__ __forceinline__ float key2f(unsigned k) { const unsigned u = (k & 0x80000000u) ? (k & 0x7fffffffu) : ~k; return __uint_as_float(u); }
template <int N> __device__ __forceinline__ void bitonic_sort_desc(unsigned (&a)[N]) {
#pragma unroll
    for (int k = 2; k <= N; k <<= 1)
#pragma unroll
        for (int j = k >> 1; j > 0; j >>= 1)
#pragma unroll
            for (int i = 0; i < N; ++i) {
                const int l = i ^ j;
                if (l > i) { if ((i & k) == 0) { CE_DESC(a[i], a[l]) } else { CE_DESC(a[l], a[i]) } }
            }
}
template <int N> __device__ __forceinline__ void bitonic_merge_desc(unsigned (&a)[N]) {
#pragma unroll
    for (int j = N >> 1; j > 0; j >>= 1)
#pragma unroll
        for (int i = 0; i < N; ++i) { const int l = i ^ j; if (l > i) { CE_DESC(a[i], a[l]) } }
}
__device__ __forceinline__ void merge_top16(unsigned (&a)[16], const unsigned (&b)[16]) {
#pragma unroll
    for (int i = 0; i < 16; ++i) a[i] = a[i] > b[15 - i] ? a[i] : b[15 - i];
    bitonic_merge_desc<16>(a);
}
__device__ __forceinline__ void xlane_merge_top16(unsigned (&a)[16], int xmask) {
    unsigned b[16];
#pragma unroll
    for (int i = 0; i < 16; ++i) b[i] = (unsigned)__shfl_xor((int)a[i], xmask);
    merge_top16(a, b);
}
__device__ __forceinline__ void phase_peer_select(const bf16_t* __restrict__ H2, const bf16_t* __restrict__ WTQ, const bf16_t* __restrict__ SUBK,
                                  int* __restrict__ EIDX, float* __restrict__ GW, char* lds) {
    const int tid = threadIdx.x, lane = tid & 63, w = tid >> 6, wm = w >> 1, wn = w & 1, lr = lane & 15, lq = lane >> 4;
    const int G = gridDim.x;
    for (int u = blockIdx.x; u < (NTOK / 128) * 8; u += G) {
        const int h = u & 7, mt = u >> 3; const int m0 = mt * 128;
        unsigned* Ll = (unsigned*)(lds + 65536);
#pragma unroll 1
        for (int p = 0; p < 2; ++p) {
            f32x4 acc[4][4]; g_zero(acc);
            g_kloop(H2, 1024, WTQ + (size_t)(h * 256 + p * 128) * 1024, 1024, 1024, m0, 0, lds, acc, tid);
#pragma unroll
            for (int i = 0; i < 4; ++i)
#pragma unroll
                for (int j = 0; j < 4; ++j) {
                    const int tok = wm * 64 + i * 16 + lr; const int d = wn * 64 + j * 16 + lq * 4;
                    *(uint2*)(lds + tok * 256 + (((d >> 3) ^ (tok & 15)) << 4) + (d & 7) * 2) = pack4(acc[i][j][0], acc[i][j][1], acc[i][j][2], acc[i][j][3]);
                }
            { const int c16 = tid & 15, r0 = tid >> 4; const bf16_t* kp = SUBK + (size_t)(h * 2 + p) * 128 * 128;
#pragma unroll
              for (int i = 0; i < 8; ++i) { const int row = r0 + 16 * i; *(uint4*)(lds + 32768 + row * 256 + ((c16 ^ (row & 15)) << 4)) = *(const uint4*)(kp + row * 128 + c16 * 8); } }
            __syncthreads();
            f32x4 sc[2][8];
#pragma unroll
            for (int tt = 0; tt < 2; ++tt)
#pragma unroll
                for (int kt = 0; kt < 8; ++kt) sc[tt][kt] = f32x4{0.f, 0.f, 0.f, 0.f};
#pragma unroll
            for (int ks = 0; ks < 4; ++ks) {
                const int sw = (((ks * 4 + lq) ^ lr) << 4);
                bf16x8 qb[2], ka[8];
#pragma unroll
                for (int tt = 0; tt < 2; ++tt) qb[tt] = *(const bf16x8*)(lds + (w * 32 + tt * 16 + lr) * 256 + sw);
#pragma unroll
                for (int kt = 0; kt < 8; ++kt) ka[kt] = *(const bf16x8*)(lds + 32768 + (kt * 16 + lr) * 256 + sw);
#pragma unroll
                for (int tt = 0; tt < 2; ++tt)
#pragma unroll
                    for (int kt = 0; kt < 8; ++kt) sc[tt][kt] = __builtin_amdgcn_mfma_f32_16x16x32_bf16(ka[kt], qb[tt], sc[tt][kt], 0, 0, 0);
            }
            __syncthreads();
#pragma unroll
            for (int tt = 0; tt < 2; ++tt) {
                __builtin_amdgcn_sched_barrier(0);
                unsigned lo[16], hi[16];
#pragma unroll
                for (int kt = 0; kt < 4; ++kt)
#pragma unroll
                    for (int r = 0; r < 4; ++r) {
                        lo[kt * 4 + r] = (f2key(sc[tt][kt][r]) & ~0x7Fu) | (unsigned)(127 - (kt * 16 + lq * 4 + r));
                        hi[kt * 4 + r] = (f2key(sc[tt][kt + 4][r]) & ~0x7Fu) | (unsigned)(127 - ((kt + 4) * 16 + lq * 4 + r));
                    }
                bitonic_sort_desc<16>(lo); bitonic_sort_desc<16>(hi);
                merge_top16(lo, hi);
                xlane_merge_top16(lo, 16); xlane_merge_top16(lo, 32);
                if (lq == 0) {
                    uint4* dst = (uint4*)(Ll + (w * 32 + tt * 16 + lr) * 32 + p * 16);
                    dst[0] = make_uint4(lo[0], lo[1], lo[2], lo[3]); dst[1] = make_uint4(lo[4], lo[5], lo[6], lo[7]);
                    dst[2] = make_uint4(lo[8], lo[9], lo[10], lo[11]); dst[3] = make_uint4(lo[12], lo[13], lo[14], lo[15]);
                }
            }
        }
        __syncthreads();
#pragma unroll
        for (int tt = 0; tt < 2; ++tt) {
            __builtin_amdgcn_sched_barrier(0);
            const int tokl = w * 32 + tt * 16 + lr;
            float v0[16], v1[16];
            { const uint4* sp = (const uint4*)(Ll + tokl * 32);
#pragma unroll
              for (int q = 0; q < 4; ++q) {
                  const uint4 a = sp[q], b = sp[4 + q];
                  v0[q * 4] = key2f(a.x & ~0x7Fu); v0[q * 4 + 1] = key2f(a.y & ~0x7Fu); v0[q * 4 + 2] = key2f(a.z & ~0x7Fu); v0[q * 4 + 3] = key2f(a.w & ~0x7Fu);
                  v1[q * 4] = key2f(b.x & ~0x7Fu); v1[q * 4 + 1] = key2f(b.y & ~0x7Fu); v1[q * 4 + 2] = key2f(b.z & ~0x7Fu); v1[q * 4 + 3] = key2f(b.w & ~0x7Fu);
              } }
            unsigned c2[16];
#pragma unroll
            for (int r = 0; r < 16; ++r) c2[r] = 0u;
#define CAND(slot, a, b) c2[slot] = (f2key(v0[a] + v1[b]) & ~0xFFu) | (unsigned)(255 - ((a) * 16 + (b)))
            if (lq == 0) {
                CAND(0, 0, 0); CAND(1, 0, 1); CAND(2, 0, 2); CAND(3, 0, 3); CAND(4, 0, 4); CAND(5, 0, 5); CAND(6, 0, 6); CAND(7, 0, 7);
                CAND(8, 0, 8); CAND(9, 0, 9); CAND(10, 0, 10); CAND(11, 0, 11); CAND(12, 0, 12); CAND(13, 0, 13); CAND(14, 0, 14); CAND(15, 0, 15);
            } else if (lq == 1) {
                CAND(0, 8, 0); CAND(1, 9, 0); CAND(2, 10, 0); CAND(3, 11, 0); CAND(4, 12, 0); CAND(5, 13, 0); CAND(6, 14, 0); CAND(7, 15, 0);
                CAND(8, 1, 0); CAND(9, 1, 1); CAND(10, 1, 2); CAND(11, 1, 3); CAND(12, 1, 4); CAND(13, 1, 5); CAND(14, 1, 6); CAND(15, 1, 7);
            } else if (lq == 2) {
                CAND(0, 2, 0); CAND(1, 2, 1); CAND(2, 2, 2); CAND(3, 2, 3); CAND(4, 2, 4); CAND(5, 3, 0); CAND(6, 3, 1); CAND(7, 3, 2);
                CAND(8, 3, 3); CAND(9, 4, 0); CAND(10, 4, 1); CAND(11, 4, 2); CAND(12, 5, 0); CAND(13, 5, 1);
            } else {
                CAND(0, 6, 0); CAND(1, 6, 1); CAND(2, 7, 0); CAND(3, 7, 1);
            }
#undef CAND
            bitonic_sort_desc<16>(c2);
            xlane_merge_top16(c2, 16); xlane_merge_top16(c2, 32);
            if (lq == 0) {
                float s[16]; int ei[16];
#pragma unroll
                for (int r = 0; r < 16; ++r) {
                    const unsigned code = 255u - (c2[r] & 0xFFu);
                    const unsigned k0 = Ll[tokl * 32 + (code >> 4)], k1 = Ll[tokl * 32 + 16 + (code & 15u)];
                    s[r] = key2f(k0 & ~0x7Fu) + key2f(k1 & ~0x7Fu);
                    ei[r] = (int)((127u - (k0 & 0x7Fu)) * 128u + (127u - (k1 & 0x7Fu)));
                }
                float mx = s[0];
#pragma unroll
                for (int r = 1; r < 16; ++r) mx = fmaxf(mx, s[r]);
                float sum = 0.f;
#pragma unroll
                for (int r = 0; r < 16; ++r) { s[r] = __expf(s[r] - mx); sum += s[r]; }
                const float inv = 1.0f / sum;
                const size_t o = ((size_t)(m0 + tokl) * 8 + h) * 16;
#pragma unroll
                for (int r = 0; r < 16; r += 4) {
                    *(int4*)(EIDX + o + r) = make_int4(ei[r], ei[r + 1], ei[r + 2], ei[r + 3]);
                    *(float4*)(GW + o + r) = make_float4(s[r] * inv, s[r + 1] * inv, s[r + 2] * inv, s[r + 3] * inv);
                }
            }
        }
        __syncthreads();
    }
}

#define DPP_ADD(r, ctrl) r += __builtin_bit_cast(float, __builtin_amdgcn_update_dpp(0, __builtin_bit_cast(int, r), ctrl, 0xf, 0xf, false))
__device__ __forceinline__ float dot8(const uint4& a, const uint4& b, float acc) {
    acc = __builtin_amdgcn_fdot2_f32_bf16(__builtin_bit_cast(bf16v2_t, a.x), __builtin_bit_cast(bf16v2_t, b.x), acc, false);
    acc = __builtin_amdgcn_fdot2_f32_bf16(__builtin_bit_cast(bf16v2_t, a.y), __builtin_bit_cast(bf16v2_t, b.y), acc, false);
    acc = __builtin_amdgcn_fdot2_f32_bf16(__builtin_bit_cast(bf16v2_t, a.z), __builtin_bit_cast(bf16v2_t, b.z), acc, false);
    acc = __builtin_amdgcn_fdot2_f32_bf16(__builtin_bit_cast(bf16v2_t, a.w), __builtin_bit_cast(bf16v2_t, b.w), acc, false);
    return acc;
}
#define PE_LDS_BYTES (65536 + 256)
__device__ __forceinline__ void phase_peer_expert(const unsigned char* __restrict__ HQ, const float* __restrict__ HSC, const int* __restrict__ EIDX, const float* __restrict__ GW,
                                  const unsigned char* __restrict__ DOWNQ, const unsigned char* __restrict__ UPQ, const float* __restrict__ DSC, const float* __restrict__ USC,
                                  const float* __restrict__ mod, const float* __restrict__ final_g, const float* x1src, float* __restrict__ X2, float* out, char* lds) {
    const int tid = threadIdx.x, lane = tid & 63, w = tid >> 6;
    const int r8 = lane >> 3, cp8 = lane & 7;
    int* eid_l = (int*)(lds + w * 16384);
    int* part_l = (int*)(lds + w * 16384 + 8192);
    float* w_l = (float*)part_l;
    float* ssq_l = (float*)(lds + 65536 + w * 64);
    const int nwaves = gridDim.x * 4;
    const int tpw = (NTOK + nwaves - 1) / nwaves;
    const int t_begin = (blockIdx.x * 4 + w) * tpw;
    for (int base = 0; base < tpw; base += 16) {
        const int t0 = t_begin + base;
        int nt = tpw - base; if (nt > 16) nt = 16; if (t0 + nt > NTOK) nt = NTOK - t0; if (nt < 0) nt = 0;
#pragma unroll 4
        for (int i = 0; i < nt; ++i) { eid_l[i * 128 + (lane & 7) * 16 + (lane >> 3)] = EIDX[(size_t)(t0 + i) * 128 + lane]; eid_l[i * 128 + (lane & 7) * 16 + 8 + (lane >> 3)] = EIDX[(size_t)(t0 + i) * 128 + 64 + lane];
                                       part_l[i * 128 + lane] = 0; part_l[i * 128 + 64 + lane] = 0; }
        if (lane < 16) ssq_l[lane] = 0.f;
        __syncthreads();
#pragma unroll 1
        for (int s = 0; s < 8; ++s) {
#pragma unroll 1
            for (int i = 0; i < nt; ++i) {
                const uint4 hq = *(const uint4*)(HQ + (size_t)(t0 + i) * 1024 + s * 128 + cp8 * 16);
                int ev[16];
#pragma unroll
                for (int q = 0; q < 4; ++q) { const int4 e4 = *(const int4*)(eid_l + i * 128 + r8 * 16 + q * 4); ev[q * 4] = e4.x; ev[q * 4 + 1] = e4.y; ev[q * 4 + 2] = e4.z; ev[q * 4 + 3] = e4.w; }
                uint4 dv[16];
#pragma unroll
                for (int j = 0; j < 16; ++j) dv[j] = *(const uint4*)(DOWNQ + (size_t)s * (16384 * 128) + (size_t)ev[j] * 128 + cp8 * 16);
                int res[16];
#pragma unroll
                for (int j = 0; j < 16; ++j) {
                    int sm = __builtin_amdgcn_sdot4((int)dv[j].x, (int)hq.x, 0, false);
                    sm = __builtin_amdgcn_sdot4((int)dv[j].y, (int)hq.y, sm, false);
                    sm = __builtin_amdgcn_sdot4((int)dv[j].z, (int)hq.z, sm, false);
                    sm = __builtin_amdgcn_sdot4((int)dv[j].w, (int)hq.w, sm, false);
                    sm += __builtin_amdgcn_update_dpp(0, sm, 0xB1, 0xf, 0xf, false);
                    sm += __builtin_amdgcn_update_dpp(0, sm, 0x4E, 0xf, 0xf, false);
                    sm += __builtin_amdgcn_update_dpp(0, sm, 0x141, 0xf, 0xf, false);
                    res[j] = sm;
                }
                if (cp8 == 0) {
                    int4* pp = (int4*)(part_l + i * 128 + r8 * 16);
#pragma unroll
                    for (int q = 0; q < 4; ++q) { int4 p4 = pp[q]; p4.x += res[q * 4]; p4.y += res[q * 4 + 1]; p4.z += res[q * 4 + 2]; p4.w += res[q * 4 + 3]; pp[q] = p4; }
                }
            }
        }
        __syncthreads();
#pragma unroll 4
        for (int i = 0; i < nt; ++i) {
            const float hs = HSC[t0 + i];
#pragma unroll
            for (int hf = 0; hf < 2; ++hf) {
                const int q = hf * 64 + lane; const int k = (q & 15) * 8 + (q >> 4); const int e = eid_l[i * 128 + q];
                const float a = (float)part_l[i * 128 + q] * hs * DSC[e];
                w_l[i * 128 + q] = GW[(size_t)(t0 + i) * 128 + k] * gelu_tanh(a) * USC[e];
            }
        }
        __syncthreads();
#pragma unroll 1
        for (int s = 0; s < 8; ++s) {
#pragma unroll 1
            for (int ib = 0; ib < nt; ib += 8) {
                const int il = (ib + r8 < nt) ? ib + r8 : nt - 1;
                const int t = t0 + il; const int b = t / SEQ;
                const int c0 = s * 128 + cp8 * 16;
                float4 xv4[4], g24[4];
#pragma unroll
                for (int q4 = 0; q4 < 4; ++q4) { xv4[q4] = *(const float4*)(x1src + (size_t)t * 1024 + c0 + q4 * 4); g24[q4] = *(const float4*)(mod + b * 6144 + 5120 + c0 + q4 * 4); }
                f32x2_t a2[8];
#pragma unroll
                for (int c = 0; c < 8; ++c) a2[c] = f32x2_t{0.f, 0.f};
                const unsigned char* ubase = UPQ + (size_t)s * (16384 * 128) + cp8 * 16;
#pragma unroll 1
                for (int q0 = 0; q0 < 128; q0 += 16) {
                    int ev[16]; float wv[16];
#pragma unroll
                    for (int q = 0; q < 4; ++q) {
                        const int4 e4 = *(const int4*)(eid_l + il * 128 + q0 + q * 4); ev[q * 4] = e4.x; ev[q * 4 + 1] = e4.y; ev[q * 4 + 2] = e4.z; ev[q * 4 + 3] = e4.w;
                        const float4 w4 = *(const float4*)(w_l + il * 128 + q0 + q * 4); wv[q * 4] = w4.x; wv[q * 4 + 1] = w4.y; wv[q * 4 + 2] = w4.z; wv[q * 4 + 3] = w4.w;
                    }
                    uint4 uv[16];
#pragma unroll
                    for (int j = 0; j < 16; ++j) uv[j] = *(const uint4*)(ubase + (size_t)ev[j] * 128);
#pragma unroll
                    for (int j = 0; j < 16; ++j) {
                        const f32x2_t wk2 = {wv[j], wv[j]};
                        const unsigned uu[4] = {uv[j].x, uv[j].y, uv[j].z, uv[j].w};
#pragma unroll
                        for (int q = 0; q < 4; ++q) {
                            a2[2 * q] = wk2 * __builtin_amdgcn_cvt_pk_f32_fp8((int)uu[q], false) + a2[2 * q];
                            a2[2 * q + 1] = wk2 * __builtin_amdgcn_cvt_pk_f32_fp8((int)uu[q], true) + a2[2 * q + 1];
                        }
                    }
                }
                float sq = 0.f;
#pragma unroll
                for (int q4 = 0; q4 < 4; ++q4) {
                    float4 r; r.x = xv4[q4].x + g24[q4].x * a2[2 * q4][0]; r.y = xv4[q4].y + g24[q4].y * a2[2 * q4][1];
                    r.z = xv4[q4].z + g24[q4].z * a2[2 * q4 + 1][0]; r.w = xv4[q4].w + g24[q4].w * a2[2 * q4 + 1][1];
                    sq += r.x * r.x + r.y * r.y + r.z * r.z + r.w * r.w;
                    if (ib + r8 < nt) *(float4*)(X2 + (size_t)t * 1024 + c0 + q4 * 4) = r;
                }
                sq += __builtin_bit_cast(float, __builtin_amdgcn_update_dpp(0, __builtin_bit_cast(int, sq), 0xB1, 0xf, 0xf, false));
                sq += __builtin_bit_cast(float, __builtin_amdgcn_update_dpp(0, __builtin_bit_cast(int, sq), 0x4E, 0xf, 0xf, false));
                sq += __builtin_bit_cast(float, __builtin_amdgcn_update_dpp(0, __builtin_bit_cast(int, sq), 0x141, 0xf, 0xf, false));
                if (cp8 == 0 && ib + r8 < nt) ssq_l[il] += sq;
            }
        }
        asm volatile("s_waitcnt vmcnt(0)" ::: "memory");
        __syncthreads();
#pragma unroll 4
        for (int i = 0; i < nt; ++i) {
            const int t = t0 + i;
            const float rn = rsqrtf(ssq_l[i] * (1.0f / 1024.0f) + EPS);
#pragma unroll
            for (int q4 = 0; q4 < 4; ++q4) {
                const int c = q4 * 256 + lane * 4;
                const float4 xv = *(const float4*)(X2 + (size_t)t * 1024 + c);
                const float4 fg = *(const float4*)(final_g + c);
                float4 r; r.x = xv.x * rn * fg.x; r.y = xv.y * rn * fg.y; r.z = xv.z * rn * fg.z; r.w = xv.w * rn * fg.w;
                *(float4*)(out + (size_t)t * 1024 + c) = r;
            }
        }
        __syncthreads();
    }
}


#define XB_TMO      128
#define XB_XCNT(j)  (256  + 64 * (j))
#define XB_XSUB(j)  (1280 + 64 * (j))
#define XB_XGEN(j)  (2304 + 64 * (j))
#define XB_TOP      3328
#define XB_TOPGEN   3392
#define XCD_BAR_WORDS 3456
#define XB_SPIN_CAP (1u << 22)
__device__ __forceinline__ unsigned xb_ld(unsigned* p)              { return __hip_atomic_load(p, __ATOMIC_RELAXED, __HIP_MEMORY_SCOPE_AGENT); }
__device__ __forceinline__ unsigned xb_add(unsigned* p, unsigned v) { return __hip_atomic_fetch_add(p, v, __ATOMIC_RELAXED, __HIP_MEMORY_SCOPE_AGENT); }
__device__ __forceinline__ unsigned xb_xcc_id() { return (unsigned)__builtin_amdgcn_s_getreg((3 << 11) | 20) & 0xFu; }
#define XB_SPIN(cond, bar) do { unsigned _sp = 0; while (cond) { __builtin_amdgcn_s_sleep(1); \
    if ((++_sp & 255u) == 0u) { if (xb_ld(&(bar)[XB_TMO])) break; if (_sp > XB_SPIN_CAP) { atomicAdd(&(bar)[XB_TMO], 1u); break; } } } } while (0)
struct XcdBarrier { unsigned* bar; unsigned x; unsigned nloc; unsigned nx; };
__device__ __forceinline__ void xcd_barrier_post(XcdBarrier& b, unsigned* bar) {
    b.bar = bar; b.x = xb_xcc_id(); b.nloc = 0u; b.nx = 0u;
    if (threadIdx.x == 0) (void)xb_add(&bar[XB_XCNT(b.x)], 1u);
}
__device__ __forceinline__ void xcd_barrier_complete(unsigned* bar, unsigned x, unsigned& nloc, unsigned& nx) {
    const unsigned G = gridDim.x;
    unsigned sum, cnt, mine, sp = 0u;
    for (;;) {
        sum = 0u; cnt = 0u; mine = 0u;
#pragma unroll
        for (unsigned j = 0; j < 16; ++j) { const unsigned c = xb_ld(&bar[XB_XCNT(j)]); sum += c; cnt += (c > 0u) ? 1u : 0u; mine = (j == x) ? c : mine; }
        if (sum == G) break;
        __builtin_amdgcn_s_sleep(1);
        if ((++sp & 255u) == 0u) { if (xb_ld(&bar[XB_TMO])) break; if (sp > XB_SPIN_CAP) { atomicAdd(&bar[XB_TMO], 1u); break; } }
    }
    nloc = mine > 0u ? mine : 1u; nx = cnt > 0u ? cnt : 1u;
}
__device__ __forceinline__ void xcd_barrier(XcdBarrier& b) {
    asm volatile("s_waitcnt vmcnt(0)" ::: "memory");
    __syncthreads();
    if (threadIdx.x == 0) {
        unsigned* bar = b.bar;
        __builtin_amdgcn_s_waitcnt(0);
        if (b.nloc == 0u) xcd_barrier_complete(bar, b.x, b.nloc, b.nx);
        const unsigned nloc = b.nloc, nx = b.nx;
        const unsigned old = xb_add(&bar[XB_XSUB(b.x)], 1u);
        const unsigned gen = old / nloc;
        if (old + 1u == (gen + 1u) * nloc) {
            __builtin_amdgcn_fence(__ATOMIC_RELEASE, "agent");
            asm volatile("s_waitcnt vmcnt(0)" ::: "memory");
            const unsigned og = xb_add(&bar[XB_TOP], 1u);
            const unsigned tg = og / nx;
            if (og + 1u == (tg + 1u) * nx) xb_add(&bar[XB_TOPGEN], 1u);
            else XB_SPIN(xb_ld(&bar[XB_TOPGEN]) == tg, bar);
            __builtin_amdgcn_fence(__ATOMIC_ACQUIRE, "agent");
            xb_add(&bar[XB_XGEN(b.x)], 1u);
            asm volatile("s_waitcnt vmcnt(0)" ::: "memory");
        } else {
            XB_SPIN(xb_ld(&bar[XB_XGEN(b.x)]) == gen, bar);
            __builtin_amdgcn_fence(__ATOMIC_ACQUIRE, "agent");
            asm volatile("s_waitcnt vmcnt(0)" ::: "memory");
        }
    }
    __syncthreads();
}

__device__ __forceinline__ void prep_convT(const float* __restrict__ srcp, bf16_t* __restrict__ dst, int K, int N, char* lds, int& cursor) {
    float (*tile)[32][33] = (float (*)[32][33])lds;
    const int tx = threadIdx.x & 31, ty = threadIdx.x >> 5;
    const int ntn = N / 32, ntiles = ntn * (K / 32);
    const int G = gridDim.x;
    const int first = ((int)blockIdx.x - cursor % G + G) % G;
    for (int t = first; t < ntiles; t += 4 * G) {
#pragma unroll
        for (int u = 0; u < 4; ++u) {
            const int tt = t + u * G;
            if (tt < ntiles) { const int n0 = (tt % ntn) * 32, k0 = (tt / ntn) * 32;
#pragma unroll
                for (int i = 0; i < 4; ++i) tile[u][ty + 8 * i][tx] = srcp[(size_t)(k0 + ty + 8 * i) * N + n0 + tx]; }
        }
        __syncthreads();
#pragma unroll
        for (int u = 0; u < 4; ++u) {
            const int tt = t + u * G;
            if (tt < ntiles) { const int n0 = (tt % ntn) * 32, k0 = (tt / ntn) * 32;
#pragma unroll
                for (int i = 0; i < 4; ++i) dst[(size_t)(n0 + ty + 8 * i) * K + k0 + tx] = f2bf(tile[u][tx][ty + 8 * i]); }
        }
        __syncthreads();
    }
    cursor += ntiles;
}
__device__ __forceinline__ void prep_conv(const float* __restrict__ srcp, bf16_t* __restrict__ dst, size_t n8) {
    for (size_t i = (size_t)blockIdx.x * blockDim.x + threadIdx.x; i < n8; i += (size_t)gridDim.x * blockDim.x) {
        const float4 a = *(const float4*)(srcp + i * 8), b = *(const float4*)(srcp + i * 8 + 4);
        uint4 o; o.x = pack2(a.x, a.y); o.y = pack2(a.z, a.w); o.z = pack2(b.x, b.y); o.w = pack2(b.z, b.w);
        *(uint4*)(dst + i * 8) = o;
    }
}
__device__ __forceinline__ void prep_ada(const float* __restrict__ c, const float* __restrict__ w_ada, const float* __restrict__ b_ada, float* __restrict__ mod, char* lds) {
    float* sc = (float*)lds;
    float* part = (float*)(lds + 16384);
    const int tid = threadIdx.x, col = tid & 63, kq = tid >> 6;
    const int G = gridDim.x;
    for (int item = (int)blockIdx.x - (G - 96 > 0 ? G - 96 : 0); item >= 0 && item < 96; item += G) {
        __syncthreads();
        for (int i = tid; i < 4096; i += 256) { const float v = c[i]; sc[i] = v * sigmoidf_(v); }
        __syncthreads();
        const int e = item * 64 + col;
        float a0 = 0.f, a1 = 0.f, a2 = 0.f, a3 = 0.f;
        for (int d = kq * 256; d < kq * 256 + 256; ++d) {
            const float wv = w_ada[(size_t)d * 6144 + e];
            a0 += sc[d] * wv; a1 += sc[1024 + d] * wv; a2 += sc[2048 + d] * wv; a3 += sc[3072 + d] * wv;
        }
        part[(kq * 4 + 0) * 64 + col] = a0; part[(kq * 4 + 1) * 64 + col] = a1; part[(kq * 4 + 2) * 64 + col] = a2; part[(kq * 4 + 3) * 64 + col] = a3;
        __syncthreads();
        { const int b = tid >> 6;
          const float s = part[(0 * 4 + b) * 64 + col] + part[(1 * 4 + b) * 64 + col] + part[(2 * 4 + b) * 64 + col] + part[(3 * 4 + b) * 64 + col];
          mod[b * 6144 + e] = s + b_ada[e]; }
    }
    if (G < 96) {
        for (int item = (int)blockIdx.x + G; item < 96; item += G) { (void)item; }
    }
}

__device__ __forceinline__ void prep_quant(const float* __restrict__ srcp, unsigned char* __restrict__ dst, float* __restrict__ scales, int rows, int off) {
    const int lane = threadIdx.x & 63, w = threadIdx.x >> 6;
    const int nwaves = gridDim.x * 4;
    for (int rb = (blockIdx.x * 4 + w) * 4; rb < rows; rb += nwaves * 4) {
        float4 v[4][4];
#pragma unroll
        for (int u = 0; u < 4; ++u)
#pragma unroll
            for (int j = 0; j < 4; ++j) v[u][j] = *(const float4*)(srcp + (size_t)(rb + u) * 1024 + lane * 16 + j * 4);
#pragma unroll
        for (int u = 0; u < 4; ++u) {
            const int r = rb + u;
            float am = 0.f;
#pragma unroll
            for (int j = 0; j < 4; ++j) am = fmaxf(am, fmaxf(fmaxf(fabsf(v[u][j].x), fabsf(v[u][j].y)), fmaxf(fabsf(v[u][j].z), fabsf(v[u][j].w))));
            for (int o = 32; o > 0; o >>= 1) am = fmaxf(am, __shfl_xor(am, o));
            unsigned o4[4];
            if (off < 0) {
                const float inv8 = am > 0.f ? 448.0f / am : 0.f;
                if (lane == 0) scales[r] = am > 0.f ? am * (1.0f / 448.0f) : 1.0f;
#pragma unroll
                for (int j = 0; j < 4; ++j) {
                    int p = 0;
                    p = __builtin_amdgcn_cvt_pk_fp8_f32(v[u][j].x * inv8, v[u][j].y * inv8, p, false);
                    p = __builtin_amdgcn_cvt_pk_fp8_f32(v[u][j].z * inv8, v[u][j].w * inv8, p, true);
                    o4[j] = (unsigned)p;
                }
            } else {
                const float inv = am > 0.f ? 127.0f / am : 0.f;
                if (lane == 0) scales[r] = am > 0.f ? am * (1.0f / 127.0f) : 1.0f;
#pragma unroll
                for (int j = 0; j < 4; ++j) {
                    const int q0 = __float2int_rn(v[u][j].x * inv) + off, q1 = __float2int_rn(v[u][j].y * inv) + off, q2 = __float2int_rn(v[u][j].z * inv) + off, q3 = __float2int_rn(v[u][j].w * inv) + off;
                    o4[j] = (unsigned)(q0 & 0xff) | ((unsigned)(q1 & 0xff) << 8) | ((unsigned)(q2 & 0xff) << 16) | ((unsigned)(q3 & 0xff) << 24);
                }
            }
            *(uint4*)(dst + (size_t)(lane >> 3) * ((size_t)rows * 128) + (size_t)r * 128 + (lane & 7) * 16) = make_uint4(o4[0], o4[1], o4[2], o4[3]);
        }
    }
}
template <bool QUANT>
__device__ __forceinline__ void phase_norm(const float* __restrict__ x, const float* __restrict__ g, const float* __restrict__ mod, int sh_off, int sc_off, bf16_t* __restrict__ H,
                                           unsigned char* __restrict__ HQ, float* __restrict__ HSC) {
    const int lane = threadIdx.x & 63, w = threadIdx.x >> 6;
    const int nwaves = gridDim.x * 4;
    for (int tb = (blockIdx.x * 4 + w) * 2; tb < NTOK; tb += nwaves * 2) {
        float4 v[2][4];
#pragma unroll
        for (int u = 0; u < 2; ++u)
#pragma unroll
            for (int j = 0; j < 4; ++j) v[u][j] = *(const float4*)(x + (size_t)(tb + u) * 1024 + j * 256 + lane * 4);
#pragma unroll
        for (int u = 0; u < 2; ++u) {
            const int t = tb + u; const int b = t / SEQ;
            float ss = 0.f;
#pragma unroll
            for (int j = 0; j < 4; ++j) ss += v[u][j].x * v[u][j].x + v[u][j].y * v[u][j].y + v[u][j].z * v[u][j].z + v[u][j].w * v[u][j].w;
            for (int o = 32; o > 0; o >>= 1) ss += __shfl_xor(ss, o);
            const float r = rsqrtf(ss * (1.0f / 1024.0f) + EPS);
            float am = 0.f;
#pragma unroll
            for (int j = 0; j < 4; ++j) {
                const int c = j * 256 + lane * 4;
                const float4 gg = *(const float4*)(g + c), sc = *(const float4*)(mod + b * 6144 + sc_off + c), sh = *(const float4*)(mod + b * 6144 + sh_off + c);
                float4& vv = v[u][j];
                vv.x = vv.x * r * gg.x * (1.0f + sc.x) + sh.x; vv.y = vv.y * r * gg.y * (1.0f + sc.y) + sh.y;
                vv.z = vv.z * r * gg.z * (1.0f + sc.z) + sh.z; vv.w = vv.w * r * gg.w * (1.0f + sc.w) + sh.w;
                *(uint2*)(H + (size_t)t * 1024 + c) = pack4(vv.x, vv.y, vv.z, vv.w);
                if (QUANT) am = fmaxf(am, fmaxf(fmaxf(fabsf(vv.x), fabsf(vv.y)), fmaxf(fabsf(vv.z), fabsf(vv.w))));
            }
            if (QUANT) {
                for (int o = 32; o > 0; o >>= 1) am = fmaxf(am, __shfl_xor(am, o));
                const float inv = am > 0.f ? 127.0f / am : 0.f;
                if (lane == 0) HSC[t] = am > 0.f ? am * (1.0f / 127.0f) : 1.0f;
#pragma unroll
                for (int j = 0; j < 4; ++j) {
                    const float4 vv = v[u][j];
                    const int q0 = __float2int_rn(vv.x * inv), q1 = __float2int_rn(vv.y * inv), q2 = __float2int_rn(vv.z * inv), q3 = __float2int_rn(vv.w * inv);
                    *(unsigned*)(HQ + (size_t)t * 1024 + j * 256 + lane * 4) = (unsigned)(q0 & 0xff) | ((unsigned)(q1 & 0xff) << 8) | ((unsigned)(q2 & 0xff) << 16) | ((unsigned)(q3 & 0xff) << 24);
                }
            }
        }
    }
}
struct MegaParams {
    const float* in[24];
    float* out;
    char* ws;
    int use_cg; int pad;
};
#define MEGA_LDS_BYTES 81920
#ifndef PROBE_DUP
#define PROBE_DUP 0
#endif
#define W_CTL   ((float*)(ws + OFF_CTL))
#define W_MOD   ((float*)(ws + OFF_MOD))
#define W_WTIN  ((bf16_t*)(ws + OFF_WTIN))
#define W_WTA   ((bf16_t*)(ws + OFF_WTA))
#define W_WTB   ((bf16_t*)(ws + OFF_WTB))
#define W_WTOUT ((bf16_t*)(ws + OFF_WTOUT))
#define W_WTQ   ((bf16_t*)(ws + OFF_WTQ))
#define W_SUBK  ((bf16_t*)(ws + OFF_SUBK))
#define W_DOWN  ((bf16_t*)(ws + OFF_DOWN))
#define W_UP    ((bf16_t*)(ws + OFF_UP))
#define W_H     ((bf16_t*)(ws + OFF_H))
#define W_Q     ((bf16_t*)(ws + OFF_Q))
#define W_K     ((bf16_t*)(ws + OFF_K))
#define W_V     ((bf16_t*)(ws + OFF_VT))
#define W_U     ((bf16_t*)(ws + OFF_U))
#define W_SV    ((bf16_t*)(ws + OFF_SV))
#define W_GATES ((bf16_t*)(ws + OFF_GATES))
#define W_YA    ((bf16_t*)(ws + OFF_YA))
#define W_YB    ((bf16_t*)(ws + OFF_YB))
#define W_MERGED ((bf16_t*)(ws + OFF_MERGED))
#define W_EIDX  ((int*)(ws + OFF_EIDX))
#define W_GW    ((float*)(ws + OFF_GW))
__global__ __launch_bounds__(256, 2) void k_mega(MegaParams P) {
    cg::grid_group grid = cg::this_grid();
    char* lds = dyn_lds; char* ws = P.ws;
    const float* x = P.in[0];
    XcdBarrier xb; xcd_barrier_post(xb, (unsigned*)(ws + OFF_BAR));
    prep_ada(P.in[1], P.in[2], P.in[3], W_MOD, lds);
    if (blockIdx.x == 0 && threadIdx.x == 0) {
        float s1 = 0.f, s2 = 0.f;
        for (int i = 0; i < 64; ++i) { s1 += P.in[6][i] * P.in[7][i]; s2 += P.in[8][i] * P.in[9][i]; }
        W_CTL[0] = __expf(s1) - __expf(s2) + 0.2f;
    }
    { int cursor = 0;
      __syncthreads();
      prep_convT(P.in[5], W_WTIN, 1024, IN_COLS, lds, cursor);
      prep_convT(P.in[15], W_WTA, 512, 1024, lds, cursor);
      prep_convT(P.in[16], W_WTB, 512, 1024, lds, cursor);
      prep_convT(P.in[17], W_WTOUT, 1024, 1024, lds, cursor);
      prep_convT(P.in[19], W_WTQ, 1024, 2048, lds, cursor); }
    prep_conv(P.in[20], W_SUBK, (size_t)8 * 2 * 128 * 128 / 8);
    prep_quant(P.in[21], (unsigned char*)(ws + OFF_DOWN), (float*)(ws + OFF_DSC), 16384, 0);
    prep_quant(P.in[22], (unsigned char*)(ws + OFF_UP), (float*)(ws + OFF_USC), 16384, -1);
    if (P.use_cg) grid.sync(); else xcd_barrier(xb);
    phase_norm<false>(x, P.in[4], W_MOD, 0, 1024, W_H, nullptr, nullptr);
    xcd_barrier(xb);
#if PROBE_DUP == 2
    phase_inproj(W_H, W_WTIN, W_Q, W_K, W_V, W_U, W_SV, W_GATES, lds);
#endif
    phase_inproj(W_H, W_WTIN, W_Q, W_K, W_V, W_U, W_SV, W_GATES, lds);
    xcd_barrier(xb);
    { const bool sgu_first = ((blockIdx.x >> 3) & 1) != 0;
      if (sgu_first) phase_sgu(W_U, W_SV, P.in[11], P.in[12], P.in[13], P.in[14], W_YB, lds);
      phase_attn(W_Q, W_K, W_V, W_CTL, P.in[10], W_YA, lds);
      if (!sgu_first) phase_sgu(W_U, W_SV, P.in[11], P.in[12], P.in[13], P.in[14], W_YB, lds); }
    xcd_barrier(xb);
#if PROBE_DUP == 5
    phase_merged(W_YA, W_YB, W_WTA, W_WTB, W_GATES, W_MERGED, lds);
#endif
    phase_merged(W_YA, W_YB, W_WTA, W_WTB, W_GATES, W_MERGED, lds);
    xcd_barrier(xb);
#if PROBE_DUP == 6
    phase_outproj(W_MERGED, W_WTOUT, x, W_MOD, P.out, lds);
#endif
    phase_outproj(W_MERGED, W_WTOUT, x, W_MOD, P.out, lds);
    xcd_barrier(xb);
    phase_norm<true>(P.out, P.in[18], W_MOD, 3072, 4096, W_H, (unsigned char*)(ws + OFF_HQ), (float*)(ws + OFF_HSC));
    xcd_barrier(xb);
#if PROBE_DUP == 8
    phase_peer_select(W_H, W_WTQ, W_SUBK, W_EIDX, W_GW, lds);
#endif
    phase_peer_select(W_H, W_WTQ, W_SUBK, W_EIDX, W_GW, lds);
    xcd_barrier(xb);
    phase_peer_expert((const unsigned char*)(ws + OFF_HQ), (const float*)(ws + OFF_HSC), W_EIDX, W_GW, (const unsigned char*)(ws + OFF_DOWN), (const unsigned char*)(ws + OFF_UP), (const float*)(ws + OFF_DSC), (const float*)(ws + OFF_USC), W_MOD, P.in[23], P.out, (float*)(ws + OFF_GATES), P.out, lds);
}

extern "C" void kernel_launch(void* const* d_in, const int* in_sizes, int n_in, void* d_out, int out_size, void* d_ws, size_t ws_size, hipStream_t stream) {
    if (ws_size < OFF_END || n_in < 24) return;
    static int grid_blocks = 0;
    if (!grid_blocks) {
        int dev = 0, cus = 0, per_cu = 0;
        hipGetDevice(&dev);
        hipDeviceGetAttribute(&cus, hipDeviceAttributeMultiprocessorCount, dev);
        hipFuncSetAttribute((const void*)k_mega, hipFuncAttributeMaxDynamicSharedMemorySize, MEGA_LDS_BYTES);
        hipOccupancyMaxActiveBlocksPerMultiprocessor(&per_cu, k_mega, 256, MEGA_LDS_BYTES);
        if (per_cu > 2) per_cu = 2;
        if (per_cu < 1) per_cu = 1;
        grid_blocks = cus * per_cu;
    }
    MegaParams P{};
    for (int i = 0; i < 24; ++i) P.in[i] = (const float*)d_in[i];
    P.out = (float*)d_out; P.ws = (char*)d_ws;
    hipMemsetAsync((char*)d_ws + OFF_BAR, 0, XCD_BAR_WORDS * 4, stream);
    void* args[] = {&P};
    hipError_t e = hipLaunchCooperativeKernel((void*)k_mega, dim3(grid_blocks), dim3(256), args, MEGA_LDS_BYTES, stream);
    if (e != hipSuccess) fprintf(stderr, "cooperative launch failed: %s (grid %d)\n", hipGetErrorString(e), grid_blocks);
}
```

```cpp
#include <hip/hip_runtime.h>
#include <hip/hip_cooperative_groups.h>
#include <stdint.h>
#include <stdio.h>
namespace cg = cooperative_groups;

typedef unsigned short bf16_t;

#define D_MODEL 1024
#define BATCH 4
#define SEQ 8192
#define NTOK (BATCH * SEQ)
#define IN_COLS 4608
#define EPS 1e-6f
#define QSCALE 0.18033688011112042f

__device__ __forceinline__ float bf2f(bf16_t v) { return __uint_as_float(((unsigned)v) << 16); }
typedef __bf16 bf16v2_t __attribute__((ext_vector_type(2)));
__device__ __forceinline__ bf16_t f2bf(float f) { return __builtin_bit_cast(unsigned short, (__bf16)f); }
__device__ __forceinline__ unsigned pack2(float a, float b) { bf16v2_t v; v[0] = (__bf16)a; v[1] = (__bf16)b; return __builtin_bit_cast(unsigned, v); }
__device__ __forceinline__ float gelu_tanh(float x) {
    const float z2 = 1.5957691216057308f * (x + 0.044715f * x * x * x);
    return x * __builtin_amdgcn_rcpf(1.0f + __expf(-z2));
}
__device__ __forceinline__ float sigmoidf_(float x) { return __builtin_amdgcn_rcpf(1.0f + __expf(-x)); }

constexpr size_t OFF_CTL   = 0;
constexpr size_t OFF_BAR   = 4096;
constexpr size_t OFF_MOD   = 4096 + 16384;
constexpr size_t OFF_STATS = OFF_MOD + 4 * 6144 * 4;
constexpr size_t OFF_WTIN  = OFF_STATS + (size_t)NTOK * 2 * 4;
constexpr size_t OFF_WTA   = OFF_WTIN + (size_t)IN_COLS * 1024 * 2;
constexpr size_t OFF_WTB   = OFF_WTA + (size_t)1024 * 512 * 2;
constexpr size_t OFF_WTOUT = OFF_WTB + (size_t)1024 * 512 * 2;
constexpr size_t OFF_WTQ   = OFF_WTOUT + (size_t)1024 * 1024 * 2;
constexpr size_t OFF_SUBK  = OFF_WTQ + (size_t)2048 * 1024 * 2;
constexpr size_t OFF_DOWN  = OFF_SUBK + (size_t)8 * 2 * 128 * 128 * 2;
constexpr size_t OFF_UP    = OFF_DOWN + (size_t)16384 * 1024;
constexpr size_t OFF_DSC   = OFF_UP + (size_t)16384 * 1024;
constexpr size_t OFF_USC   = OFF_DSC + (size_t)16384 * 4;
constexpr size_t OFF_H     = OFF_USC + (size_t)16384 * 4;
constexpr size_t OFF_Q     = OFF_H + (size_t)NTOK * 1024 * 2;
constexpr size_t OFF_K     = OFF_Q + (size_t)NTOK * 512 * 2;
constexpr size_t OFF_VT    = OFF_K + (size_t)NTOK * 512 * 2;
constexpr size_t OFF_U     = OFF_VT + (size_t)NTOK * 512 * 2;
constexpr size_t OFF_SV    = OFF_U + (size_t)NTOK * 512 * 2;
constexpr size_t OFF_GATES = OFF_SV + (size_t)NTOK * 512 * 2;
constexpr size_t OFF_YA    = OFF_GATES + (size_t)NTOK * 2048 * 2;
constexpr size_t OFF_YB    = OFF_YA + (size_t)NTOK * 512 * 2;
constexpr size_t OFF_END   = OFF_YB + (size_t)NTOK * 512 * 2;
constexpr size_t OFF_MERGED = OFF_Q;
constexpr size_t OFF_EIDX  = OFF_U;
constexpr size_t OFF_GW    = OFF_SV;
constexpr size_t OFF_HQ    = OFF_YA;
constexpr size_t OFF_HSC   = OFF_STATS;

extern __shared__ __attribute__((aligned(16))) char dyn_lds[];
using bf16x8 = __attribute__((ext_vector_type(8))) short;
using f32x4 = __attribute__((ext_vector_type(4))) float;
typedef float f32x2_t __attribute__((ext_vector_type(2)));
typedef __attribute__((address_space(3))) char* lds_ptr_t;
#define GEMM_LDS_BYTES 65536
#define SEL_LDS_BYTES 81920

__device__ __forceinline__ uint2 pack4(float a, float b, float c, float d) {
    uint2 r; r.x = pack2(a, b); r.y = pack2(c, d); return r;
}

__device__ __forceinline__ void g_load(const bf16_t* __restrict__ A, int lda, int m0, int k0, uint4 (&r)[4], int tid) {
    const int c = tid & 7, rr = tid >> 3;
#pragma unroll
    for (int i = 0; i < 4; ++i) r[i] = *(const uint4*)(A + (size_t)(m0 + rr + 32 * i) * lda + k0 + c * 8);
}
__device__ __forceinline__ void g_store(char* lds, const uint4 (&r)[4], int tid) {
    const int c = tid & 7, rr = tid >> 3;
#pragma unroll
    for (int i = 0; i < 4; ++i) { const int row = rr + 32 * i; *(uint4*)(lds + row * 128 + ((c ^ (row & 7)) << 4)) = r[i]; }
}
__device__ __forceinline__ void g_compute(const char* sA, const char* sB, f32x4 (&acc)[4][4], int wm, int wn, int lane) {
    const int lr = lane & 15, lq = lane >> 4;
#pragma unroll
    for (int ks = 0; ks < 2; ++ks) {
        bf16x8 a[4], b[4];
        const int sw = (((ks * 4 + lq) ^ (lr & 7)) << 4);
#pragma unroll
        for (int i = 0; i < 4; ++i) a[i] = *(const bf16x8*)(sA + (wm * 64 + i * 16 + lr) * 128 + sw);
#pragma unroll
        for (int j = 0; j < 4; ++j) b[j] = *(const bf16x8*)(sB + (wn * 64 + j * 16 + lr) * 128 + sw);
#pragma unroll
        for (int i = 0; i < 4; ++i)
#pragma unroll
            for (int j = 0; j < 4; ++j) acc[i][j] = __builtin_amdgcn_mfma_f32_16x16x32_bf16(b[j], a[i], acc[i][j], 0, 0, 0);
    }
}
__device__ __forceinline__ void g_dma(const bf16_t* __restrict__ A, int lda, int m0, int k0, char* lds_tile, int lane, int w) {
    const int rl = lane >> 3, pc = lane & 7;
#pragma unroll
    for (int i = 0; i < 4; ++i) {
        const int n = w * 4 + i; const int row = 8 * n + rl;
        __builtin_amdgcn_global_load_lds((const unsigned*)(A + (size_t)(m0 + row) * lda + k0 + ((pc ^ (row & 7)) << 3)),
                                         (__attribute__((address_space(3))) unsigned*)(lds_ptr_t)(lds_tile + n * 1024), 16, 0, 0);
    }
}
__device__ __forceinline__ void g_kloop(const bf16_t* __restrict__ A, int lda, const bf16_t* __restrict__ Bt, int ldb, int K, int m0, int n0,
                                        char* lds, f32x4 (&acc)[4][4], int tid) {
    const int lane = tid & 63, w = __builtin_amdgcn_readfirstlane(tid >> 6), wm = w >> 1, wn = w & 1;
    g_dma(A, lda, m0, 0, lds, lane, w); g_dma(Bt, ldb, n0, 0, lds + 16384, lane, w);
    asm volatile("s_waitcnt vmcnt(0)" ::: "memory");
    __syncthreads();
    const int nk = K >> 6;
    for (int kt = 0; kt < nk; ++kt) {
        char* cur = lds + (kt & 1) * 32768; char* nxt = lds + ((kt + 1) & 1) * 32768;
        if (kt + 1 < nk) { g_dma(A, lda, m0, (kt + 1) * 64, nxt, lane, w); g_dma(Bt, ldb, n0, (kt + 1) * 64, nxt + 16384, lane, w); }
        g_compute(cur, cur + 16384, acc, wm, wn, lane);
        asm volatile("s_waitcnt vmcnt(0)" ::: "memory");
        __syncthreads();
    }
}
__device__ __forceinline__ void g_zero(f32x4 (&acc)[4][4]) {
#pragma unroll
    for (int i = 0; i < 4; ++i)
#pragma unroll
        for (int j = 0; j < 4; ++j) acc[i][j] = f32x4{0.f, 0.f, 0.f, 0.f};
}
__device__ __forceinline__ void g_tilemap(int it, int nMt, int nNt, int& mt, int& nt, bool& valid) {
    const int G = gridDim.x, bid = blockIdx.x;
    if ((G & 7) == 0 && (nMt & 63) == 0) {
        const int x = bid & 7, slot = bid >> 3, nslot = G >> 3;
        const int u = it * nslot + slot;
        const int mPer = nMt >> 3;
        valid = u < mPer * nNt;
        const int SBN = (nNt % 9 == 0) ? 9 : ((nNt % 8 == 0) ? 8 : nNt);
        const int sbPerRow = nNt / SBN;
        const int sb = u / (8 * SBN), within = u % (8 * SBN);
        const int sbm = sb / sbPerRow, sbn = sb % sbPerRow;
        mt = x * mPer + sbm * 8 + within / SBN;
        nt = sbn * SBN + within % SBN;
    } else {
        const int t = it * G + bid;
        valid = t < nMt * nNt;
        mt = t / nNt; nt = t % nNt;
    }
}
#define G_EPI_LOOP(...) \
    { const int lane_ = tid & 63, w_ = tid >> 6, wm_ = w_ >> 1, wn_ = w_ & 1, lr_ = lane_ & 15, lq_ = lane_ >> 4; \
      _Pragma("unroll") for (int i = 0; i < 4; ++i) _Pragma("unroll") for (int j = 0; j < 4; ++j) { \
        const int m = m0 + wm_ * 64 + i * 16 + lr_; const int n = n0 + wn_ * 64 + j * 16 + lq_ * 4; const f32x4 v = acc[i][j]; __VA_ARGS__ } }


#define GW_STAGE 24576
__device__ __forceinline__ void gw_dma(const bf16_t* __restrict__ A, int lda, const bf16_t* __restrict__ Bt, int ldb, int m0, int n0, int k0, char* stage, int lane, int w) {
    const int rl = lane >> 2, pc = lane & 3;
    const int sc = (pc ^ ((-(rl >> 2)) & 3)) << 3;
#pragma unroll
    for (int i = 0; i < 2; ++i) {
        const int n = w * 2 + i;
        __builtin_amdgcn_global_load_lds((const unsigned*)(A + (size_t)(m0 + n * 16 + rl) * lda + k0 + sc),
                                         (__attribute__((address_space(3))) unsigned*)(lds_ptr_t)(stage + n * 1024), 16, 0, 0);
    }
#pragma unroll
    for (int i = 0; i < 4; ++i) {
        const int n = w * 4 + i;
        __builtin_amdgcn_global_load_lds((const unsigned*)(Bt + (size_t)(n0 + n * 16 + rl) * ldb + k0 + sc),
                                         (__attribute__((address_space(3))) unsigned*)(lds_ptr_t)(stage + 8192 + n * 1024), 16, 0, 0);
    }
}
__device__ __forceinline__ void gw_compute(const char* stage, f32x4 (&acc)[4][8], int wm, int wn, int lane) {
    const int lr = lane & 15, lq = lane >> 4;
    const int sw = (lq ^ ((-(lr >> 2)) & 3)) << 4;
    bf16x8 a[4], b[8];
#pragma unroll
    for (int i = 0; i < 4; ++i) a[i] = *(const bf16x8*)(stage + (wm * 64 + i * 16 + lr) * 64 + sw);
#pragma unroll
    for (int j = 0; j < 8; ++j) b[j] = *(const bf16x8*)(stage + 8192 + (wn * 128 + j * 16 + lr) * 64 + sw);
#pragma unroll
    for (int i = 0; i < 4; ++i)
#pragma unroll
        for (int j = 0; j < 8; ++j) acc[i][j] = __builtin_amdgcn_mfma_f32_16x16x32_bf16(b[j], a[i], acc[i][j], 0, 0, 0);
}
__device__ __forceinline__ void gw_kloop(const bf16_t* __restrict__ A, int lda, const bf16_t* __restrict__ Bt, int ldb, int K, int m0, int n0,
                                         char* lds, f32x4 (&acc)[4][8], int tid) {
    const int lane = tid & 63, w = __builtin_amdgcn_readfirstlane(tid >> 6), wm = w >> 1, wn = w & 1;
    const int nk = K >> 5;
    gw_dma(A, lda, Bt, ldb, m0, n0, 0, lds, lane, w);
    gw_dma(A, lda, Bt, ldb, m0, n0, 32, lds + GW_STAGE, lane, w);
    int cur = 0;
    for (int kt = 0; kt < nk; ++kt) {
        if (kt + 1 < nk) asm volatile("s_waitcnt vmcnt(6)" ::: "memory"); else asm volatile("s_waitcnt vmcnt(0)" ::: "memory");
        asm volatile("s_waitcnt lgkmcnt(0)" ::: "memory");
        __builtin_amdgcn_s_barrier();
        if (kt + 2 < nk) { int nx = cur + 2; if (nx >= 3) nx -= 3; gw_dma(A, lda, Bt, ldb, m0, n0, (kt + 2) * 32, lds + nx * GW_STAGE, lane, w); }
        gw_compute(lds + cur * GW_STAGE, acc, wm, wn, lane);
        cur = (cur == 2) ? 0 : cur + 1;
    }
    asm volatile("s_waitcnt lgkmcnt(0)" ::: "memory");
    __builtin_amdgcn_s_barrier();
}
__device__ __forceinline__ void gw_zero(f32x4 (&acc)[4][8]) {
#pragma unroll
    for (int i = 0; i < 4; ++i)
#pragma unroll
        for (int j = 0; j < 8; ++j) acc[i][j] = f32x4{0.f, 0.f, 0.f, 0.f};
}
#define GW_EPI_LOOP(...) \
    { const int lane_ = tid & 63, w_ = tid >> 6, wm_ = w_ >> 1, wn_ = w_ & 1, lr_ = lane_ & 15, lq_ = lane_ >> 4; \
      _Pragma("unroll") for (int i = 0; i < 4; ++i) _Pragma("unroll") for (int j = 0; j < 8; ++j) { \
        const int m = m0 + wm_ * 64 + i * 16 + lr_; const int n = n0 + wn_ * 128 + j * 16 + lq_ * 4; const f32x4 v = acc[i][j]; __VA_ARGS__ } }

__device__ __forceinline__ void phase_inproj(const bf16_t* __restrict__ H, const bf16_t* __restrict__ WTIN, bf16_t* Q, bf16_t* Kb, bf16_t* VT, bf16_t* U, bf16_t* SV, bf16_t* G, char* lds) {
    const int tid = threadIdx.x;
    const int nMt = NTOK / 128, nNt = IN_COLS / 256;
    for (int it = 0;; ++it) {
        int mt, nt; bool valid; g_tilemap(it, nMt, nNt, mt, nt, valid);
        if (!valid) break;
        const int m0 = mt * 128, n0 = nt * 256;
        f32x4 acc[4][8]; gw_zero(acc);
        gw_kloop(H, 1024, WTIN, 1024, 1024, m0, n0, lds, acc, tid);
        if (n0 < 512) { GW_EPI_LOOP( *(uint2*)(Q + (size_t)m * 512 + n) = pack4(v[0] * QSCALE, v[1] * QSCALE, v[2] * QSCALE, v[3] * QSCALE); ) }
        else if (n0 < 1024) { GW_EPI_LOOP( *(uint2*)(Kb + (size_t)m * 512 + n - 512) = pack4(v[0], v[1], v[2], v[3]); ) }
        else if (n0 < 1536) { GW_EPI_LOOP( *(uint2*)(VT + (size_t)m * 512 + n - 1024) = pack4(v[0], v[1], v[2], v[3]); ) }
        else if (n0 < 2048) { GW_EPI_LOOP( *(uint2*)(U + (size_t)m * 512 + n - 1536) = pack4(gelu_tanh(v[0]), gelu_tanh(v[1]), gelu_tanh(v[2]), gelu_tanh(v[3])); ) }
        else if (n0 < 2560) { GW_EPI_LOOP( *(uint2*)(SV + (size_t)m * 512 + n - 2048) = pack4(gelu_tanh(v[0]), gelu_tanh(v[1]), gelu_tanh(v[2]), gelu_tanh(v[3])); ) }
        else { GW_EPI_LOOP( *(uint2*)(G + (size_t)m * 2048 + n - 2560) = pack4(sigmoidf_(v[0]), sigmoidf_(v[1]), sigmoidf_(v[2]), sigmoidf_(v[3])); ) }
    }
}
__device__ __forceinline__ void phase_merged(const bf16_t* __restrict__ YA, const bf16_t* __restrict__ YB, const bf16_t* __restrict__ WTA, const bf16_t* __restrict__ WTB,
                             const bf16_t* __restrict__ G, bf16_t* MERGED, char* lds) {
    const int tid = threadIdx.x;
    const int nMt = NTOK / 128, nNt = 1024 / 128;
    for (int it = 0;; ++it) {
        int mt, nt; bool valid; g_tilemap(it, nMt, nNt, mt, nt, valid);
        if (!valid) break;
        const int m0 = mt * 128, n0 = nt * 128;
        f32x4 acc[4][4]; g_zero(acc);
        g_kloop(YB, 512, WTB, 512, 512, m0, n0, lds, acc, tid);
        { const int lane_ = tid & 63, w_ = tid >> 6, wm_ = w_ >> 1, wn_ = w_ & 1, lr_ = lane_ & 15, lq_ = lane_ >> 4;
#pragma unroll
          for (int i = 0; i < 4; ++i)
#pragma unroll
            for (int j = 0; j < 4; ++j) {
                const int m = m0 + wm_ * 64 + i * 16 + lr_; const int n = n0 + wn_ * 64 + j * 16 + lq_ * 4;
                const uint2 ga2 = *(const uint2*)(G + (size_t)m * 2048 + n);
                const uint2 gb2 = *(const uint2*)(G + (size_t)m * 2048 + 1024 + n);
                acc[i][j][0] *= __uint_as_float(gb2.x << 16) * __builtin_amdgcn_rcpf(fmaxf(__uint_as_float(ga2.x << 16), 1e-20f));
                acc[i][j][1] *= __uint_as_float(gb2.x & 0xffff0000u) * __builtin_amdgcn_rcpf(fmaxf(__uint_as_float(ga2.x & 0xffff0000u), 1e-20f));
                acc[i][j][2] *= __uint_as_float(gb2.y << 16) * __builtin_amdgcn_rcpf(fmaxf(__uint_as_float(ga2.y << 16), 1e-20f));
                acc[i][j][3] *= __uint_as_float(gb2.y & 0xffff0000u) * __builtin_amdgcn_rcpf(fmaxf(__uint_as_float(ga2.y & 0xffff0000u), 1e-20f));
            } }
        g_kloop(YA, 512, WTA, 512, 512, m0, n0, lds, acc, tid);
        G_EPI_LOOP( const uint2 ga2 = *(const uint2*)(G + (size_t)m * 2048 + n);
                    *(uint2*)(MERGED + (size_t)m * 1024 + n) = pack4(v[0] * fmaxf(__uint_as_float(ga2.x << 16), 1e-20f), v[1] * fmaxf(__uint_as_float(ga2.x & 0xffff0000u), 1e-20f),
                                                                      v[2] * fmaxf(__uint_as_float(ga2.y << 16), 1e-20f), v[3] * fmaxf(__uint_as_float(ga2.y & 0xffff0000u), 1e-20f)); )
    }
}
__device__ __forceinline__ void phase_outproj(const bf16_t* __restrict__ MERGED, const bf16_t* __restrict__ WTOUT, const float* __restrict__ x, const float* __restrict__ mod, float* x1, char* lds) {
    const int tid = threadIdx.x;
    const int nMt = NTOK / 128, nNt = 1024 / 256;
    for (int it = 0;; ++it) {
        int mt, nt; bool valid; g_tilemap(it, nMt, nNt, mt, nt, valid);
        if (!valid) break;
        const int m0 = mt * 128, n0 = nt * 256;
        f32x4 acc[4][8]; gw_zero(acc);
        gw_kloop(MERGED, 1024, WTOUT, 1024, 1024, m0, n0, lds, acc, tid);
        GW_EPI_LOOP( const int b = m / SEQ; const float4 g1 = *(const float4*)(mod + b * 6144 + 2048 + n);
                    const float4 xv = *(const float4*)(x + (size_t)m * 1024 + n);
                    float4 o; o.x = xv.x + g1.x * v[0]; o.y = xv.y + g1.y * v[1]; o.z = xv.z + g1.z * v[2]; o.w = xv.w + g1.w * v[3];
                    *(float4*)(x1 + (size_t)m * 1024 + n) = o; )
    }
}
__device__ __forceinline__ void phase_peerq(const bf16_t* __restrict__ H2, const bf16_t* __restrict__ WTQ, bf16_t* QP, char* lds) {
    const int tid = threadIdx.x;
    const int nMt = NTOK / 128, nNt = 2048 / 128;
    for (int it = 0;; ++it) {
        int mt, nt; bool valid; g_tilemap(it, nMt, nNt, mt, nt, valid);
        if (!valid) break;
        const int m0 = mt * 128, n0 = nt * 128;
        f32x4 acc[4][4]; g_zero(acc);
        g_kloop(H2, 1024, WTQ, 1024, 1024, m0, n0, lds, acc, tid);
        G_EPI_LOOP( *(uint2*)(QP + (size_t)m * 2048 + n) = pack4(v[0], v[1], v[2], v[3]); )
    }
}


using f32x16 = __attribute__((ext_vector_type(16))) float;
typedef short v4i16_t __attribute__((ext_vector_type(4)));
#define ATT_TILE 16384
#define ATT_LDS_BYTES (4 * ATT_TILE)

__device__ __forceinline__ void att_dma(const bf16_t* __restrict__ Kb, const bf16_t* __restrict__ V, int b, int h, int kt, char* kl, char* vl, int lane, int w) {
    const int pc = lane & 15, rl = lane >> 4;
#pragma unroll
    for (int i = 0; i < 4; ++i) {
        const int n = w * 4 + i; const int row = 4 * n + rl;
        const size_t rowoff = ((size_t)(b * SEQ + kt * 64 + row)) * 512 + h * 128;
        __builtin_amdgcn_global_load_lds((const unsigned*)(Kb + rowoff + ((pc ^ (row & 15)) << 3)), (__attribute__((address_space(3))) unsigned*)(lds_ptr_t)(kl + n * 1024), 16, 0, 0);
        __builtin_amdgcn_global_load_lds((const unsigned*)(V + rowoff + ((pc ^ ((row & 3) << 2)) << 3)), (__attribute__((address_space(3))) unsigned*)(lds_ptr_t)(vl + n * 1024), 16, 0, 0);
    }
}
__device__ __forceinline__ void att_item(int b, int h, int c, const bf16_t* __restrict__ Q, const bf16_t* __restrict__ Kb, const bf16_t* __restrict__ V,
                                         float lam, const float* __restrict__ head_g, bf16_t* __restrict__ YA, char* lds) {
    const int tid = threadIdx.x, lane = tid & 63;
    const int w = __builtin_amdgcn_readfirstlane(tid >> 6);
    const int i = w & 1, rq = w >> 1, r = lane & 31, hh = lane >> 5;
    const int tq = b * SEQ + c * 64 + rq * 32 + r;
    bf16x8 qf[4];
#pragma unroll
    for (int s = 0; s < 4; ++s) qf[s] = *(const bf16x8*)(Q + (size_t)tq * 512 + h * 128 + i * 64 + 16 * s + 8 * hh);
    f32x16 O[4];
#pragma unroll
    for (int d = 0; d < 4; ++d)
#pragma unroll
        for (int e = 0; e < 16; ++e) O[d][e] = 0.f;
    float m = -1e30f, l = 0.f;
    const int ntiles = c + 1;
    int vb[4];
    { const int li = lane & 15, g = lane >> 4, q = li >> 2, x = 2 * (g & 1) + ((li & 3) >> 1);
#pragma unroll
      for (int d = 0; d < 4; ++d) vb[d] = (4 * hh + q) * 256 + ((((d ^ q) << 2) | x) << 4) + 8 * (li & 1); }
    att_dma(Kb, V, b, h, 0, lds, lds + ATT_TILE, lane, w);
    asm volatile("s_waitcnt vmcnt(0)" ::: "memory");
    __syncthreads();
    for (int kt = 0; kt < ntiles; ++kt) {
        const char* kl = lds + (kt & 1) * (2 * ATT_TILE); const char* vl = kl + ATT_TILE;
        if (kt + 1 < ntiles) { char* nl = lds + ((kt + 1) & 1) * (2 * ATT_TILE); att_dma(Kb, V, b, h, kt + 1, nl, nl + ATT_TILE, lane, w); }
        f32x16 sacc[2];
        {
            bf16x8 kf[2][4];
#pragma unroll
            for (int k2 = 0; k2 < 2; ++k2)
#pragma unroll
                for (int s = 0; s < 4; ++s) {
                    const int krow = k2 * 32 + r; const int kch = i * 8 + 2 * s + hh;
                    kf[k2][s] = *(const bf16x8*)(kl + krow * 256 + ((kch ^ (krow & 15)) << 4));
                }
#pragma unroll
            for (int k2 = 0; k2 < 2; ++k2) {
#pragma unroll
                for (int e = 0; e < 16; ++e) sacc[k2][e] = 0.f;
#pragma unroll
                for (int s = 0; s < 4; ++s) sacc[k2] = __builtin_amdgcn_mfma_f32_32x32x16_bf16(kf[k2][s], qf[s], sacc[k2], 0, 0, 0);
            }
        }
        float mx = sacc[0][0];
#pragma unroll
        for (int e = 1; e < 16; ++e) mx = fmaxf(mx, sacc[0][e]);
#pragma unroll
        for (int e = 0; e < 16; ++e) mx = fmaxf(mx, sacc[1][e]);
        mx = fmaxf(mx, __shfl_xor(mx, 32));
        const float mn = fmaxf(m, mx);
        const float alpha = __builtin_amdgcn_exp2f(m - mn);
        m = mn;
        float ls = 0.f;
#pragma unroll
        for (int k2 = 0; k2 < 2; ++k2)
#pragma unroll
            for (int e = 0; e < 16; ++e) { const float p = __builtin_amdgcn_exp2f(sacc[k2][e] - mn); sacc[k2][e] = p; ls += p; }
        l = l * alpha + ls;
        if (__any(alpha != 1.0f)) {
#pragma unroll
            for (int d = 0; d < 4; ++d)
#pragma unroll
                for (int e = 0; e < 16; ++e) O[d][e] *= alpha;
        }
        bf16x8 pf[2][2];
#pragma unroll
        for (int k2 = 0; k2 < 2; ++k2)
#pragma unroll
            for (int s2 = 0; s2 < 2; ++s2) {
                union { uint4 u; bf16x8 v; } cp;
                cp.u = make_uint4(pack2(sacc[k2][8 * s2 + 0], sacc[k2][8 * s2 + 1]), pack2(sacc[k2][8 * s2 + 2], sacc[k2][8 * s2 + 3]),
                                  pack2(sacc[k2][8 * s2 + 4], sacc[k2][8 * s2 + 5]), pack2(sacc[k2][8 * s2 + 6], sacc[k2][8 * s2 + 7]));
                pf[k2][s2] = cp.v;
            }
#define ATT_VREAD(dst, st) { const lds_ptr_t vp_ = (lds_ptr_t)(vl + vb[(st) >> 2]); const int kb_ = (((st) >> 1) & 1) * 32 + ((st) & 1) * 16; \
            const v4i16_t lo_ = __builtin_amdgcn_ds_read_tr16_b64_v4i16((__attribute__((address_space(3))) v4i16_t*)(vp_ + kb_ * 256)); \
            const v4i16_t hi_ = __builtin_amdgcn_ds_read_tr16_b64_v4i16((__attribute__((address_space(3))) v4i16_t*)(vp_ + kb_ * 256 + 2048)); \
            dst = (bf16x8){lo_[0], lo_[1], lo_[2], lo_[3], hi_[0], hi_[1], hi_[2], hi_[3]}; }
        {
            bf16x8 vcur, vnxt;
            ATT_VREAD(vcur, 0)
#pragma unroll
            for (int st = 0; st < 16; ++st) {
                if (st + 1 < 16) ATT_VREAD(vnxt, st + 1)
                O[st >> 2] = __builtin_amdgcn_mfma_f32_32x32x16_bf16(vcur, pf[(st >> 1) & 1][st & 1], O[st >> 2], 0, 0, 0);
                vcur = vnxt;
            }
        }
        asm volatile("s_waitcnt vmcnt(0)" ::: "memory");
        __syncthreads();
    }
    const float ltot = l + __shfl_xor(l, 32);
    const float inv = 1.0f / ltot;
    float* ex = (float*)lds;
    if (i == 1) {
        const float sc = inv * lam;
#pragma unroll
        for (int d = 0; d < 4; ++d)
#pragma unroll
            for (int e = 0; e < 16; ++e) { const int dv = d * 32 + (e & 3) + 8 * (e >> 2) + 4 * hh; ex[(rq * 128 + dv) * 32 + r] = O[d][e] * sc; }
    }
    __syncthreads();
    if (i == 0) {
        float ss = 0.f;
#pragma unroll
        for (int d = 0; d < 4; ++d)
#pragma unroll
            for (int e = 0; e < 16; ++e) { const int dv = d * 32 + (e & 3) + 8 * (e >> 2) + 4 * hh; const float o = O[d][e] * inv - ex[(rq * 128 + dv) * 32 + r]; O[d][e] = o; ss += o * o; }
        ss += __shfl_xor(ss, 32);
        const float rn = rsqrtf(ss * (1.0f / 128.0f) + EPS) * 0.8f;
#pragma unroll
        for (int d = 0; d < 4; ++d)
#pragma unroll
            for (int g = 0; g < 4; ++g) {
                const int dv = d * 32 + 8 * g + 4 * hh;
                const float4 hg = *(const float4*)(head_g + dv);
                *(uint2*)(YA + (size_t)tq * 512 + h * 128 + dv) = pack4(O[d][4 * g] * rn * hg.x, O[d][4 * g + 1] * rn * hg.y, O[d][4 * g + 2] * rn * hg.z, O[d][4 * g + 3] * rn * hg.w);
            }
    }
    __syncthreads();
}
__device__ __forceinline__ void phase_attn(const bf16_t* __restrict__ Q, const bf16_t* __restrict__ Kb, const bf16_t* __restrict__ V, const float* __restrict__ ctl,
                           const float* __restrict__ head_g, bf16_t* __restrict__ YA, char* lds) {
    const float lam = ctl[0];
    const int G = gridDim.x, bid = blockIdx.x;
    if (G == 512) {
        const int x = bid & 7, slot = bid >> 3; const int ph = x + 8 * (slot & 1); const int s = slot >> 1;
#pragma unroll 1
        for (int it = 0; it < 4; ++it) {
            const int c = (it == 0) ? 127 - s : (it == 1) ? 64 + s : (it == 2) ? 63 - s : s;
            att_item(ph >> 2, ph & 3, c, Q, Kb, V, lam, head_g, YA, lds);
        }
    } else {
#pragma unroll 1
        for (int it = 0;; ++it) {
            const int rho = (it & 1) ? it * G + (G - 1 - bid) : it * G + bid;
            if (rho >= 2048) { if (it * G >= 2048) break; else continue; }
            const int c = 127 - (rho >> 4); const int ph = rho & 15;
            att_item(ph >> 2, ph & 3, c, Q, Kb, V, lam, head_g, YA, lds);
        }
    }
}


#define SGU_LDS_BYTES (65536 + 1024)
__device__ __forceinline__ void phase_sgu(const bf16_t* __restrict__ U, const bf16_t* __restrict__ SV, const float* __restrict__ ln_g, const float* __restrict__ ln_b,
                          const float* __restrict__ sg_w, const float* __restrict__ sg_b, bf16_t* __restrict__ YB, char* lds) {
    const int tid = threadIdx.x, lane = tid & 63, w = tid >> 6, wm = w >> 1, wn = w & 1, lr = lane & 15, lq = lane >> 4;
    float* st_mu = (float*)(lds + 65536); float* st_rs = st_mu + 128;
    char* Wl = lds; char* Sl = lds + 32768;
    for (int item = blockIdx.x; item < (NTOK / 128) * 4; item += gridDim.x) {
        const int g = item & 3, nb = item >> 2; const int t0 = nb * 128;
        for (int r0 = 0; r0 < 32; r0 += 8) {
            uint4 v8[8];
#pragma unroll
            for (int u = 0; u < 8; ++u) v8[u] = *(const uint4*)(SV + (size_t)(t0 + w * 32 + r0 + u) * 512 + lane * 8);
#pragma unroll
            for (int u = 0; u < 8; ++u) {
                const int row = w * 32 + r0 + u; const uint4 v = v8[u];
                float f[8] = {__uint_as_float(v.x << 16), __uint_as_float(v.x & 0xffff0000u), __uint_as_float(v.y << 16), __uint_as_float(v.y & 0xffff0000u),
                              __uint_as_float(v.z << 16), __uint_as_float(v.z & 0xffff0000u), __uint_as_float(v.w << 16), __uint_as_float(v.w & 0xffff0000u)};
                float s = 0.f;
#pragma unroll
                for (int j = 0; j < 8; ++j) s += f[j];
                for (int o = 32; o > 0; o >>= 1) s += __shfl_xor(s, o);
                const float mu = s * (1.0f / 512.0f);
                float q = 0.f;
#pragma unroll
                for (int j = 0; j < 8; ++j) { const float d = f[j] - mu; q += d * d; }
                for (int o = 32; o > 0; o >>= 1) q += __shfl_xor(q, o);
                if (lane == 0) { st_mu[row] = mu; st_rs[row] = rsqrtf(q * (1.0f / 512.0f) + EPS); }
            }
        }
        { const int c16 = tid & 15, r0 = tid >> 4;
#pragma unroll
          for (int i = 0; i < 8; ++i) {
              const int p = r0 + 16 * i;
              const float* wp = sg_w + ((size_t)g * 128 + p) * 128 + c16 * 8;
              float4 a = *(const float4*)wp, b = *(const float4*)(wp + 4);
              if (p < 64 && c16 >= 8) { a = make_float4(0.f, 0.f, 0.f, 0.f); b = a; }
              *(uint4*)(Wl + p * 256 + ((c16 ^ (p & 15)) << 4)) = make_uint4(pack2(a.x, a.y), pack2(a.z, a.w), pack2(b.x, b.y), pack2(b.z, b.w));
          } }
        __syncthreads();
        { const int pr = tid & 63;
#pragma unroll
          for (int it = 0; it < 4; ++it) {
              const int ch = (tid >> 6) + 4 * it;
              const int q0 = 2 * pr;
              const uint4 va = *(const uint4*)(SV + (size_t)(t0 + q0) * 512 + g * 128 + ch * 8);
              const uint4 vb = *(const uint4*)(SV + (size_t)(t0 + q0 + 1) * 512 + g * 128 + ch * 8);
              const float mua = st_mu[q0], rsa = st_rs[q0], mub = st_mu[q0 + 1], rsb = st_rs[q0 + 1];
              const unsigned ua[4] = {va.x, va.y, va.z, va.w}, ub[4] = {vb.x, vb.y, vb.z, vb.w};
#pragma unroll
              for (int e = 0; e < 8; ++e) {
                  const int c = ch * 8 + e;
                  const float lg = ln_g[g * 128 + c], lb = ln_b[g * 128 + c];
                  const float xa = (e & 1) ? __uint_as_float(ua[e >> 1] & 0xffff0000u) : __uint_as_float(ua[e >> 1] << 16);
                  const float xb = (e & 1) ? __uint_as_float(ub[e >> 1] & 0xffff0000u) : __uint_as_float(ub[e >> 1] << 16);
                  const float na = (xa - mua) * rsa * lg + lb, nb2 = (xb - mub) * rsb * lg + lb;
                  *(unsigned*)(Sl + c * 256 + (((q0 >> 3) ^ (c & 15)) << 4) + (q0 & 7) * 2) = pack2(na, nb2);
              }
          } }
        __syncthreads();
        f32x4 acc[4][4]; g_zero(acc);
        const int nks = (wm == 0) ? 2 : 4;
        for (int ks = 0; ks < nks; ++ks) {
            const int sw = (((ks * 4 + lq) ^ lr) << 4);
            bf16x8 a[4], b[4];
#pragma unroll
            for (int i = 0; i < 4; ++i) a[i] = *(const bf16x8*)(Wl + (wm * 64 + i * 16 + lr) * 256 + sw);
#pragma unroll
            for (int j = 0; j < 4; ++j) b[j] = *(const bf16x8*)(Sl + (wn * 64 + j * 16 + lr) * 256 + sw);
#pragma unroll
            for (int i = 0; i < 4; ++i)
#pragma unroll
                for (int j = 0; j < 4; ++j) acc[i][j] = __builtin_amdgcn_mfma_f32_16x16x32_bf16(b[j], a[i], acc[i][j], 0, 0, 0);
        }
#pragma unroll
        for (int i = 0; i < 4; ++i)
#pragma unroll
            for (int j = 0; j < 4; ++j) {
                const int p = wm * 64 + i * 16 + lr; const int c = wn * 64 + j * 16 + lq * 4;
                const float bias = sg_b[g * 128 + p];
                const size_t o = (size_t)(t0 + p) * 512 + g * 128 + c;
                const uint2 uu = *(const uint2*)(U + o);
                *(uint2*)(YB + o) = pack4(__uint_as_float(uu.x << 16) * (acc[i][j][0] + bias), __uint_as_float(uu.x & 0xffff0000u) * (acc[i][j][1] + bias),
                                          __uint_as_float(uu.y << 16) * (acc[i][j][2] + bias), __uint_as_float(uu.y & 0xffff0000u) * (acc[i][j][3] + bias));
            }
        __syncthreads();
    }
}

#define CE_DESC(a, b) { const unsigned t_ = (a) > (b) ? (a) : (b); b = (a) > (b) ? (b) : (a); a = t_; }
__device__ __forceinline__ unsigned f2key(float f) { const unsigned u = __float_as_uint(f); return (u & 0x80000000u) ? ~u : (u | 0x80000000u); }
__device__ __forceinline__ float key2f(unsigned k) { const unsigned u = (k & 0x80000000u) ? (k & 0x7fffffffu) : ~k; return __uint_as_float(u); }
template <int N> __device__ __forceinline__ void bitonic_sort_desc(unsigned (&a)[N]) {
#pragma unroll
    for (int k = 2; k <= N; k <<= 1)
#pragma unroll
        for (int j = k >> 1; j > 0; j >>= 1)
#pragma unroll
            for (int i = 0; i < N; ++i) {
                const int l = i ^ j;
                if (l > i) { if ((i & k) == 0) { CE_DESC(a[i], a[l]) } else { CE_DESC(a[l], a[i]) } }
            }
}
template <int N> __device__ __forceinline__ void bitonic_merge_desc(unsigned (&a)[N]) {
#pragma unroll
    for (int j = N >> 1; j > 0; j >>= 1)
#pragma unroll
        for (int i = 0; i < N; ++i) { const int l = i ^ j; if (l > i) { CE_DESC(a[i], a[l]) } }
}
__device__ __forceinline__ void merge_top16(unsigned (&a)[16], const unsigned (&b)[16]) {
#pragma unroll
    for (int i = 0; i < 16; ++i) a[i] = a[i] > b[15 - i] ? a[i] : b[15 - i];
    bitonic_merge_desc<16>(a);
}
__device__ __forceinline__ void xlane_merge_top16(unsigned (&a)[16], int xmask) {
    unsigned b[16];
#pragma unroll
    for (int i = 0; i < 16; ++i) b[i] = (unsigned)__shfl_xor((int)a[i], xmask);
    merge_top16(a, b);
}
__device__ __forceinline__ void phase_peer_select(const bf16_t* __restrict__ H2, const bf16_t* __restrict__ WTQ, const bf16_t* __restrict__ SUBK,
                                  int* __restrict__ EIDX, float* __restrict__ GW, char* lds) {
    const int tid = threadIdx.x, lane = tid & 63, w = tid >> 6, wm = w >> 1, wn = w & 1, lr = lane & 15, lq = lane >> 4;
    const int G = gridDim.x;
    for (int u = blockIdx.x; u < (NTOK / 128) * 8; u += G) {
        const int h = u & 7, mt = u >> 3; const int m0 = mt * 128;
        unsigned* Ll = (unsigned*)(lds + 65536);
#pragma unroll 1
        for (int p = 0; p < 2; ++p) {
            f32x4 acc[4][4]; g_zero(acc);
            g_kloop(H2, 1024, WTQ + (size_t)(h * 256 + p * 128) * 1024, 1024, 1024, m0, 0, lds, acc, tid);
#pragma unroll
            for (int i = 0; i < 4; ++i)
#pragma unroll
                for (int j = 0; j < 4; ++j) {
                    const int tok = wm * 64 + i * 16 + lr; const int d = wn * 64 + j * 16 + lq * 4;
                    *(uint2*)(lds + tok * 256 + (((d >> 3) ^ (tok & 15)) << 4) + (d & 7) * 2) = pack4(acc[i][j][0], acc[i][j][1], acc[i][j][2], acc[i][j][3]);
                }
            { const int c16 = tid & 15, r0 = tid >> 4; const bf16_t* kp = SUBK + (size_t)(h * 2 + p) * 128 * 128;
#pragma unroll
              for (int i = 0; i < 8; ++i) { const int row = r0 + 16 * i; *(uint4*)(lds + 32768 + row * 256 + ((c16 ^ (row & 15)) << 4)) = *(const uint4*)(kp + row * 128 + c16 * 8); } }
            __syncthreads();
            f32x4 sc[2][8];
#pragma unroll
            for (int tt = 0; tt < 2; ++tt)
#pragma unroll
                for (int kt = 0; kt < 8; ++kt) sc[tt][kt] = f32x4{0.f, 0.f, 0.f, 0.f};
#pragma unroll
            for (int ks = 0; ks < 4; ++ks) {
                const int sw = (((ks * 4 + lq) ^ lr) << 4);
                bf16x8 qb[2], ka[8];
#pragma unroll
                for (int tt = 0; tt < 2; ++tt) qb[tt] = *(const bf16x8*)(lds + (w * 32 + tt * 16 + lr) * 256 + sw);
#pragma unroll
                for (int kt = 0; kt < 8; ++kt) ka[kt] = *(const bf16x8*)(lds + 32768 + (kt * 16 + lr) * 256 + sw);
#pragma unroll
                for (int tt = 0; tt < 2; ++tt)
#pragma unroll
                    for (int kt = 0; kt < 8; ++kt) sc[tt][kt] = __builtin_amdgcn_mfma_f32_16x16x32_bf16(ka[kt], qb[tt], sc[tt][kt], 0, 0, 0);
            }
            __syncthreads();
#pragma unroll
            for (int tt = 0; tt < 2; ++tt) {
                __builtin_amdgcn_sched_barrier(0);
                unsigned lo[16], hi[16];
#pragma unroll
                for (int kt = 0; kt < 4; ++kt)
#pragma unroll
                    for (int r = 0; r < 4; ++r) {
                        lo[kt * 4 + r] = (f2key(sc[tt][kt][r]) & ~0x7Fu) | (unsigned)(127 - (kt * 16 + lq * 4 + r));
                        hi[kt * 4 + r] = (f2key(sc[tt][kt + 4][r]) & ~0x7Fu) | (unsigned)(127 - ((kt + 4) * 16 + lq * 4 + r));
                    }
                bitonic_sort_desc<16>(lo); bitonic_sort_desc<16>(hi);
                merge_top16(lo, hi);
                xlane_merge_top16(lo, 16); xlane_merge_top16(lo, 32);
                if (lq == 0) {
                    uint4* dst = (uint4*)(Ll + (w * 32 + tt * 16 + lr) * 32 + p * 16);
                    dst[0] = make_uint4(lo[0], lo[1], lo[2], lo[3]); dst[1] = make_uint4(lo[4], lo[5], lo[6], lo[7]);
                    dst[2] = make_uint4(lo[8], lo[9], lo[10], lo[11]); dst[3] = make_uint4(lo[12], lo[13], lo[14], lo[15]);
                }
            }
        }
        __syncthreads();
#pragma unroll
        for (int tt = 0; tt < 2; ++tt) {
            __builtin_amdgcn_sched_barrier(0);
            const int tokl = w * 32 + tt * 16 + lr;
            float v0[16], v1[16];
            { const uint4* sp = (const uint4*)(Ll + tokl * 32);
#pragma unroll
              for (int q = 0; q < 4; ++q) {
                  const uint4 a = sp[q], b = sp[4 + q];
                  v0[q * 4] = key2f(a.x & ~0x7Fu); v0[q * 4 + 1] = key2f(a.y & ~0x7Fu); v0[q * 4 + 2] = key2f(a.z & ~0x7Fu); v0[q * 4 + 3] = key2f(a.w & ~0x7Fu);
                  v1[q * 4] = key2f(b.x & ~0x7Fu); v1[q * 4 + 1] = key2f(b.y & ~0x7Fu); v1[q * 4 + 2] = key2f(b.z & ~0x7Fu); v1[q * 4 + 3] = key2f(b.w & ~0x7Fu);
              } }
            unsigned c2[16];
#pragma unroll
            for (int r = 0; r < 16; ++r) c2[r] = 0u;
#define CAND(slot, a, b) c2[slot] = (f2key(v0[a] + v1[b]) & ~0xFFu) | (unsigned)(255 - ((a) * 16 + (b)))
            if (lq == 0) {
                CAND(0, 0, 0); CAND(1, 0, 1); CAND(2, 0, 2); CAND(3, 0, 3); CAND(4, 0, 4); CAND(5, 0, 5); CAND(6, 0, 6); CAND(7, 0, 7);
                CAND(8, 0, 8); CAND(9, 0, 9); CAND(10, 0, 10); CAND(11, 0, 11); CAND(12, 0, 12); CAND(13, 0, 13); CAND(14, 0, 14); CAND(15, 0, 15);
            } else if (lq == 1) {
                CAND(0, 8, 0); CAND(1, 9, 0); CAND(2, 10, 0); CAND(3, 11, 0); CAND(4, 12, 0); CAND(5, 13, 0); CAND(6, 14, 0); CAND(7, 15, 0);
                CAND(8, 1, 0); CAND(9, 1, 1); CAND(10, 1, 2); CAND(11, 1, 3); CAND(12, 1, 4); CAND(13, 1, 5); CAND(14, 1, 6); CAND(15, 1, 7);
            } else if (lq == 2) {
                CAND(0, 2, 0); CAND(1, 2, 1); CAND(2, 2, 2); CAND(3, 2, 3); CAND(4, 2, 4); CAND(5, 3, 0); CAND(6, 3, 1); CAND(7, 3, 2);
                CAND(8, 3, 3); CAND(9, 4, 0); CAND(10, 4, 1); CAND(11, 4, 2); CAND(12, 5, 0); CAND(13, 5, 1);
            } else {
                CAND(0, 6, 0); CAND(1, 6, 1); CAND(2, 7, 0); CAND(3, 7, 1);
            }
#undef CAND
            bitonic_sort_desc<16>(c2);
            xlane_merge_top16(c2, 16); xlane_merge_top16(c2, 32);
            if (lq == 0) {
                float s[16]; int ei[16];
#pragma unroll
                for (int r = 0; r < 16; ++r) {
                    const unsigned code = 255u - (c2[r] & 0xFFu);
                    const unsigned k0 = Ll[tokl * 32 + (code >> 4)], k1 = Ll[tokl * 32 + 16 + (code & 15u)];
                    s[r] = key2f(k0 & ~0x7Fu) + key2f(k1 & ~0x7Fu);
                    ei[r] = (int)((127u - (k0 & 0x7Fu)) * 128u + (127u - (k1 & 0x7Fu)));
                }
                float mx = s[0];
#pragma unroll
                for (int r = 1; r < 16; ++r) mx = fmaxf(mx, s[r]);
                float sum = 0.f;
#pragma unroll
                for (int r = 0; r < 16; ++r) { s[r] = __expf(s[r] - mx); sum += s[r]; }
                const float inv = 1.0f / sum;
                const size_t o = ((size_t)(m0 + tokl) * 8 + h) * 16;
#pragma unroll
                for (int r = 0; r < 16; r += 4) {
                    *(int4*)(EIDX + o + r) = make_int4(ei[r], ei[r + 1], ei[r + 2], ei[r + 3]);
                    *(float4*)(GW + o + r) = make_float4(s[r] * inv, s[r + 1] * inv, s[r + 2] * inv, s[r + 3] * inv);
                }
            }
        }
        __syncthreads();
    }
}

#define DPP_ADD(r, ctrl) r += __builtin_bit_cast(float, __builtin_amdgcn_update_dpp(0, __builtin_bit_cast(int, r), ctrl, 0xf, 0xf, false))
__device__ __forceinline__ float dot8(const uint4& a, const uint4& b, float acc) {
    acc = __builtin_amdgcn_fdot2_f32_bf16(__builtin_bit_cast(bf16v2_t, a.x), __builtin_bit_cast(bf16v2_t, b.x), acc, false);
    acc = __builtin_amdgcn_fdot2_f32_bf16(__builtin_bit_cast(bf16v2_t, a.y), __builtin_bit_cast(bf16v2_t, b.y), acc, false);
    acc = __builtin_amdgcn_fdot2_f32_bf16(__builtin_bit_cast(bf16v2_t, a.z), __builtin_bit_cast(bf16v2_t, b.z), acc, false);
    acc = __builtin_amdgcn_fdot2_f32_bf16(__builtin_bit_cast(bf16v2_t, a.w), __builtin_bit_cast(bf16v2_t, b.w), acc, false);
    return acc;
}
#define PE_LDS_BYTES (65536 + 256)
__device__ __forceinline__ void phase_peer_expert(const unsigned char* __restrict__ HQ, const float* __restrict__ HSC, const int* __restrict__ EIDX, const float* __restrict__ GW,
                                  const unsigned char* __restrict__ DOWNQ, const unsigned char* __restrict__ UPQ, const float* __restrict__ DSC, const float* __restrict__ USC,
                                  const float* __restrict__ mod, const float* __restrict__ final_g, const float* x1src, float* __restrict__ X2, float* out, char* lds) {
    const int tid = threadIdx.x, lane = tid & 63, w = tid >> 6;
    const int r8 = lane >> 3, cp8 = lane & 7;
    int* eid_l = (int*)(lds + w * 16384);
    int* part_l = (int*)(lds + w * 16384 + 8192);
    float* w_l = (float*)part_l;
    float* ssq_l = (float*)(lds + 65536 + w * 64);
    const int nwaves = gridDim.x * 4;
    const int tpw = (NTOK + nwaves - 1) / nwaves;
    const int t_begin = (blockIdx.x * 4 + w) * tpw;
    for (int base = 0; base < tpw; base += 16) {
        const int t0 = t_begin + base;
        int nt = tpw - base; if (nt > 16) nt = 16; if (t0 + nt > NTOK) nt = NTOK - t0; if (nt < 0) nt = 0;
#pragma unroll 4
        for (int i = 0; i < nt; ++i) { eid_l[i * 128 + (lane & 7) * 16 + (lane >> 3)] = EIDX[(size_t)(t0 + i) * 128 + lane]; eid_l[i * 128 + (lane & 7) * 16 + 8 + (lane >> 3)] = EIDX[(size_t)(t0 + i) * 128 + 64 + lane];
                                       part_l[i * 128 + lane] = 0; part_l[i * 128 + 64 + lane] = 0; }
        if (lane < 16) ssq_l[lane] = 0.f;
        __syncthreads();
#pragma unroll 1
        for (int s = 0; s < 8; ++s) {
#pragma unroll 1
            for (int i = 0; i < nt; ++i) {
                const uint4 hq = *(const uint4*)(HQ + (size_t)(t0 + i) * 1024 + s * 128 + cp8 * 16);
                int ev[16];
#pragma unroll
                for (int q = 0; q < 4; ++q) { const int4 e4 = *(const int4*)(eid_l + i * 128 + r8 * 16 + q * 4); ev[q * 4] = e4.x; ev[q * 4 + 1] = e4.y; ev[q * 4 + 2] = e4.z; ev[q * 4 + 3] = e4.w; }
                uint4 dv[16];
#pragma unroll
                for (int j = 0; j < 16; ++j) dv[j] = *(const uint4*)(DOWNQ + (size_t)s * (16384 * 128) + (size_t)ev[j] * 128 + cp8 * 16);
                int res[16];
#pragma unroll
                for (int j = 0; j < 16; ++j) {
                    int sm = __builtin_amdgcn_sdot4((int)dv[j].x, (int)hq.x, 0, false);
                    sm = __builtin_amdgcn_sdot4((int)dv[j].y, (int)hq.y, sm, false);
                    sm = __builtin_amdgcn_sdot4((int)dv[j].z, (int)hq.z, sm, false);
                    sm = __builtin_amdgcn_sdot4((int)dv[j].w, (int)hq.w, sm, false);
                    sm += __builtin_amdgcn_update_dpp(0, sm, 0xB1, 0xf, 0xf, false);
                    sm += __builtin_amdgcn_update_dpp(0, sm, 0x4E, 0xf, 0xf, false);
                    sm += __builtin_amdgcn_update_dpp(0, sm, 0x141, 0xf, 0xf, false);
                    res[j] = sm;
                }
                if (cp8 == 0) {
                    int4* pp = (int4*)(part_l + i * 128 + r8 * 16);
#pragma unroll
                    for (int q = 0; q < 4; ++q) { int4 p4 = pp[q]; p4.x += res[q * 4]; p4.y += res[q * 4 + 1]; p4.z += res[q * 4 + 2]; p4.w += res[q * 4 + 3]; pp[q] = p4; }
                }
            }
        }
        __syncthreads();
#pragma unroll 4
        for (int i = 0; i < nt; ++i) {
            const float hs = HSC[t0 + i];
#pragma unroll
            for (int hf = 0; hf < 2; ++hf) {
                const int q = hf * 64 + lane; const int k = (q & 15) * 8 + (q >> 4); const int e = eid_l[i * 128 + q];
                const float a = (float)part_l[i * 128 + q] * hs * DSC[e];
                w_l[i * 128 + q] = GW[(size_t)(t0 + i) * 128 + k] * gelu_tanh(a) * USC[e];
            }
        }
        __syncthreads();
#pragma unroll 1
        for (int s = 0; s < 8; ++s) {
#pragma unroll 1
            for (int ib = 0; ib < nt; ib += 8) {
                const int il = (ib + r8 < nt) ? ib + r8 : nt - 1;
                const int t = t0 + il; const int b = t / SEQ;
                const int c0 = s * 128 + cp8 * 16;
                float4 xv4[4], g24[4];
#pragma unroll
                for (int q4 = 0; q4 < 4; ++q4) { xv4[q4] = *(const float4*)(x1src + (size_t)t * 1024 + c0 + q4 * 4); g24[q4] = *(const float4*)(mod + b * 6144 + 5120 + c0 + q4 * 4); }
                f32x2_t a2[8];
#pragma unroll
                for (int c = 0; c < 8; ++c) a2[c] = f32x2_t{0.f, 0.f};
                const unsigned char* ubase = UPQ + (size_t)s * (16384 * 128) + cp8 * 16;
#pragma unroll 1
                for (int q0 = 0; q0 < 128; q0 += 16) {
                    int ev[16]; float wv[16];
#pragma unroll
                    for (int q = 0; q < 4; ++q) {
                        const int4 e4 = *(const int4*)(eid_l + il * 128 + q0 + q * 4); ev[q * 4] = e4.x; ev[q * 4 + 1] = e4.y; ev[q * 4 + 2] = e4.z; ev[q * 4 + 3] = e4.w;
                        const float4 w4 = *(const float4*)(w_l + il * 128 + q0 + q * 4); wv[q * 4] = w4.x; wv[q * 4 + 1] = w4.y; wv[q * 4 + 2] = w4.z; wv[q * 4 + 3] = w4.w;
                    }
                    uint4 uv[16];
#pragma unroll
                    for (int j = 0; j < 16; ++j) uv[j] = *(const uint4*)(ubase + (size_t)ev[j] * 128);
#pragma unroll
                    for (int j = 0; j < 16; ++j) {
                        const f32x2_t wk2 = {wv[j], wv[j]};
                        const unsigned uu[4] = {uv[j].x, uv[j].y, uv[j].z, uv[j].w};
#pragma unroll
                        for (int q = 0; q < 4; ++q) {
                            a2[2 * q] = wk2 * __builtin_amdgcn_cvt_pk_f32_fp8((int)uu[q], false) + a2[2 * q];
                            a2[2 * q + 1] = wk2 * __builtin_amdgcn_cvt_pk_f32_fp8((int)uu[q], true) + a2[2 * q + 1];
                        }
                    }
                }
                float sq = 0.f;
#pragma unroll
                for (int q4 = 0; q4 < 4; ++q4) {
                    float4 r; r.x = xv4[q4].x + g24[q4].x * a2[2 * q4][0]; r.y = xv4[q4].y + g24[q4].y * a2[2 * q4][1];
                    r.z = xv4[q4].z + g24[q4].z * a2[2 * q4 + 1][0]; r.w = xv4[q4].w + g24[q4].w * a2[2 * q4 + 1][1];
                    sq += r.x * r.x + r.y * r.y + r.z * r.z + r.w * r.w;
                    if (ib + r8 < nt) *(float4*)(X2 + (size_t)t * 1024 + c0 + q4 * 4) = r;
                }
                sq += __builtin_bit_cast(float, __builtin_amdgcn_update_dpp(0, __builtin_bit_cast(int, sq), 0xB1, 0xf, 0xf, false));
                sq += __builtin_bit_cast(float, __builtin_amdgcn_update_dpp(0, __builtin_bit_cast(int, sq), 0x4E, 0xf, 0xf, false));
                sq += __builtin_bit_cast(float, __builtin_amdgcn_update_dpp(0, __builtin_bit_cast(int, sq), 0x141, 0xf, 0xf, false));
                if (cp8 == 0 && ib + r8 < nt) ssq_l[il] += sq;
            }
        }
        asm volatile("s_waitcnt vmcnt(0)" ::: "memory");
        __syncthreads();
#pragma unroll 4
        for (int i = 0; i < nt; ++i) {
            const int t = t0 + i;
            const float rn = rsqrtf(ssq_l[i] * (1.0f / 1024.0f) + EPS);
#pragma unroll
            for (int q4 = 0; q4 < 4; ++q4) {
                const int c = q4 * 256 + lane * 4;
                const float4 xv = *(const float4*)(X2 + (size_t)t * 1024 + c);
                const float4 fg = *(const float4*)(final_g + c);
                float4 r; r.x = xv.x * rn * fg.x; r.y = xv.y * rn * fg.y; r.z = xv.z * rn * fg.z; r.w = xv.w * rn * fg.w;
                *(float4*)(out + (size_t)t * 1024 + c) = r;
            }
        }
        __syncthreads();
    }
}


#define XB_TMO      128
#define XB_XCNT(j)  (256  + 64 * (j))
#define XB_XSUB(j)  (1280 + 64 * (j))
#define XB_XGEN(j)  (2304 + 64 * (j))
#define XB_TOP      3328
#define XB_TOPGEN   3392
#define XCD_BAR_WORDS 3456
#define XB_SPIN_CAP (1u << 22)
__device__ __forceinline__ unsigned xb_ld(unsigned* p)              { return __hip_atomic_load(p, __ATOMIC_RELAXED, __HIP_MEMORY_SCOPE_AGENT); }
__device__ __forceinline__ unsigned xb_add(unsigned* p, unsigned v) { return __hip_atomic_fetch_add(p, v, __ATOMIC_RELAXED, __HIP_MEMORY_SCOPE_AGENT); }
__device__ __forceinline__ unsigned xb_xcc_id() { return (unsigned)__builtin_amdgcn_s_getreg((3 << 11) | 20) & 0xFu; }
#define XB_SPIN(cond, bar) do { unsigned _sp = 0; while (cond) { __builtin_amdgcn_s_sleep(1); \
    if ((++_sp & 255u) == 0u) { if (xb_ld(&(bar)[XB_TMO])) break; if (_sp > XB_SPIN_CAP) { atomicAdd(&(bar)[XB_TMO], 1u); break; } } } } while (0)
struct XcdBarrier { unsigned* bar; unsigned x; unsigned nloc; unsigned nx; };
__device__ __forceinline__ void xcd_barrier_post(XcdBarrier& b, unsigned* bar) {
    b.bar = bar; b.x = xb_xcc_id(); b.nloc = 0u; b.nx = 0u;
    if (threadIdx.x == 0) (void)xb_add(&bar[XB_XCNT(b.x)], 1u);
}
__device__ __forceinline__ void xcd_barrier_complete(unsigned* bar, unsigned x, unsigned& nloc, unsigned& nx) {
    const unsigned G = gridDim.x;
    unsigned sum, cnt, mine, sp = 0u;
    for (;;) {
        sum = 0u; cnt = 0u; mine = 0u;
#pragma unroll
        for (unsigned j = 0; j < 16; ++j) { const unsigned c = xb_ld(&bar[XB_XCNT(j)]); sum += c; cnt += (c > 0u) ? 1u : 0u; mine = (j == x) ? c : mine; }
        if (sum == G) break;
        __builtin_amdgcn_s_sleep(1);
        if ((++sp & 255u) == 0u) { if (xb_ld(&bar[XB_TMO])) break; if (sp > XB_SPIN_CAP) { atomicAdd(&bar[XB_TMO], 1u); break; } }
    }
    nloc = mine > 0u ? mine : 1u; nx = cnt > 0u ? cnt : 1u;
}
__device__ __forceinline__ void xcd_barrier(XcdBarrier& b) {
    asm volatile("s_waitcnt vmcnt(0)" ::: "memory");
    __syncthreads();
    if (threadIdx.x == 0) {
        unsigned* bar = b.bar;
        __builtin_amdgcn_s_waitcnt(0);
        if (b.nloc == 0u) xcd_barrier_complete(bar, b.x, b.nloc, b.nx);
        const unsigned nloc = b.nloc, nx = b.nx;
        const unsigned old = xb_add(&bar[XB_XSUB(b.x)], 1u);
        const unsigned gen = old / nloc;
        if (old + 1u == (gen + 1u) * nloc) {
            __builtin_amdgcn_fence(__ATOMIC_RELEASE, "agent");
            asm volatile("s_waitcnt vmcnt(0)" ::: "memory");
            const unsigned og = xb_add(&bar[XB_TOP], 1u);
            const unsigned tg = og / nx;
            if (og + 1u == (tg + 1u) * nx) xb_add(&bar[XB_TOPGEN], 1u);
            else XB_SPIN(xb_ld(&bar[XB_TOPGEN]) == tg, bar);
            __builtin_amdgcn_fence(__ATOMIC_ACQUIRE, "agent");
            xb_add(&bar[XB_XGEN(b.x)], 1u);
            asm volatile("s_waitcnt vmcnt(0)" ::: "memory");
        } else {
            XB_SPIN(xb_ld(&bar[XB_XGEN(b.x)]) == gen, bar);
            __builtin_amdgcn_fence(__ATOMIC_ACQUIRE, "agent");
            asm volatile("s_waitcnt vmcnt(0)" ::: "memory");
        }
    }
    __syncthreads();
}

__device__ __forceinline__ void prep_convT(const float* __restrict__ srcp, bf16_t* __restrict__ dst, int K, int N, char* lds, int& cursor) {
    float (*tile)[32][33] = (float (*)[32][33])lds;
    const int tx = threadIdx.x & 31, ty = threadIdx.x >> 5;
    const int ntn = N / 32, ntiles = ntn * (K / 32);
    const int G = gridDim.x;
    const int first = ((int)blockIdx.x - cursor % G + G) % G;
    for (int t = first; t < ntiles; t += 4 * G) {
#pragma unroll
        for (int u = 0; u < 4; ++u) {
            const int tt = t + u * G;
            if (tt < ntiles) { const int n0 = (tt % ntn) * 32, k0 = (tt / ntn) * 32;
#pragma unroll
                for (int i = 0; i < 4; ++i) tile[u][ty + 8 * i][tx] = srcp[(size_t)(k0 + ty + 8 * i) * N + n0 + tx]; }
        }
        __syncthreads();
#pragma unroll
        for (int u = 0; u < 4; ++u) {
            const int tt = t + u * G;
            if (tt < ntiles) { const int n0 = (tt % ntn) * 32, k0 = (tt / ntn) * 32;
#pragma unroll
                for (int i = 0; i < 4; ++i) dst[(size_t)(n0 + ty + 8 * i) * K + k0 + tx] = f2bf(tile[u][tx][ty + 8 * i]); }
        }
        __syncthreads();
    }
    cursor += ntiles;
}
__device__ __forceinline__ void prep_conv(const float* __restrict__ srcp, bf16_t* __restrict__ dst, size_t n8) {
    for (size_t i = (size_t)blockIdx.x * blockDim.x + threadIdx.x; i < n8; i += (size_t)gridDim.x * blockDim.x) {
        const float4 a = *(const float4*)(srcp + i * 8), b = *(const float4*)(srcp + i * 8 + 4);
        uint4 o; o.x = pack2(a.x, a.y); o.y = pack2(a.z, a.w); o.z = pack2(b.x, b.y); o.w = pack2(b.z, b.w);
        *(uint4*)(dst + i * 8) = o;
    }
}
__device__ __forceinline__ void prep_ada(const float* __restrict__ c, const float* __restrict__ w_ada, const float* __restrict__ b_ada, float* __restrict__ mod, char* lds) {
    float* sc = (float*)lds;
    float* part = (float*)(lds + 16384);
    const int tid = threadIdx.x, col = tid & 63, kq = tid >> 6;
    const int G = gridDim.x;
    for (int item = (int)blockIdx.x - (G - 96 > 0 ? G - 96 : 0); item >= 0 && item < 96; item += G) {
        __syncthreads();
        for (int i = tid; i < 4096; i += 256) { const float v = c[i]; sc[i] = v * sigmoidf_(v); }
        __syncthreads();
        const int e = item * 64 + col;
        float a0 = 0.f, a1 = 0.f, a2 = 0.f, a3 = 0.f;
#pragma unroll 16
        for (int d = kq * 256; d < kq * 256 + 256; ++d) {
            const float wv = w_ada[(size_t)d * 6144 + e];
            a0 += sc[d] * wv; a1 += sc[1024 + d] * wv; a2 += sc[2048 + d] * wv; a3 += sc[3072 + d] * wv;
        }
        part[(kq * 4 + 0) * 64 + col] = a0; part[(kq * 4 + 1) * 64 + col] = a1; part[(kq * 4 + 2) * 64 + col] = a2; part[(kq * 4 + 3) * 64 + col] = a3;
        __syncthreads();
        { const int b = tid >> 6;
          const float s = part[(0 * 4 + b) * 64 + col] + part[(1 * 4 + b) * 64 + col] + part[(2 * 4 + b) * 64 + col] + part[(3 * 4 + b) * 64 + col];
          mod[b * 6144 + e] = s + b_ada[e]; }
    }
    if (G < 96) {
        for (int item = (int)blockIdx.x + G; item < 96; item += G) { (void)item; }
    }
}

__device__ __forceinline__ void prep_quant(const float* __restrict__ srcp, unsigned char* __restrict__ dst, float* __restrict__ scales, int rows, int off) {
    const int lane = threadIdx.x & 63, w = threadIdx.x >> 6;
    const int nwaves = gridDim.x * 4;
    for (int rb = (blockIdx.x * 4 + w) * 4; rb < rows; rb += nwaves * 4) {
        float4 v[4][4];
#pragma unroll
        for (int u = 0; u < 4; ++u)
#pragma unroll
            for (int j = 0; j < 4; ++j) v[u][j] = *(const float4*)(srcp + (size_t)(rb + u) * 1024 + lane * 16 + j * 4);
#pragma unroll
        for (int u = 0; u < 4; ++u) {
            const int r = rb + u;
            float am = 0.f;
#pragma unroll
            for (int j = 0; j < 4; ++j) am = fmaxf(am, fmaxf(fmaxf(fabsf(v[u][j].x), fabsf(v[u][j].y)), fmaxf(fabsf(v[u][j].z), fabsf(v[u][j].w))));
            for (int o = 32; o > 0; o >>= 1) am = fmaxf(am, __shfl_xor(am, o));
            unsigned o4[4];
            if (off < 0) {
                const float inv8 = am > 0.f ? 448.0f / am : 0.f;
                if (lane == 0) scales[r] = am > 0.f ? am * (1.0f / 448.0f) : 1.0f;
#pragma unroll
                for (int j = 0; j < 4; ++j) {
                    int p = 0;
                    p = __builtin_amdgcn_cvt_pk_fp8_f32(v[u][j].x * inv8, v[u][j].y * inv8, p, false);
                    p = __builtin_amdgcn_cvt_pk_fp8_f32(v[u][j].z * inv8, v[u][j].w * inv8, p, true);
                    o4[j] = (unsigned)p;
                }
            } else {
                const float inv = am > 0.f ? 127.0f / am : 0.f;
                if (lane == 0) scales[r] = am > 0.f ? am * (1.0f / 127.0f) : 1.0f;
#pragma unroll
                for (int j = 0; j < 4; ++j) {
                    const int q0 = __float2int_rn(v[u][j].x * inv) + off, q1 = __float2int_rn(v[u][j].y * inv) + off, q2 = __float2int_rn(v[u][j].z * inv) + off, q3 = __float2int_rn(v[u][j].w * inv) + off;
                    o4[j] = (unsigned)(q0 & 0xff) | ((unsigned)(q1 & 0xff) << 8) | ((unsigned)(q2 & 0xff) << 16) | ((unsigned)(q3 & 0xff) << 24);
                }
            }
            *(uint4*)(dst + (size_t)(lane >> 3) * ((size_t)rows * 128) + (size_t)r * 128 + (lane & 7) * 16) = make_uint4(o4[0], o4[1], o4[2], o4[3]);
        }
    }
}
template <bool QUANT>
__device__ __forceinline__ void phase_norm(const float* __restrict__ x, const float* __restrict__ g, const float* __restrict__ mod, int sh_off, int sc_off, bf16_t* __restrict__ H,
                                           unsigned char* __restrict__ HQ, float* __restrict__ HSC) {
    const int lane = threadIdx.x & 63, w = threadIdx.x >> 6;
    const int nwaves = gridDim.x * 4;
    for (int tb = (blockIdx.x * 4 + w) * 2; tb < NTOK; tb += nwaves * 2) {
        float4 v[2][4];
#pragma unroll
        for (int u = 0; u < 2; ++u)
#pragma unroll
            for (int j = 0; j < 4; ++j) v[u][j] = *(const float4*)(x + (size_t)(tb + u) * 1024 + j * 256 + lane * 4);
#pragma unroll
        for (int u = 0; u < 2; ++u) {
            const int t = tb + u; const int b = t / SEQ;
            float ss = 0.f;
#pragma unroll
            for (int j = 0; j < 4; ++j) ss += v[u][j].x * v[u][j].x + v[u][j].y * v[u][j].y + v[u][j].z * v[u][j].z + v[u][j].w * v[u][j].w;
            for (int o = 32; o > 0; o >>= 1) ss += __shfl_xor(ss, o);
            const float r = rsqrtf(ss * (1.0f / 1024.0f) + EPS);
            float am = 0.f;
#pragma unroll
            for (int j = 0; j < 4; ++j) {
                const int c = j * 256 + lane * 4;
                const float4 gg = *(const float4*)(g + c), sc = *(const float4*)(mod + b * 6144 + sc_off + c), sh = *(const float4*)(mod + b * 6144 + sh_off + c);
                float4& vv = v[u][j];
                vv.x = vv.x * r * gg.x * (1.0f + sc.x) + sh.x; vv.y = vv.y * r * gg.y * (1.0f + sc.y) + sh.y;
                vv.z = vv.z * r * gg.z * (1.0f + sc.z) + sh.z; vv.w = vv.w * r * gg.w * (1.0f + sc.w) + sh.w;
                *(uint2*)(H + (size_t)t * 1024 + c) = pack4(vv.x, vv.y, vv.z, vv.w);
                if (QUANT) am = fmaxf(am, fmaxf(fmaxf(fabsf(vv.x), fabsf(vv.y)), fmaxf(fabsf(vv.z), fabsf(vv.w))));
            }
            if (QUANT) {
                for (int o = 32; o > 0; o >>= 1) am = fmaxf(am, __shfl_xor(am, o));
                const float inv = am > 0.f ? 127.0f / am : 0.f;
                if (lane == 0) HSC[t] = am > 0.f ? am * (1.0f / 127.0f) : 1.0f;
#pragma unroll
                for (int j = 0; j < 4; ++j) {
                    const float4 vv = v[u][j];
                    const int q0 = __float2int_rn(vv.x * inv), q1 = __float2int_rn(vv.y * inv), q2 = __float2int_rn(vv.z * inv), q3 = __float2int_rn(vv.w * inv);
                    *(unsigned*)(HQ + (size_t)t * 1024 + j * 256 + lane * 4) = (unsigned)(q0 & 0xff) | ((unsigned)(q1 & 0xff) << 8) | ((unsigned)(q2 & 0xff) << 16) | ((unsigned)(q3 & 0xff) << 24);
                }
            }
        }
    }
}
struct MegaParams {
    const float* in[24];
    float* out;
    char* ws;
    int use_cg; int pad;
};
#define MEGA_LDS_BYTES 81920
#ifndef PROBE_DUP
#define PROBE_DUP 0
#endif
#define W_CTL   ((float*)(ws + OFF_CTL))
#define W_MOD   ((float*)(ws + OFF_MOD))
#define W_WTIN  ((bf16_t*)(ws + OFF_WTIN))
#define W_WTA   ((bf16_t*)(ws + OFF_WTA))
#define W_WTB   ((bf16_t*)(ws + OFF_WTB))
#define W_WTOUT ((bf16_t*)(ws + OFF_WTOUT))
#define W_WTQ   ((bf16_t*)(ws + OFF_WTQ))
#define W_SUBK  ((bf16_t*)(ws + OFF_SUBK))
#define W_DOWN  ((bf16_t*)(ws + OFF_DOWN))
#define W_UP    ((bf16_t*)(ws + OFF_UP))
#define W_H     ((bf16_t*)(ws + OFF_H))
#define W_Q     ((bf16_t*)(ws + OFF_Q))
#define W_K     ((bf16_t*)(ws + OFF_K))
#define W_V     ((bf16_t*)(ws + OFF_VT))
#define W_U     ((bf16_t*)(ws + OFF_U))
#define W_SV    ((bf16_t*)(ws + OFF_SV))
#define W_GATES ((bf16_t*)(ws + OFF_GATES))
#define W_YA    ((bf16_t*)(ws + OFF_YA))
#define W_YB    ((bf16_t*)(ws + OFF_YB))
#define W_MERGED ((bf16_t*)(ws + OFF_MERGED))
#define W_EIDX  ((int*)(ws + OFF_EIDX))
#define W_GW    ((float*)(ws + OFF_GW))
__global__ __launch_bounds__(256, 2) void k_mega(MegaParams P) {
    cg::grid_group grid = cg::this_grid();
    char* lds = dyn_lds; char* ws = P.ws;
    const float* x = P.in[0];
    XcdBarrier xb; xcd_barrier_post(xb, (unsigned*)(ws + OFF_BAR));
    prep_ada(P.in[1], P.in[2], P.in[3], W_MOD, lds);
    if (blockIdx.x == 0 && threadIdx.x == 0) {
        float s1 = 0.f, s2 = 0.f;
        for (int i = 0; i < 64; ++i) { s1 += P.in[6][i] * P.in[7][i]; s2 += P.in[8][i] * P.in[9][i]; }
        W_CTL[0] = __expf(s1) - __expf(s2) + 0.2f;
    }
    { int cursor = 0;
      __syncthreads();
      prep_convT(P.in[5], W_WTIN, 1024, IN_COLS, lds, cursor);
      prep_convT(P.in[15], W_WTA, 512, 1024, lds, cursor);
      prep_convT(P.in[16], W_WTB, 512, 1024, lds, cursor);
      prep_convT(P.in[17], W_WTOUT, 1024, 1024, lds, cursor);
      prep_convT(P.in[19], W_WTQ, 1024, 2048, lds, cursor); }
    prep_conv(P.in[20], W_SUBK, (size_t)8 * 2 * 128 * 128 / 8);
    if (P.use_cg) grid.sync(); else xcd_barrier(xb);
    phase_norm<false>(x, P.in[4], W_MOD, 0, 1024, W_H, nullptr, nullptr);
    xcd_barrier(xb);
#if PROBE_DUP == 2
    phase_inproj(W_H, W_WTIN, W_Q, W_K, W_V, W_U, W_SV, W_GATES, lds);
#endif
    phase_inproj(W_H, W_WTIN, W_Q, W_K, W_V, W_U, W_SV, W_GATES, lds);
    xcd_barrier(xb);
    { const bool sgu_first = ((blockIdx.x >> 3) & 1) != 0;
      if (sgu_first) phase_sgu(W_U, W_SV, P.in[11], P.in[12], P.in[13], P.in[14], W_YB, lds);
      if (sgu_first) { prep_quant(P.in[21], (unsigned char*)(ws + OFF_DOWN), (float*)(ws + OFF_DSC), 16384, 0); prep_quant(P.in[22], (unsigned char*)(ws + OFF_UP), (float*)(ws + OFF_USC), 16384, -1); }
      phase_attn(W_Q, W_K, W_V, W_CTL, P.in[10], W_YA, lds);
      if (!sgu_first) { prep_quant(P.in[21], (unsigned char*)(ws + OFF_DOWN), (float*)(ws + OFF_DSC), 16384, 0); prep_quant(P.in[22], (unsigned char*)(ws + OFF_UP), (float*)(ws + OFF_USC), 16384, -1);
                        phase_sgu(W_U, W_SV, P.in[11], P.in[12], P.in[13], P.in[14], W_YB, lds); } }
    xcd_barrier(xb);
#if PROBE_DUP == 5
    phase_merged(W_YA, W_YB, W_WTA, W_WTB, W_GATES, W_MERGED, lds);
#endif
    phase_merged(W_YA, W_YB, W_WTA, W_WTB, W_GATES, W_MERGED, lds);
    xcd_barrier(xb);
#if PROBE_DUP == 6
    phase_outproj(W_MERGED, W_WTOUT, x, W_MOD, P.out, lds);
#endif
    phase_outproj(W_MERGED, W_WTOUT, x, W_MOD, P.out, lds);
    xcd_barrier(xb);
    phase_norm<true>(P.out, P.in[18], W_MOD, 3072, 4096, W_H, (unsigned char*)(ws + OFF_HQ), (float*)(ws + OFF_HSC));
    xcd_barrier(xb);
#if PROBE_DUP == 8
    phase_peer_select(W_H, W_WTQ, W_SUBK, W_EIDX, W_GW, lds);
#endif
    phase_peer_select(W_H, W_WTQ, W_SUBK, W_EIDX, W_GW, lds);
    xcd_barrier(xb);
    phase_peer_expert((const unsigned char*)(ws + OFF_HQ), (const float*)(ws + OFF_HSC), W_EIDX, W_GW, (const unsigned char*)(ws + OFF_DOWN), (const unsigned char*)(ws + OFF_UP), (const float*)(ws + OFF_DSC), (const float*)(ws + OFF_USC), W_MOD, P.in[23], P.out, (float*)(ws + OFF_GATES), P.out, lds);
}

extern "C" void kernel_launch(void* const* d_in, const int* in_sizes, int n_in, void* d_out, int out_size, void* d_ws, size_t ws_size, hipStream_t stream) {
    if (ws_size < OFF_END || n_in < 24) return;
    static int grid_blocks = 0;
    if (!grid_blocks) {
        int dev = 0, cus = 0, per_cu = 0;
        hipGetDevice(&dev);
        hipDeviceGetAttribute(&cus, hipDeviceAttributeMultiprocessorCount, dev);
        hipFuncSetAttribute((const void*)k_mega, hipFuncAttributeMaxDynamicSharedMemorySize, MEGA_LDS_BYTES);
        hipOccupancyMaxActiveBlocksPerMultiprocessor(&per_cu, k_mega, 256, MEGA_LDS_BYTES);
        if (per_cu > 2) per_cu = 2;
        if (per_cu < 1) per_cu = 1;
        grid_blocks = cus * per_cu;
    }
    MegaParams P{};
    for (int i = 0; i < 24; ++i) P.in[i] = (const float*)d_in[i];
    P.out = (float*)d_out; P.ws = (char*)d_ws;
    hipMemsetAsync((char*)d_ws + OFF_BAR, 0, XCD_BAR_WORDS * 4, stream);
    void* args[] = {&P};
    hipError_t e = hipLaunchCooperativeKernel((void*)k_mega, dim3(grid_blocks), dim3(256), args, MEGA_LDS_BYTES, stream);
    if (e != hipSuccess) fprintf(stderr, "cooperative launch failed: %s (grid %d)\n", hipGetErrorString(e), grid_blocks);
}
```

```cpp
#include <hip/hip_runtime.h>
#include <hip/hip_cooperative_groups.h>
#include <stdint.h>
#include <stdio.h>
namespace cg = cooperative_groups;

typedef unsigned short bf16_t;

#define D_MODEL 1024
#define BATCH 4
#define SEQ 8192
#define NTOK (BATCH * SEQ)
#define IN_COLS 4608
#define EPS 1e-6f
#define QSCALE 0.18033688011112042f

__device__ __forceinline__ float bf2f(bf16_t v) { return __uint_as_float(((unsigned)v) << 16); }
typedef __bf16 bf16v2_t __attribute__((ext_vector_type(2)));
__device__ __forceinline__ bf16_t f2bf(float f) { return __builtin_bit_cast(unsigned short, (__bf16)f); }
__device__ __forceinline__ unsigned pack2(float a, float b) { bf16v2_t v; v[0] = (__bf16)a; v[1] = (__bf16)b; return __builtin_bit_cast(unsigned, v); }
__device__ __forceinline__ float gelu_tanh(float x) {
    const float z2 = 1.5957691216057308f * (x + 0.044715f * x * x * x);
    return x * __builtin_amdgcn_rcpf(1.0f + __expf(-z2));
}
__device__ __forceinline__ float sigmoidf_(float x) { return __builtin_amdgcn_rcpf(1.0f + __expf(-x)); }

constexpr size_t OFF_CTL   = 0;
constexpr size_t OFF_BAR   = 4096;
constexpr size_t OFF_MOD   = 4096 + 16384;
constexpr size_t OFF_STATS = OFF_MOD + 4 * 6144 * 4;
constexpr size_t OFF_WTIN  = OFF_STATS + (size_t)NTOK * 2 * 4;
constexpr size_t OFF_WTA   = OFF_WTIN + (size_t)IN_COLS * 1024 * 2;
constexpr size_t OFF_WTB   = OFF_WTA + (size_t)1024 * 512 * 2;
constexpr size_t OFF_WTOUT = OFF_WTB + (size_t)1024 * 512 * 2;
constexpr size_t OFF_WTQ   = OFF_WTOUT + (size_t)1024 * 1024 * 2;
constexpr size_t OFF_SUBK  = OFF_WTQ + (size_t)2048 * 1024 * 2;
constexpr size_t OFF_DOWN  = OFF_SUBK + (size_t)8 * 2 * 128 * 128 * 2;
constexpr size_t OFF_UP    = OFF_DOWN + (size_t)16384 * 1024;
constexpr size_t OFF_DSC   = OFF_UP + (size_t)16384 * 1024;
constexpr size_t OFF_USC   = OFF_DSC + (size_t)16384 * 4;
constexpr size_t OFF_H     = OFF_USC + (size_t)16384 * 4;
constexpr size_t OFF_Q     = OFF_H + (size_t)NTOK * 1024 * 2;
constexpr size_t OFF_K     = OFF_Q + (size_t)NTOK * 512 * 2;
constexpr size_t OFF_VT    = OFF_K + (size_t)NTOK * 512 * 2;
constexpr size_t OFF_U     = OFF_VT + (size_t)NTOK * 512 * 2;
constexpr size_t OFF_SV    = OFF_U + (size_t)NTOK * 512 * 2;
constexpr size_t OFF_GATES = OFF_SV + (size_t)NTOK * 512 * 2;
constexpr size_t OFF_YA    = OFF_GATES + (size_t)NTOK * 2048 * 2;
constexpr size_t OFF_YB    = OFF_YA + (size_t)NTOK * 512 * 2;
constexpr size_t OFF_END   = OFF_YB + (size_t)NTOK * 512 * 2;
constexpr size_t OFF_MERGED = OFF_Q;
constexpr size_t OFF_EIDX  = OFF_U;
constexpr size_t OFF_GW    = OFF_SV;
constexpr size_t OFF_HQ    = OFF_YA;
constexpr size_t OFF_HSC   = OFF_STATS;

#define NW 8
#define NTHR (NW * 64)
extern __shared__ __attribute__((aligned(16))) char dyn_lds[];
using bf16x8 = __attribute__((ext_vector_type(8))) short;
using f32x4 = __attribute__((ext_vector_type(4))) float;
typedef float f32x2_t __attribute__((ext_vector_type(2)));
typedef __attribute__((address_space(3))) char* lds_ptr_t;
#define GEMM_LDS_BYTES 65536
#define SEL_LDS_BYTES 81920

__device__ __forceinline__ uint2 pack4(float a, float b, float c, float d) {
    uint2 r; r.x = pack2(a, b); r.y = pack2(c, d); return r;
}

__device__ __forceinline__ void g_compute(const char* sA, const char* sB, f32x4 (&acc)[4][4], int wm, int wn, int lane) {
    const int lr = lane & 15, lq = lane >> 4;
#pragma unroll
    for (int ks = 0; ks < 2; ++ks) {
        bf16x8 a[4], b[4];
        const int sw = (((ks * 4 + lq) ^ (lr & 7)) << 4);
#pragma unroll
        for (int i = 0; i < 4; ++i) a[i] = *(const bf16x8*)(sA + (wm * 64 + i * 16 + lr) * 128 + sw);
#pragma unroll
        for (int j = 0; j < 4; ++j) b[j] = *(const bf16x8*)(sB + (wn * 64 + j * 16 + lr) * 128 + sw);
#pragma unroll
        for (int i = 0; i < 4; ++i)
#pragma unroll
            for (int j = 0; j < 4; ++j) acc[i][j] = __builtin_amdgcn_mfma_f32_16x16x32_bf16(b[j], a[i], acc[i][j], 0, 0, 0);
    }
}
template <int PPW>
__device__ __forceinline__ void g_dma(const bf16_t* __restrict__ A, int lda, int m0, int k0, char* lds_tile, int lane, int w) {
    const int rl = lane >> 3, pc = lane & 7;
#pragma unroll
    for (int i = 0; i < PPW; ++i) {
        const int n = w * PPW + i; const int row = 8 * n + rl;
        __builtin_amdgcn_global_load_lds((const unsigned*)(A + (size_t)(m0 + row) * lda + k0 + ((pc ^ (row & 7)) << 3)),
                                         (__attribute__((address_space(3))) unsigned*)(lds_ptr_t)(lds_tile + n * 1024), 16, 0, 0);
    }
}
#define G_STAGE 49152
__device__ __forceinline__ void g_kloop(const bf16_t* __restrict__ A, int lda, const bf16_t* __restrict__ Bt, int ldb, int K, int m0, int n0,
                                        char* lds, f32x4 (&acc)[4][4], int tid) {
    const int lane = tid & 63, w = __builtin_amdgcn_readfirstlane(tid >> 6), wm = w >> 1, wn = w & 1;
    g_dma<4>(A, lda, m0, 0, lds, lane, w); g_dma<2>(Bt, ldb, n0, 0, lds + 32768, lane, w);
    asm volatile("s_waitcnt vmcnt(0)" ::: "memory");
    __syncthreads();
    const int nk = K >> 6;
    for (int kt = 0; kt < nk; ++kt) {
        char* cur = lds + (kt & 1) * G_STAGE; char* nxt = lds + ((kt + 1) & 1) * G_STAGE;
        if (kt + 1 < nk) { g_dma<4>(A, lda, m0, (kt + 1) * 64, nxt, lane, w); g_dma<2>(Bt, ldb, n0, (kt + 1) * 64, nxt + 32768, lane, w); }
        g_compute(cur, cur + 32768, acc, wm, wn, lane);
        asm volatile("s_waitcnt vmcnt(0)" ::: "memory");
        __syncthreads();
    }
}
__device__ __forceinline__ void g_zero(f32x4 (&acc)[4][4]) {
#pragma unroll
    for (int i = 0; i < 4; ++i)
#pragma unroll
        for (int j = 0; j < 4; ++j) acc[i][j] = f32x4{0.f, 0.f, 0.f, 0.f};
}
__device__ __forceinline__ void g_tilemap(int it, int nMt, int nNt, int& mt, int& nt, bool& valid) {
    const int G = gridDim.x, bid = blockIdx.x;
    if ((G & 7) == 0 && (nMt & 63) == 0) {
        const int x = bid & 7, slot = bid >> 3, nslot = G >> 3;
        const int u = it * nslot + slot;
        const int mPer = nMt >> 3;
        valid = u < mPer * nNt;
        const int SBN = (nNt % 9 == 0) ? 9 : ((nNt % 8 == 0) ? 8 : nNt);
        const int sbPerRow = nNt / SBN;
        const int sb = u / (8 * SBN), within = u % (8 * SBN);
        const int sbm = sb / sbPerRow, sbn = sb % sbPerRow;
        mt = x * mPer + sbm * 8 + within / SBN;
        nt = sbn * SBN + within % SBN;
    } else {
        const int t = it * G + bid;
        valid = t < nMt * nNt;
        mt = t / nNt; nt = t % nNt;
    }
}
#define G_EPI_LOOP(...) \
    { const int lane_ = tid & 63, w_ = tid >> 6, wm_ = w_ >> 1, wn_ = w_ & 1, lr_ = lane_ & 15, lq_ = lane_ >> 4; \
      _Pragma("unroll") for (int i = 0; i < 4; ++i) _Pragma("unroll") for (int j = 0; j < 4; ++j) { \
        const int m = m0 + wm_ * 64 + i * 16 + lr_; const int n = n0 + wn_ * 64 + j * 16 + lq_ * 4; const f32x4 v = acc[i][j]; __VA_ARGS__ } }


#define GW_STAGE 32768
__device__ __forceinline__ void gw_dma(const bf16_t* __restrict__ A, int lda, const bf16_t* __restrict__ Bt, int ldb, int m0, int n0, int k0, char* stage, int lane, int w) {
    const int rl = lane >> 2, pc = lane & 3;
    const int sc = (pc ^ ((-(rl >> 2)) & 3)) << 3;
#pragma unroll
    for (int i = 0; i < 2; ++i) {
        const int n = w * 2 + i;
        __builtin_amdgcn_global_load_lds((const unsigned*)(A + (size_t)(m0 + n * 16 + rl) * lda + k0 + sc),
                                         (__attribute__((address_space(3))) unsigned*)(lds_ptr_t)(stage + n * 1024), 16, 0, 0);
        __builtin_amdgcn_global_load_lds((const unsigned*)(Bt + (size_t)(n0 + n * 16 + rl) * ldb + k0 + sc),
                                         (__attribute__((address_space(3))) unsigned*)(lds_ptr_t)(stage + 16384 + n * 1024), 16, 0, 0);
    }
}
__device__ __forceinline__ void gw_compute(const char* stage, f32x4 (&acc)[4][8], int wm, int wn, int lane) {
    const int lr = lane & 15, lq = lane >> 4;
    const int sw = (lq ^ ((-(lr >> 2)) & 3)) << 4;
    bf16x8 a[4], b[8];
#pragma unroll
    for (int i = 0; i < 4; ++i) a[i] = *(const bf16x8*)(stage + (wm * 64 + i * 16 + lr) * 64 + sw);
#pragma unroll
    for (int j = 0; j < 8; ++j) b[j] = *(const bf16x8*)(stage + 16384 + (wn * 128 + j * 16 + lr) * 64 + sw);
#pragma unroll
    for (int i = 0; i < 4; ++i)
#pragma unroll
        for (int j = 0; j < 8; ++j) acc[i][j] = __builtin_amdgcn_mfma_f32_16x16x32_bf16(b[j], a[i], acc[i][j], 0, 0, 0);
}
__device__ __forceinline__ void gw_kloop(const bf16_t* __restrict__ A, int lda, const bf16_t* __restrict__ Bt, int ldb, int K, int m0, int n0,
                                         char* lds, f32x4 (&acc)[4][8], int tid) {
    const int lane = tid & 63, w = __builtin_amdgcn_readfirstlane(tid >> 6), wm = w >> 1, wn = w & 1;
    const int nk = K >> 5;
    gw_dma(A, lda, Bt, ldb, m0, n0, 0, lds, lane, w);
    gw_dma(A, lda, Bt, ldb, m0, n0, 32, lds + GW_STAGE, lane, w);
    int cur = 0;
    for (int kt = 0; kt < nk; ++kt) {
        if (kt + 1 < nk) asm volatile("s_waitcnt vmcnt(4)" ::: "memory"); else asm volatile("s_waitcnt vmcnt(0)" ::: "memory");
        asm volatile("s_waitcnt lgkmcnt(0)" ::: "memory");
        __builtin_amdgcn_s_barrier();
        if (kt + 2 < nk) { int nx = cur + 2; if (nx >= 3) nx -= 3; gw_dma(A, lda, Bt, ldb, m0, n0, (kt + 2) * 32, lds + nx * GW_STAGE, lane, w); }
        gw_compute(lds + cur * GW_STAGE, acc, wm, wn, lane);
        cur = (cur == 2) ? 0 : cur + 1;
    }
    asm volatile("s_waitcnt lgkmcnt(0)" ::: "memory");
    __builtin_amdgcn_s_barrier();
}
__device__ __forceinline__ void gw_zero(f32x4 (&acc)[4][8]) {
#pragma unroll
    for (int i = 0; i < 4; ++i)
#pragma unroll
        for (int j = 0; j < 8; ++j) acc[i][j] = f32x4{0.f, 0.f, 0.f, 0.f};
}
#define GW_EPI_LOOP(...) \
    { const int lane_ = tid & 63, w_ = tid >> 6, wm_ = w_ >> 1, wn_ = w_ & 1, lr_ = lane_ & 15, lq_ = lane_ >> 4; \
      _Pragma("unroll") for (int i = 0; i < 4; ++i) _Pragma("unroll") for (int j = 0; j < 8; ++j) { \
        const int m = m0 + wm_ * 64 + i * 16 + lr_; const int n = n0 + wn_ * 128 + j * 16 + lq_ * 4; const f32x4 v = acc[i][j]; __VA_ARGS__ } }

__device__ __forceinline__ void phase_inproj(const bf16_t* __restrict__ H, const bf16_t* __restrict__ WTIN, bf16_t* Q, bf16_t* Kb, bf16_t* VT, bf16_t* U, bf16_t* SV, bf16_t* G, char* lds) {
    const int tid = threadIdx.x;
    const int nMt = NTOK / 256, nNt = IN_COLS / 256;
    for (int it = 0;; ++it) {
        int mt, nt; bool valid; g_tilemap(it, nMt, nNt, mt, nt, valid);
        if (!valid) break;
        const int m0 = mt * 256, n0 = nt * 256;
        f32x4 acc[4][8]; gw_zero(acc);
        gw_kloop(H, 1024, WTIN, 1024, 1024, m0, n0, lds, acc, tid);
        if (n0 < 512) { GW_EPI_LOOP( *(uint2*)(Q + (size_t)m * 512 + n) = pack4(v[0] * QSCALE, v[1] * QSCALE, v[2] * QSCALE, v[3] * QSCALE); ) }
        else if (n0 < 1024) { GW_EPI_LOOP( *(uint2*)(Kb + (size_t)m * 512 + n - 512) = pack4(v[0], v[1], v[2], v[3]); ) }
        else if (n0 < 1536) { GW_EPI_LOOP( *(uint2*)(VT + (size_t)m * 512 + n - 1024) = pack4(v[0], v[1], v[2], v[3]); ) }
        else if (n0 < 2048) { GW_EPI_LOOP( *(uint2*)(U + (size_t)m * 512 + n - 1536) = pack4(gelu_tanh(v[0]), gelu_tanh(v[1]), gelu_tanh(v[2]), gelu_tanh(v[3])); ) }
        else if (n0 < 2560) { GW_EPI_LOOP( *(uint2*)(SV + (size_t)m * 512 + n - 2048) = pack4(gelu_tanh(v[0]), gelu_tanh(v[1]), gelu_tanh(v[2]), gelu_tanh(v[3])); ) }
        else { GW_EPI_LOOP( *(uint2*)(G + (size_t)m * 2048 + n - 2560) = pack4(sigmoidf_(v[0]), sigmoidf_(v[1]), sigmoidf_(v[2]), sigmoidf_(v[3])); ) }
    }
}
__device__ __forceinline__ void phase_merged(const bf16_t* __restrict__ YA, const bf16_t* __restrict__ YB, const bf16_t* __restrict__ WTA, const bf16_t* __restrict__ WTB,
                             const bf16_t* __restrict__ G, bf16_t* MERGED, char* lds) {
    const int tid = threadIdx.x;
    const int nMt = NTOK / 256, nNt = 1024 / 128;
    for (int it = 0;; ++it) {
        int mt, nt; bool valid; g_tilemap(it, nMt, nNt, mt, nt, valid);
        if (!valid) break;
        const int m0 = mt * 256, n0 = nt * 128;
        f32x4 acc[4][4]; g_zero(acc);
        g_kloop(YB, 512, WTB, 512, 512, m0, n0, lds, acc, tid);
        { const int lane_ = tid & 63, w_ = tid >> 6, wm_ = w_ >> 1, wn_ = w_ & 1, lr_ = lane_ & 15, lq_ = lane_ >> 4;
#pragma unroll
          for (int i = 0; i < 4; ++i)
#pragma unroll
            for (int j = 0; j < 4; ++j) {
                const int m = m0 + wm_ * 64 + i * 16 + lr_; const int n = n0 + wn_ * 64 + j * 16 + lq_ * 4;
                const uint2 ga2 = *(const uint2*)(G + (size_t)m * 2048 + n);
                const uint2 gb2 = *(const uint2*)(G + (size_t)m * 2048 + 1024 + n);
                acc[i][j][0] *= __uint_as_float(gb2.x << 16) * __builtin_amdgcn_rcpf(fmaxf(__uint_as_float(ga2.x << 16), 1e-20f));
                acc[i][j][1] *= __uint_as_float(gb2.x & 0xffff0000u) * __builtin_amdgcn_rcpf(fmaxf(__uint_as_float(ga2.x & 0xffff0000u), 1e-20f));
                acc[i][j][2] *= __uint_as_float(gb2.y << 16) * __builtin_amdgcn_rcpf(fmaxf(__uint_as_float(ga2.y << 16), 1e-20f));
                acc[i][j][3] *= __uint_as_float(gb2.y & 0xffff0000u) * __builtin_amdgcn_rcpf(fmaxf(__uint_as_float(ga2.y & 0xffff0000u), 1e-20f));
            } }
        g_kloop(YA, 512, WTA, 512, 512, m0, n0, lds, acc, tid);
        G_EPI_LOOP( const uint2 ga2 = *(const uint2*)(G + (size_t)m * 2048 + n);
                    *(uint2*)(MERGED + (size_t)m * 1024 + n) = pack4(v[0] * fmaxf(__uint_as_float(ga2.x << 16), 1e-20f), v[1] * fmaxf(__uint_as_float(ga2.x & 0xffff0000u), 1e-20f),
                                                                      v[2] * fmaxf(__uint_as_float(ga2.y << 16), 1e-20f), v[3] * fmaxf(__uint_as_float(ga2.y & 0xffff0000u), 1e-20f)); )
    }
}
__device__ __forceinline__ void phase_outproj(const bf16_t* __restrict__ MERGED, const bf16_t* __restrict__ WTOUT, const float* __restrict__ x, const float* __restrict__ mod, float* x1, char* lds) {
    const int tid = threadIdx.x;
    const int nMt = NTOK / 256, nNt = 1024 / 256;
    for (int it = 0;; ++it) {
        int mt, nt; bool valid; g_tilemap(it, nMt, nNt, mt, nt, valid);
        if (!valid) break;
        const int m0 = mt * 256, n0 = nt * 256;
        f32x4 acc[4][8]; gw_zero(acc);
        gw_kloop(MERGED, 1024, WTOUT, 1024, 1024, m0, n0, lds, acc, tid);
        GW_EPI_LOOP( const int b = m / SEQ; const float4 g1 = *(const float4*)(mod + b * 6144 + 2048 + n);
                    const float4 xv = *(const float4*)(x + (size_t)m * 1024 + n);
                    float4 o; o.x = xv.x + g1.x * v[0]; o.y = xv.y + g1.y * v[1]; o.z = xv.z + g1.z * v[2]; o.w = xv.w + g1.w * v[3];
                    *(float4*)(x1 + (size_t)m * 1024 + n) = o; )
    }
}
__device__ __forceinline__ void phase_peerq(const bf16_t* __restrict__ H2, const bf16_t* __restrict__ WTQ, bf16_t* QP, char* lds) {
    const int tid = threadIdx.x;
    const int nMt = NTOK / 256, nNt = 2048 / 128;
    for (int it = 0;; ++it) {
        int mt, nt; bool valid; g_tilemap(it, nMt, nNt, mt, nt, valid);
        if (!valid) break;
        const int m0 = mt * 256, n0 = nt * 128;
        f32x4 acc[4][4]; g_zero(acc);
        g_kloop(H2, 1024, WTQ, 1024, 1024, m0, n0, lds, acc, tid);
        G_EPI_LOOP( *(uint2*)(QP + (size_t)m * 2048 + n) = pack4(v[0], v[1], v[2], v[3]); )
    }
}


using f32x16 = __attribute__((ext_vector_type(16))) float;
typedef short v4i16_t __attribute__((ext_vector_type(4)));
#define ATT_TILE 16384
#define ATT_LDS_BYTES (4 * ATT_TILE)

__device__ __forceinline__ void att_dma(const bf16_t* __restrict__ Kb, const bf16_t* __restrict__ V, int b, int h, int kt, char* kl, char* vl, int lane, int w) {
    const int pc = lane & 15, rl = lane >> 4;
#pragma unroll
    for (int i = 0; i < 2; ++i) {
        const int n = w * 2 + i; const int row = 4 * n + rl;
        const size_t rowoff = ((size_t)(b * SEQ + kt * 64 + row)) * 512 + h * 128;
        __builtin_amdgcn_global_load_lds((const unsigned*)(Kb + rowoff + ((pc ^ (row & 15)) << 3)), (__attribute__((address_space(3))) unsigned*)(lds_ptr_t)(kl + n * 1024), 16, 0, 0);
        __builtin_amdgcn_global_load_lds((const unsigned*)(V + rowoff + ((pc ^ ((row & 3) << 2)) << 3)), (__attribute__((address_space(3))) unsigned*)(lds_ptr_t)(vl + n * 1024), 16, 0, 0);
    }
}
__device__ __forceinline__ void att_item(int b, int h, int cp, const bf16_t* __restrict__ Q, const bf16_t* __restrict__ Kb, const bf16_t* __restrict__ V,
                                         float lam, const float* __restrict__ head_g, bf16_t* __restrict__ YA, char* lds) {
    const int tid = threadIdx.x, lane = tid & 63;
    const int w = __builtin_amdgcn_readfirstlane(tid >> 6);
    const int i = w & 1, rq = w >> 1, r = lane & 31, hh = lane >> 5;
    const int tq = b * SEQ + cp * 128 + rq * 32 + r;
    bf16x8 qf[4];
#pragma unroll
    for (int s = 0; s < 4; ++s) qf[s] = *(const bf16x8*)(Q + (size_t)tq * 512 + h * 128 + i * 64 + 16 * s + 8 * hh);
    f32x16 O[4];
#pragma unroll
    for (int d = 0; d < 4; ++d)
#pragma unroll
        for (int e = 0; e < 16; ++e) O[d][e] = 0.f;
    float m = -1e30f, l = 0.f;
    const int ntiles = 2 * cp + 2;
    const int ntiles_w = 2 * cp + (rq >> 1) + 1;
    int vb[4];
    { const int li = lane & 15, g = lane >> 4, q = li >> 2, x = 2 * (g & 1) + ((li & 3) >> 1);
#pragma unroll
      for (int d = 0; d < 4; ++d) vb[d] = (4 * hh + q) * 256 + ((((d ^ q) << 2) | x) << 4) + 8 * (li & 1); }
    att_dma(Kb, V, b, h, 0, lds, lds + ATT_TILE, lane, w);
    asm volatile("s_waitcnt vmcnt(0)" ::: "memory");
    __syncthreads();
    for (int kt = 0; kt < ntiles; ++kt) {
        const char* kl = lds + (kt & 1) * (2 * ATT_TILE); const char* vl = kl + ATT_TILE;
        if (kt + 1 < ntiles) { char* nl = lds + ((kt + 1) & 1) * (2 * ATT_TILE); att_dma(Kb, V, b, h, kt + 1, nl, nl + ATT_TILE, lane, w); }
        if (kt < ntiles_w) {
        f32x16 sacc[2];
        {
            bf16x8 kf[2][4];
#pragma unroll
            for (int k2 = 0; k2 < 2; ++k2)
#pragma unroll
                for (int s = 0; s < 4; ++s) {
                    const int krow = k2 * 32 + r; const int kch = i * 8 + 2 * s + hh;
                    kf[k2][s] = *(const bf16x8*)(kl + krow * 256 + ((kch ^ (krow & 15)) << 4));
                }
#pragma unroll
            for (int k2 = 0; k2 < 2; ++k2) {
#pragma unroll
                for (int e = 0; e < 16; ++e) sacc[k2][e] = 0.f;
#pragma unroll
                for (int s = 0; s < 4; ++s) sacc[k2] = __builtin_amdgcn_mfma_f32_32x32x16_bf16(kf[k2][s], qf[s], sacc[k2], 0, 0, 0);
            }
        }
        float mx = sacc[0][0];
#pragma unroll
        for (int e = 1; e < 16; ++e) mx = fmaxf(mx, sacc[0][e]);
#pragma unroll
        for (int e = 0; e < 16; ++e) mx = fmaxf(mx, sacc[1][e]);
        mx = fmaxf(mx, __shfl_xor(mx, 32));
        const float mn = fmaxf(m, mx);
        const float alpha = __builtin_amdgcn_exp2f(m - mn);
        m = mn;
        float ls = 0.f;
#pragma unroll
        for (int k2 = 0; k2 < 2; ++k2)
#pragma unroll
            for (int e = 0; e < 16; ++e) { const float p = __builtin_amdgcn_exp2f(sacc[k2][e] - mn); sacc[k2][e] = p; ls += p; }
        l = l * alpha + ls;
        if (__any(alpha != 1.0f)) {
#pragma unroll
            for (int d = 0; d < 4; ++d)
#pragma unroll
                for (int e = 0; e < 16; ++e) O[d][e] *= alpha;
        }
        bf16x8 pf[2][2];
#pragma unroll
        for (int k2 = 0; k2 < 2; ++k2)
#pragma unroll
            for (int s2 = 0; s2 < 2; ++s2) {
                union { uint4 u; bf16x8 v; } cp;
                cp.u = make_uint4(pack2(sacc[k2][8 * s2 + 0], sacc[k2][8 * s2 + 1]), pack2(sacc[k2][8 * s2 + 2], sacc[k2][8 * s2 + 3]),
                                  pack2(sacc[k2][8 * s2 + 4], sacc[k2][8 * s2 + 5]), pack2(sacc[k2][8 * s2 + 6], sacc[k2][8 * s2 + 7]));
                pf[k2][s2] = cp.v;
            }
#define ATT_VREAD(dst, st) { const lds_ptr_t vp_ = (lds_ptr_t)(vl + vb[(st) >> 2]); const int kb_ = (((st) >> 1) & 1) * 32 + ((st) & 1) * 16; \
            const v4i16_t lo_ = __builtin_amdgcn_ds_read_tr16_b64_v4i16((__attribute__((address_space(3))) v4i16_t*)(vp_ + kb_ * 256)); \
            const v4i16_t hi_ = __builtin_amdgcn_ds_read_tr16_b64_v4i16((__attribute__((address_space(3))) v4i16_t*)(vp_ + kb_ * 256 + 2048)); \
            dst = (bf16x8){lo_[0], lo_[1], lo_[2], lo_[3], hi_[0], hi_[1], hi_[2], hi_[3]}; }
        {
            bf16x8 vcur, vnxt;
            ATT_VREAD(vcur, 0)
#pragma unroll
            for (int st = 0; st < 16; ++st) {
                if (st + 1 < 16) ATT_VREAD(vnxt, st + 1)
                O[st >> 2] = __builtin_amdgcn_mfma_f32_32x32x16_bf16(vcur, pf[(st >> 1) & 1][st & 1], O[st >> 2], 0, 0, 0);
                vcur = vnxt;
            }
        }
        }
        asm volatile("s_waitcnt vmcnt(0)" ::: "memory");
        __syncthreads();
    }
    const float ltot = l + __shfl_xor(l, 32);
    const float inv = 1.0f / ltot;
    float* ex = (float*)lds;
    if (i == 1) {
        const float sc = inv * lam;
#pragma unroll
        for (int d = 0; d < 4; ++d)
#pragma unroll
            for (int e = 0; e < 16; ++e) { const int dv = d * 32 + (e & 3) + 8 * (e >> 2) + 4 * hh; ex[(rq * 128 + dv) * 32 + r] = O[d][e] * sc; }
    }
    __syncthreads();
    if (i == 0) {
        float ss = 0.f;
#pragma unroll
        for (int d = 0; d < 4; ++d)
#pragma unroll
            for (int e = 0; e < 16; ++e) { const int dv = d * 32 + (e & 3) + 8 * (e >> 2) + 4 * hh; const float o = O[d][e] * inv - ex[(rq * 128 + dv) * 32 + r]; O[d][e] = o; ss += o * o; }
        ss += __shfl_xor(ss, 32);
        const float rn = rsqrtf(ss * (1.0f / 128.0f) + EPS) * 0.8f;
#pragma unroll
        for (int d = 0; d < 4; ++d)
#pragma unroll
            for (int g = 0; g < 4; ++g) {
                const int dv = d * 32 + 8 * g + 4 * hh;
                const float4 hg = *(const float4*)(head_g + dv);
                *(uint2*)(YA + (size_t)tq * 512 + h * 128 + dv) = pack4(O[d][4 * g] * rn * hg.x, O[d][4 * g + 1] * rn * hg.y, O[d][4 * g + 2] * rn * hg.z, O[d][4 * g + 3] * rn * hg.w);
            }
    }
    __syncthreads();
}
__device__ __forceinline__ void phase_attn(const bf16_t* __restrict__ Q, const bf16_t* __restrict__ Kb, const bf16_t* __restrict__ V, const float* __restrict__ ctl,
                           const float* __restrict__ head_g, bf16_t* __restrict__ YA, char* lds) {
    const float lam = ctl[0];
    const int G = gridDim.x, bid = blockIdx.x;
    if (G == 256) {
        const int x = bid & 7, slot = bid >> 3; const int ph = x + 8 * (slot & 1); const int s = slot >> 1;
#pragma unroll 1
        for (int it = 0; it < 4; ++it) {
            const int cp = (it == 0) ? 63 - s : (it == 1) ? 32 + s : (it == 2) ? 31 - s : s;
            att_item(ph >> 2, ph & 3, cp, Q, Kb, V, lam, head_g, YA, lds);
        }
    } else {
#pragma unroll 1
        for (int it = 0;; ++it) {
            const int rho = (it & 1) ? it * G + (G - 1 - bid) : it * G + bid;
            if (rho >= 1024) { if (it * G >= 1024) break; else continue; }
            const int cp = 63 - (rho >> 4); const int ph = rho & 15;
            att_item(ph >> 2, ph & 3, cp, Q, Kb, V, lam, head_g, YA, lds);
        }
    }
}


#define SGU_LDS_BYTES (65536 + 1024)
__device__ __forceinline__ void phase_sgu(const bf16_t* __restrict__ U, const bf16_t* __restrict__ SV, const float* __restrict__ ln_g, const float* __restrict__ ln_b,
                          const float* __restrict__ sg_w, const float* __restrict__ sg_b, bf16_t* __restrict__ YB, char* lds) {
    const int tid = threadIdx.x, lane = tid & 63, w = tid >> 6, wm = w >> 1  , wn = w & 1  , lr = lane & 15, lq = lane >> 4;
    float* st_mu = (float*)(lds + 65536); float* st_rs = st_mu + 128;
    char* Wl = lds; char* Sl = lds + 32768;
    for (int item = blockIdx.x; item < (NTOK / 128) * 4; item += gridDim.x) {
        const int g = item & 3, nb = item >> 2; const int t0 = nb * 128;
        for (int r0 = 0; r0 < 16; r0 += 8) {
            uint4 v8[8];
#pragma unroll
            for (int u = 0; u < 8; ++u) v8[u] = *(const uint4*)(SV + (size_t)(t0 + w * 16 + r0 + u) * 512 + lane * 8);
#pragma unroll
            for (int u = 0; u < 8; ++u) {
                const int row = w * 16 + r0 + u; const uint4 v = v8[u];
                float f[8] = {__uint_as_float(v.x << 16), __uint_as_float(v.x & 0xffff0000u), __uint_as_float(v.y << 16), __uint_as_float(v.y & 0xffff0000u),
                              __uint_as_float(v.z << 16), __uint_as_float(v.z & 0xffff0000u), __uint_as_float(v.w << 16), __uint_as_float(v.w & 0xffff0000u)};
                float s = 0.f;
#pragma unroll
                for (int j = 0; j < 8; ++j) s += f[j];
                for (int o = 32; o > 0; o >>= 1) s += __shfl_xor(s, o);
                const float mu = s * (1.0f / 512.0f);
                float q = 0.f;
#pragma unroll
                for (int j = 0; j < 8; ++j) { const float d = f[j] - mu; q += d * d; }
                for (int o = 32; o > 0; o >>= 1) q += __shfl_xor(q, o);
                if (lane == 0) { st_mu[row] = mu; st_rs[row] = rsqrtf(q * (1.0f / 512.0f) + EPS); }
            }
        }
        { const int c16 = tid & 15, r0 = tid >> 4;
#pragma unroll
          for (int i = 0; i < 4; ++i) {
              const int p = r0 + 32 * i;
              const float* wp = sg_w + ((size_t)g * 128 + p) * 128 + c16 * 8;
              float4 a = *(const float4*)wp, b = *(const float4*)(wp + 4);
              if (p < 64 && c16 >= 8) { a = make_float4(0.f, 0.f, 0.f, 0.f); b = a; }
              *(uint4*)(Wl + p * 256 + ((c16 ^ (p & 15)) << 4)) = make_uint4(pack2(a.x, a.y), pack2(a.z, a.w), pack2(b.x, b.y), pack2(b.z, b.w));
          } }
        __syncthreads();
        { const int pr = tid & 63;
#pragma unroll
          for (int it = 0; it < 2; ++it) {
              const int ch = (tid >> 6) + 8 * it;
              const int q0 = 2 * pr;
              const uint4 va = *(const uint4*)(SV + (size_t)(t0 + q0) * 512 + g * 128 + ch * 8);
              const uint4 vb = *(const uint4*)(SV + (size_t)(t0 + q0 + 1) * 512 + g * 128 + ch * 8);
              const float mua = st_mu[q0], rsa = st_rs[q0], mub = st_mu[q0 + 1], rsb = st_rs[q0 + 1];
              const unsigned ua[4] = {va.x, va.y, va.z, va.w}, ub[4] = {vb.x, vb.y, vb.z, vb.w};
#pragma unroll
              for (int e = 0; e < 8; ++e) {
                  const int c = ch * 8 + e;
                  const float lg = ln_g[g * 128 + c], lb = ln_b[g * 128 + c];
                  const float xa = (e & 1) ? __uint_as_float(ua[e >> 1] & 0xffff0000u) : __uint_as_float(ua[e >> 1] << 16);
                  const float xb = (e & 1) ? __uint_as_float(ub[e >> 1] & 0xffff0000u) : __uint_as_float(ub[e >> 1] << 16);
                  const float na = (xa - mua) * rsa * lg + lb, nb2 = (xb - mub) * rsb * lg + lb;
                  *(unsigned*)(Sl + c * 256 + (((q0 >> 3) ^ (c & 15)) << 4) + (q0 & 7) * 2) = pack2(na, nb2);
              }
          } }
        __syncthreads();
        f32x4 acc[2][4];
#pragma unroll
        for (int i = 0; i < 2; ++i)
#pragma unroll
            for (int j = 0; j < 4; ++j) acc[i][j] = f32x4{0.f, 0.f, 0.f, 0.f};
        const int nks = (wm < 2) ? 2 : 4;
        for (int ks = 0; ks < nks; ++ks) {
            const int sw = (((ks * 4 + lq) ^ lr) << 4);
            bf16x8 a[2], b[4];
#pragma unroll
            for (int i = 0; i < 2; ++i) a[i] = *(const bf16x8*)(Wl + (wm * 32 + i * 16 + lr) * 256 + sw);
#pragma unroll
            for (int j = 0; j < 4; ++j) b[j] = *(const bf16x8*)(Sl + (wn * 64 + j * 16 + lr) * 256 + sw);
#pragma unroll
            for (int i = 0; i < 2; ++i)
#pragma unroll
                for (int j = 0; j < 4; ++j) acc[i][j] = __builtin_amdgcn_mfma_f32_16x16x32_bf16(b[j], a[i], acc[i][j], 0, 0, 0);
        }
#pragma unroll
        for (int i = 0; i < 2; ++i)
#pragma unroll
            for (int j = 0; j < 4; ++j) {
                const int p = wm * 32 + i * 16 + lr; const int c = wn * 64 + j * 16 + lq * 4;
                const float bias = sg_b[g * 128 + p];
                const size_t o = (size_t)(t0 + p) * 512 + g * 128 + c;
                const uint2 uu = *(const uint2*)(U + o);
                *(uint2*)(YB + o) = pack4(__uint_as_float(uu.x << 16) * (acc[i][j][0] + bias), __uint_as_float(uu.x & 0xffff0000u) * (acc[i][j][1] + bias),
                                          __uint_as_float(uu.y << 16) * (acc[i][j][2] + bias), __uint_as_float(uu.y & 0xffff0000u) * (acc[i][j][3] + bias));
            }
        __syncthreads();
    }
}

#define CE_DESC(a, b) { const unsigned t_ = (a) > (b) ? (a) : (b); b = (a) > (b) ? (b) : (a); a = t_; }
__device__ __forceinline__ unsigned f2key(float f) { const unsigned u = __float_as_uint(f); return (u & 0x80000000u) ? ~u : (u | 0x80000000u); }
__device__ __forceinline__ float key2f(unsigned k) { const unsigned u = (k & 0x80000000u) ? (k & 0x7fffffffu) : ~k; return __uint_as_float(u); }
template <int N> __device__ __forceinline__ void bitonic_sort_desc(unsigned (&a)[N]) {
#pragma unroll
    for (int k = 2; k <= N; k <<= 1)
#pragma unroll
        for (int j = k >> 1; j > 0; j >>= 1)
#pragma unroll
            for (int i = 0; i < N; ++i) {
                const int l = i ^ j;
                if (l > i) { if ((i & k) == 0) { CE_DESC(a[i], a[l]) } else { CE_DESC(a[l], a[i]) } }
            }
}
template <int N> __device__ __forceinline__ void bitonic_merge_desc(unsigned (&a)[N]) {
#pragma unroll
    for (int j = N >> 1; j > 0; j >>= 1)
#pragma unroll
        for (int i = 0; i < N; ++i) { const int l = i ^ j; if (l > i) { CE_DESC(a[i], a[l]) } }
}
__device__ __forceinline__ void merge_top16(unsigned (&a)[16], const unsigned (&b)[16]) {
#pragma unroll
    for (int i = 0; i < 16; ++i) a[i] = a[i] > b[15 - i] ? a[i] : b[15 - i];
    bitonic_merge_desc<16>(a);
}
__device__ __forceinline__ void xlane_merge_top16(unsigned (&a)[16], int xmask) {
    unsigned b[16];
#pragma unroll
    for (int i = 0; i < 16; ++i) b[i] = (unsigned)__shfl_xor((int)a[i], xmask);
    merge_top16(a, b);
}
__device__ __forceinline__ void phase_peer_select(const bf16_t* __restrict__ H2, const bf16_t* __restrict__ WTQ, const bf16_t* __restrict__ SUBK,
                                  int* __restrict__ EIDX, float* __restrict__ GW, char* lds) {
    const int tid = threadIdx.x, lane = tid & 63, w = tid >> 6, wm = w >> 1, wn = w & 1, lr = lane & 15, lq = lane >> 4;
    const int G = gridDim.x;
    for (int u = blockIdx.x; u < (NTOK / 256) * 8; u += G) {
        const int h = u & 7, mt = u >> 3; const int m0 = mt * 256;
        unsigned* Ll = (unsigned*)(lds + 98304);
#pragma unroll 1
        for (int p = 0; p < 2; ++p) {
            f32x4 acc[4][4]; g_zero(acc);
            g_kloop(H2, 1024, WTQ + (size_t)(h * 256 + p * 128) * 1024, 1024, 1024, m0, 0, lds, acc, tid);
#pragma unroll
            for (int i = 0; i < 4; ++i)
#pragma unroll
                for (int j = 0; j < 4; ++j) {
                    const int tok = wm * 64 + i * 16 + lr; const int d = wn * 64 + j * 16 + lq * 4;
                    *(uint2*)(lds + tok * 256 + (((d >> 3) ^ (tok & 15)) << 4) + (d & 7) * 2) = pack4(acc[i][j][0], acc[i][j][1], acc[i][j][2], acc[i][j][3]);
                }
            { const int c16 = tid & 15, r0 = tid >> 4; const bf16_t* kp = SUBK + (size_t)(h * 2 + p) * 128 * 128;
#pragma unroll
              for (int i = 0; i < 4; ++i) { const int row = r0 + 32 * i; *(uint4*)(lds + 65536 + row * 256 + ((c16 ^ (row & 15)) << 4)) = *(const uint4*)(kp + row * 128 + c16 * 8); } }
            __syncthreads();
            f32x4 sc[2][8];
#pragma unroll
            for (int tt = 0; tt < 2; ++tt)
#pragma unroll
                for (int kt = 0; kt < 8; ++kt) sc[tt][kt] = f32x4{0.f, 0.f, 0.f, 0.f};
#pragma unroll
            for (int ks = 0; ks < 4; ++ks) {
                const int sw = (((ks * 4 + lq) ^ lr) << 4);
                bf16x8 qb[2], ka[8];
#pragma unroll
                for (int tt = 0; tt < 2; ++tt) qb[tt] = *(const bf16x8*)(lds + (w * 32 + tt * 16 + lr) * 256 + sw);
#pragma unroll
                for (int kt = 0; kt < 8; ++kt) ka[kt] = *(const bf16x8*)(lds + 65536 + (kt * 16 + lr) * 256 + sw);
#pragma unroll
                for (int tt = 0; tt < 2; ++tt)
#pragma unroll
                    for (int kt = 0; kt < 8; ++kt) sc[tt][kt] = __builtin_amdgcn_mfma_f32_16x16x32_bf16(ka[kt], qb[tt], sc[tt][kt], 0, 0, 0);
            }
            __syncthreads();
#pragma unroll
            for (int tt = 0; tt < 2; ++tt) {
                __builtin_amdgcn_sched_barrier(0);
                unsigned lo[16], hi[16];
#pragma unroll
                for (int kt = 0; kt < 4; ++kt)
#pragma unroll
                    for (int r = 0; r < 4; ++r) {
                        lo[kt * 4 + r] = (f2key(sc[tt][kt][r]) & ~0x7Fu) | (unsigned)(127 - (kt * 16 + lq * 4 + r));
                        hi[kt * 4 + r] = (f2key(sc[tt][kt + 4][r]) & ~0x7Fu) | (unsigned)(127 - ((kt + 4) * 16 + lq * 4 + r));
                    }
                bitonic_sort_desc<16>(lo); bitonic_sort_desc<16>(hi);
                merge_top16(lo, hi);
                xlane_merge_top16(lo, 16); xlane_merge_top16(lo, 32);
                if (lq == 0) {
                    uint4* dst = (uint4*)(Ll + (w * 32 + tt * 16 + lr) * 32 + p * 16);
                    dst[0] = make_uint4(lo[0], lo[1], lo[2], lo[3]); dst[1] = make_uint4(lo[4], lo[5], lo[6], lo[7]);
                    dst[2] = make_uint4(lo[8], lo[9], lo[10], lo[11]); dst[3] = make_uint4(lo[12], lo[13], lo[14], lo[15]);
                }
            }
        }
        __syncthreads();
#pragma unroll
        for (int tt = 0; tt < 2; ++tt) {
            __builtin_amdgcn_sched_barrier(0);
            const int tokl = w * 32 + tt * 16 + lr;
            float v0[16], v1[16];
            { const uint4* sp = (const uint4*)(Ll + tokl * 32);
#pragma unroll
              for (int q = 0; q < 4; ++q) {
                  const uint4 a = sp[q], b = sp[4 + q];
                  v0[q * 4] = key2f(a.x & ~0x7Fu); v0[q * 4 + 1] = key2f(a.y & ~0x7Fu); v0[q * 4 + 2] = key2f(a.z & ~0x7Fu); v0[q * 4 + 3] = key2f(a.w & ~0x7Fu);
                  v1[q * 4] = key2f(b.x & ~0x7Fu); v1[q * 4 + 1] = key2f(b.y & ~0x7Fu); v1[q * 4 + 2] = key2f(b.z & ~0x7Fu); v1[q * 4 + 3] = key2f(b.w & ~0x7Fu);
              } }
            unsigned c2[16];
#pragma unroll
            for (int r = 0; r < 16; ++r) c2[r] = 0u;
#define CAND(slot, a, b) c2[slot] = (f2key(v0[a] + v1[b]) & ~0xFFu) | (unsigned)(255 - ((a) * 16 + (b)))
            if (lq == 0) {
                CAND(0, 0, 0); CAND(1, 0, 1); CAND(2, 0, 2); CAND(3, 0, 3); CAND(4, 0, 4); CAND(5, 0, 5); CAND(6, 0, 6); CAND(7, 0, 7);
                CAND(8, 0, 8); CAND(9, 0, 9); CAND(10, 0, 10); CAND(11, 0, 11); CAND(12, 0, 12); CAND(13, 0, 13); CAND(14, 0, 14); CAND(15, 0, 15);
            } else if (lq == 1) {
                CAND(0, 8, 0); CAND(1, 9, 0); CAND(2, 10, 0); CAND(3, 11, 0); CAND(4, 12, 0); CAND(5, 13, 0); CAND(6, 14, 0); CAND(7, 15, 0);
                CAND(8, 1, 0); CAND(9, 1, 1); CAND(10, 1, 2); CAND(11, 1, 3); CAND(12, 1, 4); CAND(13, 1, 5); CAND(14, 1, 6); CAND(15, 1, 7);
            } else if (lq == 2) {
                CAND(0, 2, 0); CAND(1, 2, 1); CAND(2, 2, 2); CAND(3, 2, 3); CAND(4, 2, 4); CAND(5, 3, 0); CAND(6, 3, 1); CAND(7, 3, 2);
                CAND(8, 3, 3); CAND(9, 4, 0); CAND(10, 4, 1); CAND(11, 4, 2); CAND(12, 5, 0); CAND(13, 5, 1);
            } else {
                CAND(0, 6, 0); CAND(1, 6, 1); CAND(2, 7, 0); CAND(3, 7, 1);
            }
#undef CAND
            bitonic_sort_desc<16>(c2);
            xlane_merge_top16(c2, 16); xlane_merge_top16(c2, 32);
            if (lq == 0) {
                float s[16]; int ei[16];
#pragma unroll
                for (int r = 0; r < 16; ++r) {
                    const unsigned code = 255u - (c2[r] & 0xFFu);
                    const unsigned k0 = Ll[tokl * 32 + (code >> 4)], k1 = Ll[tokl * 32 + 16 + (code & 15u)];
                    s[r] = key2f(k0 & ~0x7Fu) + key2f(k1 & ~0x7Fu);
                    ei[r] = (int)((127u - (k0 & 0x7Fu)) * 128u + (127u - (k1 & 0x7Fu)));
                }
                float mx = s[0];
#pragma unroll
                for (int r = 1; r < 16; ++r) mx = fmaxf(mx, s[r]);
                float sum = 0.f;
#pragma unroll
                for (int r = 0; r < 16; ++r) { s[r] = __expf(s[r] - mx); sum += s[r]; }
                const float inv = 1.0f / sum;
                const size_t o = ((size_t)(m0 + tokl) * 8 + h) * 16;
#pragma unroll
                for (int r = 0; r < 16; r += 4) {
                    *(int4*)(EIDX + o + r) = make_int4(ei[r], ei[r + 1], ei[r + 2], ei[r + 3]);
                    *(float4*)(GW + o + r) = make_float4(s[r] * inv, s[r + 1] * inv, s[r + 2] * inv, s[r + 3] * inv);
                }
            }
        }
        __syncthreads();
    }
}

#define DPP_ADD(r, ctrl) r += __builtin_bit_cast(float, __builtin_amdgcn_update_dpp(0, __builtin_bit_cast(int, r), ctrl, 0xf, 0xf, false))
__device__ __forceinline__ float dot8(const uint4& a, const uint4& b, float acc) {
    acc = __builtin_amdgcn_fdot2_f32_bf16(__builtin_bit_cast(bf16v2_t, a.x), __builtin_bit_cast(bf16v2_t, b.x), acc, false);
    acc = __builtin_amdgcn_fdot2_f32_bf16(__builtin_bit_cast(bf16v2_t, a.y), __builtin_bit_cast(bf16v2_t, b.y), acc, false);
    acc = __builtin_amdgcn_fdot2_f32_bf16(__builtin_bit_cast(bf16v2_t, a.z), __builtin_bit_cast(bf16v2_t, b.z), acc, false);
    acc = __builtin_amdgcn_fdot2_f32_bf16(__builtin_bit_cast(bf16v2_t, a.w), __builtin_bit_cast(bf16v2_t, b.w), acc, false);
    return acc;
}
#define PE_LDS_BYTES (65536 + 256)
__device__ __forceinline__ void phase_peer_expert(const unsigned char* __restrict__ HQ, const float* __restrict__ HSC, const int* __restrict__ EIDX, const float* __restrict__ GW,
                                  const unsigned char* __restrict__ DOWNQ, const unsigned char* __restrict__ UPQ, const float* __restrict__ DSC, const float* __restrict__ USC,
                                  const float* __restrict__ mod, const float* __restrict__ final_g, const float* x1src, float* __restrict__ X2, float* out, char* lds) {
    const int tid = threadIdx.x, lane = tid & 63, w = tid >> 6;
    const int r8 = lane >> 3, cp8 = lane & 7;
    int* eid_l = (int*)(lds + w * 16384);
    int* part_l = (int*)(lds + w * 16384 + 8192);
    float* w_l = (float*)part_l;
    float* ssq_l = (float*)(lds + NW * 16384 + w * 64);
    const int nwaves = gridDim.x * NW;
    const int tpw = (NTOK + nwaves - 1) / nwaves;
    const int t_begin = (blockIdx.x * NW + w) * tpw;
    for (int base = 0; base < tpw; base += 16) {
        const int t0 = t_begin + base;
        int nt = tpw - base; if (nt > 16) nt = 16; if (t0 + nt > NTOK) nt = NTOK - t0; if (nt < 0) nt = 0;
#pragma unroll 4
        for (int i = 0; i < nt; ++i) { eid_l[i * 128 + (lane & 7) * 16 + (lane >> 3)] = EIDX[(size_t)(t0 + i) * 128 + lane]; eid_l[i * 128 + (lane & 7) * 16 + 8 + (lane >> 3)] = EIDX[(size_t)(t0 + i) * 128 + 64 + lane];
                                       part_l[i * 128 + lane] = 0; part_l[i * 128 + 64 + lane] = 0; }
        if (lane < 16) ssq_l[lane] = 0.f;
        __syncthreads();
#pragma unroll 1
        for (int s = 0; s < 8; ++s) {
#pragma unroll 1
            for (int i = 0; i < nt; ++i) {
                const uint4 hq = *(const uint4*)(HQ + (size_t)(t0 + i) * 1024 + s * 128 + cp8 * 16);
                int ev[16];
#pragma unroll
                for (int q = 0; q < 4; ++q) { const int4 e4 = *(const int4*)(eid_l + i * 128 + r8 * 16 + q * 4); ev[q * 4] = e4.x; ev[q * 4 + 1] = e4.y; ev[q * 4 + 2] = e4.z; ev[q * 4 + 3] = e4.w; }
                uint4 dv[16];
#pragma unroll
                for (int j = 0; j < 16; ++j) dv[j] = *(const uint4*)(DOWNQ + (size_t)s * (16384 * 128) + (size_t)ev[j] * 128 + cp8 * 16);
                int res[16];
#pragma unroll
                for (int j = 0; j < 16; ++j) {
                    int sm = __builtin_amdgcn_sdot4((int)dv[j].x, (int)hq.x, 0, false);
                    sm = __builtin_amdgcn_sdot4((int)dv[j].y, (int)hq.y, sm, false);
                    sm = __builtin_amdgcn_sdot4((int)dv[j].z, (int)hq.z, sm, false);
                    sm = __builtin_amdgcn_sdot4((int)dv[j].w, (int)hq.w, sm, false);
                    sm += __builtin_amdgcn_update_dpp(0, sm, 0xB1, 0xf, 0xf, false);
                    sm += __builtin_amdgcn_update_dpp(0, sm, 0x4E, 0xf, 0xf, false);
                    sm += __builtin_amdgcn_update_dpp(0, sm, 0x141, 0xf, 0xf, false);
                    res[j] = sm;
                }
                if (cp8 == 0) {
                    int4* pp = (int4*)(part_l + i * 128 + r8 * 16);
#pragma unroll
                    for (int q = 0; q < 4; ++q) { int4 p4 = pp[q]; p4.x += res[q * 4]; p4.y += res[q * 4 + 1]; p4.z += res[q * 4 + 2]; p4.w += res[q * 4 + 3]; pp[q] = p4; }
                }
            }
        }
        __syncthreads();
#pragma unroll 4
        for (int i = 0; i < nt; ++i) {
            const float hs = HSC[t0 + i];
#pragma unroll
            for (int hf = 0; hf < 2; ++hf) {
                const int q = hf * 64 + lane; const int k = (q & 15) * 8 + (q >> 4); const int e = eid_l[i * 128 + q];
                const float a = (float)part_l[i * 128 + q] * hs * DSC[e];
                w_l[i * 128 + q] = GW[(size_t)(t0 + i) * 128 + k] * gelu_tanh(a) * USC[e];
            }
        }
        __syncthreads();
#pragma unroll 1
        for (int s = 0; s < 8; ++s) {
#pragma unroll 1
            for (int ib = 0; ib < nt; ib += 8) {
                const int il = (ib + r8 < nt) ? ib + r8 : nt - 1;
                const int t = t0 + il; const int b = t / SEQ;
                const int c0 = s * 128 + cp8 * 16;
                float4 xv4[4], g24[4];
#pragma unroll
                for (int q4 = 0; q4 < 4; ++q4) { xv4[q4] = *(const float4*)(x1src + (size_t)t * 1024 + c0 + q4 * 4); g24[q4] = *(const float4*)(mod + b * 6144 + 5120 + c0 + q4 * 4); }
                f32x2_t a2[8];
#pragma unroll
                for (int c = 0; c < 8; ++c) a2[c] = f32x2_t{0.f, 0.f};
                const unsigned char* ubase = UPQ + (size_t)s * (16384 * 128) + cp8 * 16;
#pragma unroll 1
                for (int q0 = 0; q0 < 128; q0 += 16) {
                    int ev[16]; float wv[16];
#pragma unroll
                    for (int q = 0; q < 4; ++q) {
                        const int4 e4 = *(const int4*)(eid_l + il * 128 + q0 + q * 4); ev[q * 4] = e4.x; ev[q * 4 + 1] = e4.y; ev[q * 4 + 2] = e4.z; ev[q * 4 + 3] = e4.w;
                        const float4 w4 = *(const float4*)(w_l + il * 128 + q0 + q * 4); wv[q * 4] = w4.x; wv[q * 4 + 1] = w4.y; wv[q * 4 + 2] = w4.z; wv[q * 4 + 3] = w4.w;
                    }
                    uint4 uv[16];
#pragma unroll
                    for (int j = 0; j < 16; ++j) uv[j] = *(const uint4*)(ubase + (size_t)ev[j] * 128);
#pragma unroll
                    for (int j = 0; j < 16; ++j) {
                        const f32x2_t wk2 = {wv[j], wv[j]};
                        const unsigned uu[4] = {uv[j].x, uv[j].y, uv[j].z, uv[j].w};
#pragma unroll
                        for (int q = 0; q < 4; ++q) {
                            a2[2 * q] = wk2 * __builtin_amdgcn_cvt_pk_f32_fp8((int)uu[q], false) + a2[2 * q];
                            a2[2 * q + 1] = wk2 * __builtin_amdgcn_cvt_pk_f32_fp8((int)uu[q], true) + a2[2 * q + 1];
                        }
                    }
                }
                float sq = 0.f;
#pragma unroll
                for (int q4 = 0; q4 < 4; ++q4) {
                    float4 r; r.x = xv4[q4].x + g24[q4].x * a2[2 * q4][0]; r.y = xv4[q4].y + g24[q4].y * a2[2 * q4][1];
                    r.z = xv4[q4].z + g24[q4].z * a2[2 * q4 + 1][0]; r.w = xv4[q4].w + g24[q4].w * a2[2 * q4 + 1][1];
                    sq += r.x * r.x + r.y * r.y + r.z * r.z + r.w * r.w;
                    if (ib + r8 < nt) *(float4*)(X2 + (size_t)t * 1024 + c0 + q4 * 4) = r;
                }
                sq += __builtin_bit_cast(float, __builtin_amdgcn_update_dpp(0, __builtin_bit_cast(int, sq), 0xB1, 0xf, 0xf, false));
                sq += __builtin_bit_cast(float, __builtin_amdgcn_update_dpp(0, __builtin_bit_cast(int, sq), 0x4E, 0xf, 0xf, false));
                sq += __builtin_bit_cast(float, __builtin_amdgcn_update_dpp(0, __builtin_bit_cast(int, sq), 0x141, 0xf, 0xf, false));
                if (cp8 == 0 && ib + r8 < nt) ssq_l[il] += sq;
            }
        }
        asm volatile("s_waitcnt vmcnt(0)" ::: "memory");
        __syncthreads();
#pragma unroll 4
        for (int i = 0; i < nt; ++i) {
            const int t = t0 + i;
            const float rn = rsqrtf(ssq_l[i] * (1.0f / 1024.0f) + EPS);
#pragma unroll
            for (int q4 = 0; q4 < 4; ++q4) {
                const int c = q4 * 256 + lane * 4;
                const float4 xv = *(const float4*)(X2 + (size_t)t * 1024 + c);
                const float4 fg = *(const float4*)(final_g + c);
                float4 r; r.x = xv.x * rn * fg.x; r.y = xv.y * rn * fg.y; r.z = xv.z * rn * fg.z; r.w = xv.w * rn * fg.w;
                *(float4*)(out + (size_t)t * 1024 + c) = r;
            }
        }
        __syncthreads();
    }
}


#define XB_TMO      128
#define XB_XCNT(j)  (256  + 64 * (j))
#define XB_XSUB(j)  (1280 + 64 * (j))
#define XB_XGEN(j)  (2304 + 64 * (j))
#define XB_TOP      3328
#define XB_TOPGEN   3392
#define XCD_BAR_WORDS 3456
#define XB_SPIN_CAP (1u << 22)
__device__ __forceinline__ unsigned xb_ld(unsigned* p)              { return __hip_atomic_load(p, __ATOMIC_RELAXED, __HIP_MEMORY_SCOPE_AGENT); }
__device__ __forceinline__ unsigned xb_add(unsigned* p, unsigned v) { return __hip_atomic_fetch_add(p, v, __ATOMIC_RELAXED, __HIP_MEMORY_SCOPE_AGENT); }
__device__ __forceinline__ unsigned xb_xcc_id() { return (unsigned)__builtin_amdgcn_s_getreg((3 << 11) | 20) & 0xFu; }
#define XB_SPIN(cond, bar) do { unsigned _sp = 0; while (cond) { __builtin_amdgcn_s_sleep(1); \
    if ((++_sp & 255u) == 0u) { if (xb_ld(&(bar)[XB_TMO])) break; if (_sp > XB_SPIN_CAP) { atomicAdd(&(bar)[XB_TMO], 1u); break; } } } } while (0)
struct XcdBarrier { unsigned* bar; unsigned x; unsigned nloc; unsigned nx; };
__device__ __forceinline__ void xcd_barrier_post(XcdBarrier& b, unsigned* bar) {
    b.bar = bar; b.x = xb_xcc_id(); b.nloc = 0u; b.nx = 0u;
    if (threadIdx.x == 0) (void)xb_add(&bar[XB_XCNT(b.x)], 1u);
}
__device__ __forceinline__ void xcd_barrier_complete(unsigned* bar, unsigned x, unsigned& nloc, unsigned& nx) {
    const unsigned G = gridDim.x;
    unsigned sum, cnt, mine, sp = 0u;
    for (;;) {
        sum = 0u; cnt = 0u; mine = 0u;
#pragma unroll
        for (unsigned j = 0; j < 16; ++j) { const unsigned c = xb_ld(&bar[XB_XCNT(j)]); sum += c; cnt += (c > 0u) ? 1u : 0u; mine = (j == x) ? c : mine; }
        if (sum == G) break;
        __builtin_amdgcn_s_sleep(1);
        if ((++sp & 255u) == 0u) { if (xb_ld(&bar[XB_TMO])) break; if (sp > XB_SPIN_CAP) { atomicAdd(&bar[XB_TMO], 1u); break; } }
    }
    nloc = mine > 0u ? mine : 1u; nx = cnt > 0u ? cnt : 1u;
}
__device__ __forceinline__ void xcd_barrier(XcdBarrier& b) {
    asm volatile("s_waitcnt vmcnt(0)" ::: "memory");
    __syncthreads();
    if (threadIdx.x == 0) {
        unsigned* bar = b.bar;
        __builtin_amdgcn_s_waitcnt(0);
        if (b.nloc == 0u) xcd_barrier_complete(bar, b.x, b.nloc, b.nx);
        const unsigned nloc = b.nloc, nx = b.nx;
        const unsigned old = xb_add(&bar[XB_XSUB(b.x)], 1u);
        const unsigned gen = old / nloc;
        if (old + 1u == (gen + 1u) * nloc) {
            __builtin_amdgcn_fence(__ATOMIC_RELEASE, "agent");
            asm volatile("s_waitcnt vmcnt(0)" ::: "memory");
            const unsigned og = xb_add(&bar[XB_TOP], 1u);
            const unsigned tg = og / nx;
            if (og + 1u == (tg + 1u) * nx) xb_add(&bar[XB_TOPGEN], 1u);
            else XB_SPIN(xb_ld(&bar[XB_TOPGEN]) == tg, bar);
            __builtin_amdgcn_fence(__ATOMIC_ACQUIRE, "agent");
            xb_add(&bar[XB_XGEN(b.x)], 1u);
            asm volatile("s_waitcnt vmcnt(0)" ::: "memory");
        } else {
            XB_SPIN(xb_ld(&bar[XB_XGEN(b.x)]) == gen, bar);
            __builtin_amdgcn_fence(__ATOMIC_ACQUIRE, "agent");
            asm volatile("s_waitcnt vmcnt(0)" ::: "memory");
        }
    }
    __syncthreads();
}

__device__ __forceinline__ void prep_convT(const float* __restrict__ srcp, bf16_t* __restrict__ dst, int K, int N, char* lds, int& cursor) {
    float (*tile)[32][33] = (float (*)[32][33])lds;
    const int tx = threadIdx.x & 31, ty = threadIdx.x >> 5;
    const int ntn = N / 32, ntiles = ntn * (K / 32);
    const int G = gridDim.x;
    const int first = ((int)blockIdx.x - cursor % G + G) % G;
    for (int t = first; t < ntiles; t += 4 * G) {
#pragma unroll
        for (int u = 0; u < 4; ++u) {
            const int tt = t + u * G;
            if (tt < ntiles) { const int n0 = (tt % ntn) * 32, k0 = (tt / ntn) * 32;
#pragma unroll
                for (int i = 0; i < 2; ++i) tile[u][ty + 16 * i][tx] = srcp[(size_t)(k0 + ty + 16 * i) * N + n0 + tx]; }
        }
        __syncthreads();
#pragma unroll
        for (int u = 0; u < 4; ++u) {
            const int tt = t + u * G;
            if (tt < ntiles) { const int n0 = (tt % ntn) * 32, k0 = (tt / ntn) * 32;
#pragma unroll
                for (int i = 0; i < 2; ++i) dst[(size_t)(n0 + ty + 16 * i) * K + k0 + tx] = f2bf(tile[u][tx][ty + 16 * i]); }
        }
        __syncthreads();
    }
    cursor += ntiles;
}
__device__ __forceinline__ void prep_conv(const float* __restrict__ srcp, bf16_t* __restrict__ dst, size_t n8) {
    for (size_t i = (size_t)blockIdx.x * blockDim.x + threadIdx.x; i < n8; i += (size_t)gridDim.x * blockDim.x) {
        const float4 a = *(const float4*)(srcp + i * 8), b = *(const float4*)(srcp + i * 8 + 4);
        uint4 o; o.x = pack2(a.x, a.y); o.y = pack2(a.z, a.w); o.z = pack2(b.x, b.y); o.w = pack2(b.z, b.w);
        *(uint4*)(dst + i * 8) = o;
    }
}
__device__ __forceinline__ void prep_ada(const float* __restrict__ c, const float* __restrict__ w_ada, const float* __restrict__ b_ada, float* __restrict__ mod, char* lds) {
    float* sc = (float*)lds;
    float* part = (float*)(lds + 16384);
    const int tid = threadIdx.x, col = tid & 63, kq = tid >> 6;
    const int G = gridDim.x;
    for (int item = (int)blockIdx.x - (G - 96 > 0 ? G - 96 : 0); item >= 0 && item < 96; item += G) {
        __syncthreads();
        for (int i = tid; i < 4096; i += NTHR) { const float v = c[i]; sc[i] = v * sigmoidf_(v); }
        __syncthreads();
        const int e = item * 64 + col;
        float a0 = 0.f, a1 = 0.f, a2 = 0.f, a3 = 0.f;
#pragma unroll 16
        for (int d = kq * 128; d < kq * 128 + 128; ++d) {
            const float wv = w_ada[(size_t)d * 6144 + e];
            a0 += sc[d] * wv; a1 += sc[1024 + d] * wv; a2 += sc[2048 + d] * wv; a3 += sc[3072 + d] * wv;
        }
        part[(kq * 4 + 0) * 64 + col] = a0; part[(kq * 4 + 1) * 64 + col] = a1; part[(kq * 4 + 2) * 64 + col] = a2; part[(kq * 4 + 3) * 64 + col] = a3;
        __syncthreads();
        if (tid < 256) { const int b = tid >> 6;
          float s = 0.f;
#pragma unroll
          for (int k8 = 0; k8 < 8; ++k8) s += part[(k8 * 4 + b) * 64 + col];
          mod[b * 6144 + e] = s + b_ada[e]; }
    }
}

__device__ __forceinline__ void prep_quant(const float* __restrict__ srcp, unsigned char* __restrict__ dst, float* __restrict__ scales, int rows, int off) {
    const int lane = threadIdx.x & 63, w = threadIdx.x >> 6;
    const int nwaves = gridDim.x * NW;
    for (int rb = (blockIdx.x * NW + w) * 4; rb < rows; rb += nwaves * 4) {
        float4 v[4][4];
#pragma unroll
        for (int u = 0; u < 4; ++u)
#pragma unroll
            for (int j = 0; j < 4; ++j) v[u][j] = *(const float4*)(srcp + (size_t)(rb + u) * 1024 + lane * 16 + j * 4);
#pragma unroll
        for (int u = 0; u < 4; ++u) {
            const int r = rb + u;
            float am = 0.f;
#pragma unroll
            for (int j = 0; j < 4; ++j) am = fmaxf(am, fmaxf(fmaxf(fabsf(v[u][j].x), fabsf(v[u][j].y)), fmaxf(fabsf(v[u][j].z), fabsf(v[u][j].w))));
            for (int o = 32; o > 0; o >>= 1) am = fmaxf(am, __shfl_xor(am, o));
            unsigned o4[4];
            if (off < 0) {
                const float inv8 = am > 0.f ? 448.0f / am : 0.f;
                if (lane == 0) scales[r] = am > 0.f ? am * (1.0f / 448.0f) : 1.0f;
#pragma unroll
                for (int j = 0; j < 4; ++j) {
                    int p = 0;
                    p = __builtin_amdgcn_cvt_pk_fp8_f32(v[u][j].x * inv8, v[u][j].y * inv8, p, false);
                    p = __builtin_amdgcn_cvt_pk_fp8_f32(v[u][j].z * inv8, v[u][j].w * inv8, p, true);
                    o4[j] = (unsigned)p;
                }
            } else {
                const float inv = am > 0.f ? 127.0f / am : 0.f;
                if (lane == 0) scales[r] = am > 0.f ? am * (1.0f / 127.0f) : 1.0f;
#pragma unroll
                for (int j = 0; j < 4; ++j) {
                    const int q0 = __float2int_rn(v[u][j].x * inv) + off, q1 = __float2int_rn(v[u][j].y * inv) + off, q2 = __float2int_rn(v[u][j].z * inv) + off, q3 = __float2int_rn(v[u][j].w * inv) + off;
                    o4[j] = (unsigned)(q0 & 0xff) | ((unsigned)(q1 & 0xff) << 8) | ((unsigned)(q2 & 0xff) << 16) | ((unsigned)(q3 & 0xff) << 24);
                }
            }
            *(uint4*)(dst + (size_t)(lane >> 3) * ((size_t)rows * 128) + (size_t)r * 128 + (lane & 7) * 16) = make_uint4(o4[0], o4[1], o4[2], o4[3]);
        }
    }
}
template <bool QUANT>
__device__ __forceinline__ void phase_norm(const float* __restrict__ x, const float* __restrict__ g, const float* __restrict__ mod, int sh_off, int sc_off, bf16_t* __restrict__ H,
                                           unsigned char* __restrict__ HQ, float* __restrict__ HSC) {
    const int lane = threadIdx.x & 63, w = threadIdx.x >> 6;
    const int nwaves = gridDim.x * NW;
    for (int tb = (blockIdx.x * NW + w) * 2; tb < NTOK; tb += nwaves * 2) {
        float4 v[2][4];
#pragma unroll
        for (int u = 0; u < 2; ++u)
#pragma unroll
            for (int j = 0; j < 4; ++j) v[u][j] = *(const float4*)(x + (size_t)(tb + u) * 1024 + j * 256 + lane * 4);
#pragma unroll
        for (int u = 0; u < 2; ++u) {
            const int t = tb + u; const int b = t / SEQ;
            float ss = 0.f;
#pragma unroll
            for (int j = 0; j < 4; ++j) ss += v[u][j].x * v[u][j].x + v[u][j].y * v[u][j].y + v[u][j].z * v[u][j].z + v[u][j].w * v[u][j].w;
            for (int o = 32; o > 0; o >>= 1) ss += __shfl_xor(ss, o);
            const float r = rsqrtf(ss * (1.0f / 1024.0f) + EPS);
            float am = 0.f;
#pragma unroll
            for (int j = 0; j < 4; ++j) {
                const int c = j * 256 + lane * 4;
                const float4 gg = *(const float4*)(g + c), sc = *(const float4*)(mod + b * 6144 + sc_off + c), sh = *(const float4*)(mod + b * 6144 + sh_off + c);
                float4& vv = v[u][j];
                vv.x = vv.x * r * gg.x * (1.0f + sc.x) + sh.x; vv.y = vv.y * r * gg.y * (1.0f + sc.y) + sh.y;
                vv.z = vv.z * r * gg.z * (1.0f + sc.z) + sh.z; vv.w = vv.w * r * gg.w * (1.0f + sc.w) + sh.w;
                *(uint2*)(H + (size_t)t * 1024 + c) = pack4(vv.x, vv.y, vv.z, vv.w);
                if (QUANT) am = fmaxf(am, fmaxf(fmaxf(fabsf(vv.x), fabsf(vv.y)), fmaxf(fabsf(vv.z), fabsf(vv.w))));
            }
            if (QUANT) {
                for (int o = 32; o > 0; o >>= 1) am = fmaxf(am, __shfl_xor(am, o));
                const float inv = am > 0.f ? 127.0f / am : 0.f;
                if (lane == 0) HSC[t] = am > 0.f ? am * (1.0f / 127.0f) : 1.0f;
#pragma unroll
                for (int j = 0; j < 4; ++j) {
                    const float4 vv = v[u][j];
                    const int q0 = __float2int_rn(vv.x * inv), q1 = __float2int_rn(vv.y * inv), q2 = __float2int_rn(vv.z * inv), q3 = __float2int_rn(vv.w * inv);
                    *(unsigned*)(HQ + (size_t)t * 1024 + j * 256 + lane * 4) = (unsigned)(q0 & 0xff) | ((unsigned)(q1 & 0xff) << 8) | ((unsigned)(q2 & 0xff) << 16) | ((unsigned)(q3 & 0xff) << 24);
                }
            }
        }
    }
}
struct MegaParams {
    const float* in[24];
    float* out;
    char* ws;
    int use_cg; int pad;
};
#define MEGA_LDS_BYTES (NW * 16384 + 1024)
#ifndef PROBE_DUP
#define PROBE_DUP 0
#endif
#define W_CTL   ((float*)(ws + OFF_CTL))
#define W_MOD   ((float*)(ws + OFF_MOD))
#define W_WTIN  ((bf16_t*)(ws + OFF_WTIN))
#define W_WTA   ((bf16_t*)(ws + OFF_WTA))
#define W_WTB   ((bf16_t*)(ws + OFF_WTB))
#define W_WTOUT ((bf16_t*)(ws + OFF_WTOUT))
#define W_WTQ   ((bf16_t*)(ws + OFF_WTQ))
#define W_SUBK  ((bf16_t*)(ws + OFF_SUBK))
#define W_DOWN  ((bf16_t*)(ws + OFF_DOWN))
#define W_UP    ((bf16_t*)(ws + OFF_UP))
#define W_H     ((bf16_t*)(ws + OFF_H))
#define W_Q     ((bf16_t*)(ws + OFF_Q))
#define W_K     ((bf16_t*)(ws + OFF_K))
#define W_V     ((bf16_t*)(ws + OFF_VT))
#define W_U     ((bf16_t*)(ws + OFF_U))
#define W_SV    ((bf16_t*)(ws + OFF_SV))
#define W_GATES ((bf16_t*)(ws + OFF_GATES))
#define W_YA    ((bf16_t*)(ws + OFF_YA))
#define W_YB    ((bf16_t*)(ws + OFF_YB))
#define W_MERGED ((bf16_t*)(ws + OFF_MERGED))
#define W_EIDX  ((int*)(ws + OFF_EIDX))
#define W_GW    ((float*)(ws + OFF_GW))
__global__ __launch_bounds__(NTHR, 2) void k_mega(MegaParams P) {
    cg::grid_group grid = cg::this_grid();
    char* lds = dyn_lds; char* ws = P.ws;
    const float* x = P.in[0];
    XcdBarrier xb; xcd_barrier_post(xb, (unsigned*)(ws + OFF_BAR));
    prep_ada(P.in[1], P.in[2], P.in[3], W_MOD, lds);
    if (blockIdx.x == 0 && threadIdx.x == 0) {
        float s1 = 0.f, s2 = 0.f;
        for (int i = 0; i < 64; ++i) { s1 += P.in[6][i] * P.in[7][i]; s2 += P.in[8][i] * P.in[9][i]; }
        W_CTL[0] = __expf(s1) - __expf(s2) + 0.2f;
    }
    { int cursor = 0;
      __syncthreads();
      prep_convT(P.in[5], W_WTIN, 1024, IN_COLS, lds, cursor);
      prep_convT(P.in[15], W_WTA, 512, 1024, lds, cursor);
      prep_convT(P.in[16], W_WTB, 512, 1024, lds, cursor);
      prep_convT(P.in[17], W_WTOUT, 1024, 1024, lds, cursor);
      prep_convT(P.in[19], W_WTQ, 1024, 2048, lds, cursor); }
    prep_conv(P.in[20], W_SUBK, (size_t)8 * 2 * 128 * 128 / 8);
    if (P.use_cg) grid.sync(); else xcd_barrier(xb);
    phase_norm<false>(x, P.in[4], W_MOD, 0, 1024, W_H, nullptr, nullptr);
    xcd_barrier(xb);
#if PROBE_DUP == 2
    phase_inproj(W_H, W_WTIN, W_Q, W_K, W_V, W_U, W_SV, W_GATES, lds);
#endif
    phase_inproj(W_H, W_WTIN, W_Q, W_K, W_V, W_U, W_SV, W_GATES, lds);
    xcd_barrier(xb);
    { const bool sgu_first = ((blockIdx.x >> 3) & 1) != 0;
      if (sgu_first) phase_sgu(W_U, W_SV, P.in[11], P.in[12], P.in[13], P.in[14], W_YB, lds);
      if (sgu_first) { prep_quant(P.in[21], (unsigned char*)(ws + OFF_DOWN), (float*)(ws + OFF_DSC), 16384, 0); prep_quant(P.in[22], (unsigned char*)(ws + OFF_UP), (float*)(ws + OFF_USC), 16384, -1); }
      phase_attn(W_Q, W_K, W_V, W_CTL, P.in[10], W_YA, lds);
      if (!sgu_first) { prep_quant(P.in[21], (unsigned char*)(ws + OFF_DOWN), (float*)(ws + OFF_DSC), 16384, 0); prep_quant(P.in[22], (unsigned char*)(ws + OFF_UP), (float*)(ws + OFF_USC), 16384, -1);
                        phase_sgu(W_U, W_SV, P.in[11], P.in[12], P.in[13], P.in[14], W_YB, lds); } }
    xcd_barrier(xb);
#if PROBE_DUP == 5
    phase_merged(W_YA, W_YB, W_WTA, W_WTB, W_GATES, W_MERGED, lds);
#endif
    phase_merged(W_YA, W_YB, W_WTA, W_WTB, W_GATES, W_MERGED, lds);
    xcd_barrier(xb);
#if PROBE_DUP == 6
    phase_outproj(W_MERGED, W_WTOUT, x, W_MOD, P.out, lds);
#endif
    phase_outproj(W_MERGED, W_WTOUT, x, W_MOD, P.out, lds);
    xcd_barrier(xb);
    phase_norm<true>(P.out, P.in[18], W_MOD, 3072, 4096, W_H, (unsigned char*)(ws + OFF_HQ), (float*)(ws + OFF_HSC));
    xcd_barrier(xb);
#if PROBE_DUP == 8
    phase_peer_select(W_H, W_WTQ, W_SUBK, W_EIDX, W_GW, lds);
#endif
    phase_peer_select(W_H, W_WTQ, W_SUBK, W_EIDX, W_GW, lds);
    xcd_barrier(xb);
    phase_peer_expert((const unsigned char*)(ws + OFF_HQ), (const float*)(ws + OFF_HSC), W_EIDX, W_GW, (const unsigned char*)(ws + OFF_DOWN), (const unsigned char*)(ws + OFF_UP), (const float*)(ws + OFF_DSC), (const float*)(ws + OFF_USC), W_MOD, P.in[23], P.out, (float*)(ws + OFF_GATES), P.out, lds);
}

extern "C" void kernel_launch(void* const* d_in, const int* in_sizes, int n_in, void* d_out, int out_size, void* d_ws, size_t ws_size, hipStream_t stream) {
    if (ws_size < OFF_END || n_in < 24) return;
    static int grid_blocks = 0;
    if (!grid_blocks) {
        int dev = 0, cus = 0, per_cu = 0;
        hipGetDevice(&dev);
        hipDeviceGetAttribute(&cus, hipDeviceAttributeMultiprocessorCount, dev);
        hipFuncSetAttribute((const void*)k_mega, hipFuncAttributeMaxDynamicSharedMemorySize, MEGA_LDS_BYTES);
        hipOccupancyMaxActiveBlocksPerMultiprocessor(&per_cu, k_mega, NTHR, MEGA_LDS_BYTES);
        if (per_cu > 1) per_cu = 1;
        if (per_cu < 1) per_cu = 1;
        grid_blocks = cus * per_cu;
    }
    MegaParams P{};
    for (int i = 0; i < 24; ++i) P.in[i] = (const float*)d_in[i];
    P.out = (float*)d_out; P.ws = (char*)d_ws;
    hipMemsetAsync((char*)d_ws + OFF_BAR, 0, XCD_BAR_WORDS * 4, stream);
    void* args[] = {&P};
    hipError_t e = hipLaunchCooperativeKernel((void*)k_mega, dim3(grid_blocks), dim3(NTHR), args, MEGA_LDS_BYTES, stream);
    if (e != hipSuccess) fprintf(stderr, "cooperative launch failed: %s (grid %d)\n", hipGetErrorString(e), grid_blocks);
}
```

```cpp
#include <hip/hip_runtime.h>
#include <hip/hip_cooperative_groups.h>
#include <stdint.h>
#include <stdio.h>
namespace cg = cooperative_groups;

typedef unsigned short bf16_t;

#define D_MODEL 1024
#define BATCH 4
#define SEQ 8192
#define NTOK (BATCH * SEQ)
#define IN_COLS 4608
#define EPS 1e-6f
#define QSCALE 0.18033688011112042f

__device__ __forceinline__ float bf2f(bf16_t v) { return __uint_as_float(((unsigned)v) << 16); }
typedef __bf16 bf16v2_t __attribute__((ext_vector_type(2)));
__device__ __forceinline__ bf16_t f2bf(float f) { return __builtin_bit_cast(unsigned short, (__bf16)f); }
__device__ __forceinline__ unsigned pack2(float a, float b) { bf16v2_t v; v[0] = (__bf16)a; v[1] = (__bf16)b; return __builtin_bit_cast(unsigned, v); }
__device__ __forceinline__ float gelu_tanh(float x) {
    const float z2 = 1.5957691216057308f * (x + 0.044715f * x * x * x);
    return x * __builtin_amdgcn_rcpf(1.0f + __expf(-z2));
}
__device__ __forceinline__ float sigmoidf_(float x) { return __builtin_amdgcn_rcpf(1.0f + __expf(-x)); }

constexpr size_t OFF_CTL   = 0;
constexpr size_t OFF_BAR   = 4096;
constexpr size_t OFF_MOD   = 4096 + 16384;
constexpr size_t OFF_STATS = OFF_MOD + 4 * 6144 * 4;
constexpr size_t OFF_WTIN  = OFF_STATS + (size_t)NTOK * 2 * 4;
constexpr size_t OFF_WTA   = OFF_WTIN + (size_t)IN_COLS * 1024 * 2;
constexpr size_t OFF_WTB   = OFF_WTA + (size_t)1024 * 512 * 2;
constexpr size_t OFF_WTOUT = OFF_WTB + (size_t)1024 * 512 * 2;
constexpr size_t OFF_WTQ   = OFF_WTOUT + (size_t)1024 * 1024 * 2;
constexpr size_t OFF_SUBK  = OFF_WTQ + (size_t)2048 * 1024 * 2;
constexpr size_t OFF_DOWN  = OFF_SUBK + (size_t)8 * 2 * 128 * 128 * 2;
constexpr size_t OFF_UP    = OFF_DOWN + (size_t)16384 * 1024;
constexpr size_t OFF_DSC   = OFF_UP + (size_t)16384 * 1024;
constexpr size_t OFF_USC   = OFF_DSC + (size_t)16384 * 4;
constexpr size_t OFF_H     = OFF_USC + (size_t)16384 * 4;
constexpr size_t OFF_Q     = OFF_H + (size_t)NTOK * 1024 * 2;
constexpr size_t OFF_K     = OFF_Q + (size_t)NTOK * 512 * 2;
constexpr size_t OFF_VT    = OFF_K + (size_t)NTOK * 512 * 2;
constexpr size_t OFF_U     = OFF_VT + (size_t)NTOK * 512 * 2;
constexpr size_t OFF_SV    = OFF_U + (size_t)NTOK * 512 * 2;
constexpr size_t OFF_GATES = OFF_SV + (size_t)NTOK * 512 * 2;
constexpr size_t OFF_YA    = OFF_GATES + (size_t)NTOK * 2048 * 2;
constexpr size_t OFF_YB    = OFF_YA + (size_t)NTOK * 512 * 2;
constexpr size_t OFF_END   = OFF_YB + (size_t)NTOK * 512 * 2;
constexpr size_t OFF_MERGED = OFF_Q;
constexpr size_t OFF_EIDX  = OFF_U;
constexpr size_t OFF_GW    = OFF_SV;
constexpr size_t OFF_HQ    = OFF_YA;
constexpr size_t OFF_HSC   = OFF_STATS;

#define NW 8
#define NTHR (NW * 64)
extern __shared__ __attribute__((aligned(16))) char dyn_lds[];
using bf16x8 = __attribute__((ext_vector_type(8))) short;
using f32x4 = __attribute__((ext_vector_type(4))) float;
typedef float f32x2_t __attribute__((ext_vector_type(2)));
typedef _Float16 h2_t __attribute__((ext_vector_type(2)));
typedef __attribute__((address_space(3))) char* lds_ptr_t;
#define GEMM_LDS_BYTES 65536
#define SEL_LDS_BYTES 81920

__device__ __forceinline__ uint2 pack4(float a, float b, float c, float d) {
    uint2 r; r.x = pack2(a, b); r.y = pack2(c, d); return r;
}


namespace pg8 {
#define PG8_LAS __attribute__((address_space(3)))
typedef unsigned short bf16_t;
typedef short bf16x8 __attribute__((ext_vector_type(8)));
typedef float f32x4 __attribute__((ext_vector_type(4)));
typedef unsigned u32x4 __attribute__((ext_vector_type(4)));
constexpr int BM = 256, BK = 64, HALF = 128, HTB = HALF * BK * 2  , STAGE_BYTES = 8 * HTB, NXCD = 8, WGM = 8;

__host__ __device__ __forceinline__ int lds_byte(int r, int c) { const int st = (r >> 4) * 2 + (c >> 5), rr = r & 15, cc = c & 31, ob = rr * 64 + cc * 2; return st * 1024 + (ob ^ (((ob >> 9) & 1) << 5)); }
__host__ __device__ __forceinline__ void stage_rc(int b, int& R, int& C) { const int st = b / 1024, sb = b % 1024, swz = sb ^ (((sb >> 9) & 1) << 5); R = (st >> 1) * 16 + swz / 64; C = (st & 1) * 32 + (swz % 64) / 2; }
__host__ __device__ __forceinline__ int perm32(int rho) { const int n = rho >> 4, i = rho & 15; return 8 * (i >> 2) + 4 * n + (i & 3); }

struct Unit { int pm, pn; };
struct Gemm { const bf16_t* A; const bf16_t* Bt; int M, N, K; };

struct StaticOrder {
    int nM, nN, nwg, G, c;
    __host__ __device__ void init(int M, int N, int G_, int c_) { nM = M / BM; nN = N / BM; nwg = nM * nN; G = G_; c = c_; }
    __host__ __device__ bool next(int i, Unit& u) const {
        const long L = (long)i * G + c; if (L >= nwg) return false;
        int wgid = (int)L; { const int q = nwg / NXCD, r = nwg % NXCD, xcd = wgid % NXCD, off = wgid / NXCD; wgid = (xcd < r ? xcd * (q + 1) : r * (q + 1) + (xcd - r) * q) + off; }
        const int nig = WGM * nN, gid = wgid / nig, fm = gid * WGM, gsz = (nM - fm) < WGM ? (nM - fm) : WGM;
        u.pm = fm + ((wgid % nig) % gsz); u.pn = (wgid % nig) / gsz; return true;
    }
    __device__ __forceinline__ void a_ready(const Unit&) const {}
    __device__ __forceinline__ void done(const Unit&) const {}
};

template <class Epi, class Sched, bool STAMP = false>
__device__ __forceinline__ void gemm_phase(PG8_LAS unsigned char* lds, const Gemm g, const Sched& S, const Epi& E, unsigned long long* stamps) {
    const int tid = threadIdx.x, wid = __builtin_amdgcn_readfirstlane(tid >> 6), lane = tid & 63, wr = wid >> 2, wc = wid & 3, fr = lane & 15, fq = lane >> 4;
    const int K = g.K, nt = K / BK;
    int ts_lo = 0, ts_hi = 0, nts = 0; const unsigned long long rt_entry = STAMP ? (unsigned long long)wall_clock64() : 0ull;
#define PG8_STAMP() do { if (STAMP && wid == 0 && nts < 64) { const unsigned long long _c = (unsigned long long)clock64(); \
        ts_lo = (lane == nts) ? (int)(unsigned)_c : ts_lo; ts_hi = (lane == nts) ? (int)(unsigned)(_c >> 32) : ts_hi; ++nts; } } while (0)
    PG8_STAMP();
    unsigned voffA[2], voffB[2];
#pragma unroll
    for (int i = 0; i < 2; ++i) { int R, C; stage_rc(tid * 16 + i * 8192, R, C); const int Rb = Epi::PERM ? ((R & ~31) + perm32(R & 31)) : R;
        voffA[i] = (unsigned)(R * K + C) * 2u; voffB[i] = (unsigned)(Rb * K + C) * 2u; }
    const size_t kstep = (size_t)(BK * 2);
    const size_t hstep = (size_t)HALF * K * 2;
    const size_t tstep = 2 * hstep;
    const unsigned ldsw = (unsigned)wid * 1024u;
    const int aoff = lds_byte(wr * 64 + fr, fq * 8), boff = lds_byte(wc * 32 + fr, fq * 8);
#define PG8_SA(b, h) (((b) * 2 + (h)) * HTB)
#define PG8_SB(b, h) ((4 + (b) * 2 + (h)) * HTB)
#define PG8_STAGE(bufoff, gbase, voff) do { _Pragma("unroll") for (int _i = 0; _i < 2; ++_i) \
        __builtin_amdgcn_global_load_lds((const unsigned*)((const char*)(gbase) + (voff)[_i]), (PG8_LAS unsigned*)(lds + (bufoff) + ldsw + _i * 8192), 16, 0, 0); } while (0)
#define PG8_LDA(dst, b, h) do { _Pragma("unroll") for (int m = 0; m < 4; ++m) _Pragma("unroll") for (int k = 0; k < 2; ++k) dst[m][k] = *(const PG8_LAS bf16x8*)(lds + PG8_SA(b, h) + aoff + m * 2048 + k * 1024); } while (0)
#define PG8_LDB(dst, b, h) do { _Pragma("unroll") for (int n = 0; n < 2; ++n) _Pragma("unroll") for (int k = 0; k < 2; ++k) dst[n][k] = *(const PG8_LAS bf16x8*)(lds + PG8_SB(b, h) + boff + n * 2048 + k * 1024); } while (0)
#define PG8_MMA(ai, bj, At, Bt) do { __builtin_amdgcn_s_setprio(1); _Pragma("unroll") for (int m = 0; m < 4; ++m) _Pragma("unroll") for (int n = 0; n < 2; ++n) _Pragma("unroll") for (int k = 0; k < 2; ++k) \
        acc[ai][bj][m][n] = __builtin_amdgcn_mfma_f32_16x16x32_bf16(Bt[n][k], At[m][k], acc[ai][bj][m][n], 0, 0, 0); __builtin_amdgcn_s_setprio(0); } while (0)
#define PG8_WAIT_V(n) asm volatile("s_waitcnt vmcnt(" #n ")" ::: "memory")
#define PG8_WAIT_L(n) asm volatile("s_waitcnt lgkmcnt(" #n ")" ::: "memory")
#define PG8_BAR __builtin_amdgcn_s_barrier()
#define PG8_SCHED __builtin_amdgcn_sched_barrier(0)
    Unit cur, nxt; int ui = 0;
    if (!S.next(0, cur)) return;
    f32x4 acc[2][2][4][2];
#pragma unroll
    for (int a = 0; a < 2; ++a)
#pragma unroll
        for (int b = 0; b < 2; ++b)
#pragma unroll
            for (int m = 0; m < 4; ++m)
#pragma unroll
                for (int n = 0; n < 2; ++n) acc[a][b][m][n] = (f32x4){0.f, 0.f, 0.f, 0.f};
    bf16x8 At[4][2], B0[2][2], B1[2][2];
    const char* cA = (const char*)g.A + (size_t)cur.pm * tstep; const char* cB = (const char*)g.Bt + (size_t)cur.pn * tstep;
    S.a_ready(cur);
    PG8_STAGE(PG8_SB(0, 0), cB, voffB); PG8_STAGE(PG8_SA(0, 0), cA, voffA); PG8_STAGE(PG8_SB(0, 1), cB + hstep, voffB); PG8_STAGE(PG8_SA(0, 1), cA + hstep, voffA);
    if (wr == 1) PG8_BAR;
    PG8_WAIT_V(4); PG8_BAR;
    PG8_STAGE(PG8_SB(1, 0), cB + kstep, voffB); PG8_STAGE(PG8_SA(1, 0), cA + kstep, voffA); PG8_STAGE(PG8_SB(1, 1), cB + hstep + kstep, voffB);
    PG8_WAIT_V(6); PG8_BAR;
    PG8_STAMP();
    for (;;) {
        const bool has_next = S.next(ui + 1, nxt);
        const char* nA = has_next ? (const char*)g.A + (size_t)nxt.pm * tstep : cA; const char* nB = has_next ? (const char*)g.Bt + (size_t)nxt.pn * tstep : cB;
        for (int t = 0; t < nt; t += 2) {
            const bool last = (t == nt - 2);
            const char* a1 = cA + (size_t)(t + 1) * kstep;
            const char* a2 = last ? nA : cA + (size_t)(t + 2) * kstep; const char* b2 = last ? nB : cB + (size_t)(t + 2) * kstep;
            const char* a3 = a2 + kstep; const char* b3 = b2 + kstep;
            if (last && has_next) S.a_ready(nxt);
            PG8_LDB(B0, 0, 0); PG8_SCHED; PG8_LDA(At, 0, 0); PG8_STAGE(PG8_SA(1, 1), a1 + hstep, voffA);
            PG8_WAIT_L(8); PG8_BAR; PG8_WAIT_L(0); PG8_MMA(0, 0, At, B0); PG8_BAR; PG8_SCHED;
            PG8_LDB(B1, 0, 1); PG8_STAGE(PG8_SB(0, 0), b2, voffB);
            PG8_BAR; PG8_WAIT_L(0); PG8_MMA(0, 1, At, B1); PG8_BAR;
            PG8_LDA(At, 0, 1); PG8_STAGE(PG8_SA(0, 0), a2, voffA);
            PG8_BAR; PG8_WAIT_L(0); PG8_MMA(1, 0, At, B0); PG8_BAR; PG8_SCHED;
            PG8_STAGE(PG8_SB(0, 1), b2 + hstep, voffB);
            PG8_WAIT_V(6); PG8_BAR; PG8_MMA(1, 1, At, B1); PG8_BAR;
            PG8_LDB(B0, 1, 0); PG8_SCHED; PG8_LDA(At, 1, 0); PG8_STAGE(PG8_SA(0, 1), a2 + hstep, voffA);
            PG8_WAIT_L(8); PG8_BAR; PG8_WAIT_L(0); PG8_MMA(0, 0, At, B0); PG8_BAR; PG8_SCHED;
            PG8_LDB(B1, 1, 1); PG8_STAGE(PG8_SB(1, 0), b3, voffB);
            PG8_BAR; PG8_WAIT_L(0); PG8_MMA(0, 1, At, B1); PG8_BAR;
            PG8_LDA(At, 1, 1); PG8_STAGE(PG8_SA(1, 0), a3, voffA);
            PG8_BAR; PG8_WAIT_L(0); PG8_MMA(1, 0, At, B0); PG8_BAR; PG8_SCHED;
            PG8_STAGE(PG8_SB(1, 1), b3 + hstep, voffB);
            PG8_WAIT_V(6); PG8_BAR; PG8_MMA(1, 1, At, B1); PG8_BAR;
        }
        PG8_STAMP();
        if constexpr (!Epi::AFTER_DRAIN) { E(acc, cur, wr, wc, fr, fq); S.done(cur); }
        PG8_STAMP();
        if (!has_next) break;
#pragma unroll
        for (int a = 0; a < 2; ++a)
#pragma unroll
            for (int b = 0; b < 2; ++b)
#pragma unroll
                for (int m = 0; m < 4; ++m)
#pragma unroll
                    for (int n = 0; n < 2; ++n) acc[a][b][m][n] = (f32x4){0.f, 0.f, 0.f, 0.f};
        cur = nxt; cA = nA; cB = nB; ++ui;
    }
    PG8_WAIT_V(0);
    if (wr == 0) PG8_BAR;
    PG8_BAR;
    if constexpr (Epi::AFTER_DRAIN) { E.fused(acc, cur, wr, wc, fr, fq, lds, wid, lane); S.done(cur); }
    PG8_STAMP();
    if (STAMP && wid == 0) { stamps[lane] = lane < nts ? (((unsigned long long)(unsigned)ts_hi << 32) | (unsigned)ts_lo) : 0ull;
        if (lane == 62) stamps[62] = rt_entry; if (lane == 63) stamps[63] = (unsigned long long)wall_clock64(); }
#undef PG8_STAMP
#undef PG8_SA
#undef PG8_SB
#undef PG8_STAGE
#undef PG8_LDA
#undef PG8_LDB
#undef PG8_MMA
#undef PG8_WAIT_V
#undef PG8_WAIT_L
#undef PG8_BAR
#undef PG8_SCHED
}
}

struct EpiInProj8 {
    static constexpr bool PERM = true, AFTER_DRAIN = false;
    bf16_t *Q, *Kb, *V, *U, *SV, *G;
    __device__ __forceinline__ void operator()(const pg8::f32x4 (&acc)[2][2][4][2], const pg8::Unit& u, int wr, int wc, int fr, int fq) const {
        const int row0 = u.pm * 256 + wr * 64 + fr; const int colt = u.pn * 256;
        bf16_t* base; int ld, cl, act;
        if (colt < 512) { base = Q; ld = 512; cl = colt; act = 1; }
        else if (colt < 1024) { base = Kb; ld = 512; cl = colt - 512; act = 0; }
        else if (colt < 1536) { base = V; ld = 512; cl = colt - 1024; act = 0; }
        else if (colt < 2048) { base = U; ld = 512; cl = colt - 1536; act = 2; }
        else if (colt < 2560) { base = SV; ld = 512; cl = colt - 2048; act = 2; }
        else { base = G; ld = 2048; cl = colt - 2560; act = 3; }
        const int col0 = cl + wc * 32 + 8 * fq;
#pragma unroll
        for (int ai = 0; ai < 2; ++ai)
#pragma unroll
            for (int m = 0; m < 4; ++m) { bf16_t* rowp = base + (size_t)(row0 + ai * 128 + m * 16) * ld + col0;
#pragma unroll
                for (int bj = 0; bj < 2; ++bj) { pg8::f32x4 v0 = acc[ai][bj][m][0], v1 = acc[ai][bj][m][1];
                    if (act == 1) { v0 *= QSCALE; v1 *= QSCALE; }
                    else if (act == 2) {
#pragma unroll
                        for (int j = 0; j < 4; ++j) { v0[j] = gelu_tanh(v0[j]); v1[j] = gelu_tanh(v1[j]); } }
                    else if (act == 3) {
#pragma unroll
                        for (int j = 0; j < 4; ++j) { v0[j] = sigmoidf_(v0[j]); v1[j] = sigmoidf_(v1[j]); } }
                    uint4 wv; wv.x = pack2(v0[0], v0[1]); wv.y = pack2(v0[2], v0[3]); wv.z = pack2(v1[0], v1[1]); wv.w = pack2(v1[2], v1[3]);
                    *(uint4*)(rowp + bj * 128) = wv; } }
    }
};

struct EpiOut8 {
    static constexpr bool PERM = true, AFTER_DRAIN = false;
    const float* x; const float* mod; bf16_t* x1;
    __device__ __forceinline__ void operator()(const pg8::f32x4 (&acc)[2][2][4][2], const pg8::Unit& u, int wr, int wc, int fr, int fq) const {
        const int row0 = u.pm * 256 + wr * 64 + fr, col0 = u.pn * 256 + wc * 32 + 8 * fq;
        const int b = (u.pm * 256) / SEQ;
        pg8::f32x4 g1[2][2];
#pragma unroll
        for (int bj = 0; bj < 2; ++bj)
#pragma unroll
            for (int n = 0; n < 2; ++n) g1[bj][n] = *(const pg8::f32x4*)(mod + b * 6144 + 2048 + col0 + bj * 128 + n * 4);
#pragma unroll
        for (int ai = 0; ai < 2; ++ai)
#pragma unroll
            for (int m = 0; m < 4; ++m) { const size_t ro = (size_t)(row0 + ai * 128 + m * 16) * 1024 + col0;
#pragma unroll
                for (int bj = 0; bj < 2; ++bj) {
                    const pg8::f32x4 xa = *(const pg8::f32x4*)(x + ro + bj * 128), xb = *(const pg8::f32x4*)(x + ro + bj * 128 + 4);
                    const pg8::f32x4 v0 = xa + g1[bj][0] * acc[ai][bj][m][0], v1 = xb + g1[bj][1] * acc[ai][bj][m][1];
                    uint4 wv; wv.x = pack2(v0[0], v0[1]); wv.y = pack2(v0[2], v0[3]); wv.z = pack2(v1[0], v1[1]); wv.w = pack2(v1[2], v1[3]);
                    *(uint4*)(x1 + ro + bj * 128) = wv; } }
    }
};
template <int PASS> struct EpiMerged8 {
    static constexpr bool PERM = true, AFTER_DRAIN = false;
    const bf16_t* G; bf16_t* MERGED;
    __device__ __forceinline__ void operator()(const pg8::f32x4 (&acc)[2][2][4][2], const pg8::Unit& u, int wr, int wc, int fr, int fq) const {
        const int row0 = u.pm * 256 + wr * 64 + fr, col0 = u.pn * 256 + wc * 32 + 8 * fq;
#pragma unroll
        for (int ai = 0; ai < 2; ++ai)
#pragma unroll
            for (int m = 0; m < 4; ++m) { const int row = row0 + ai * 128 + m * 16;
#pragma unroll
                for (int bj = 0; bj < 2; ++bj) { const int col = col0 + bj * 128;
                    const uint4 gg = *(const uint4*)(G + (size_t)row * 2048 + (PASS == 1 ? 1024 : 0) + col);
                    const unsigned gw[4] = {gg.x, gg.y, gg.z, gg.w};
                    pg8::f32x4 v0 = acc[ai][bj][m][0], v1 = acc[ai][bj][m][1];
                    float o[8];
#pragma unroll
                    for (int j = 0; j < 4; ++j) {
                        const float glo = __uint_as_float(gw[j] << 16), ghi = __uint_as_float(gw[j] & 0xffff0000u);
                        const float a0 = (j < 2) ? v0[2 * j] : v1[2 * (j - 2)], a1 = (j < 2) ? v0[2 * j + 1] : v1[2 * (j - 2) + 1];
                        o[2 * j] = glo * a0; o[2 * j + 1] = ghi * a1;
                    }
                    bf16_t* dst = MERGED + (size_t)row * 1024 + col;
                    if (PASS == 2) { const uint4 tt = *(const uint4*)dst; const unsigned tw[4] = {tt.x, tt.y, tt.z, tt.w};
#pragma unroll
                        for (int j = 0; j < 4; ++j) { o[2 * j] += __uint_as_float(tw[j] << 16); o[2 * j + 1] += __uint_as_float(tw[j] & 0xffff0000u); } }
                    uint4 wv; wv.x = pack2(o[0], o[1]); wv.y = pack2(o[2], o[3]); wv.z = pack2(o[4], o[5]); wv.w = pack2(o[6], o[7]);
                    *(uint4*)dst = wv; } }
    }
};
struct EpiPlain8 {
    static constexpr bool PERM = true, AFTER_DRAIN = false;
    bf16_t* O; int ld;
    __device__ __forceinline__ void operator()(const pg8::f32x4 (&acc)[2][2][4][2], const pg8::Unit& u, int wr, int wc, int fr, int fq) const {
        const int row0 = u.pm * 256 + wr * 64 + fr, col0 = u.pn * 256 + wc * 32 + 8 * fq;
#pragma unroll
        for (int ai = 0; ai < 2; ++ai)
#pragma unroll
            for (int m = 0; m < 4; ++m) { bf16_t* rowp = O + (size_t)(row0 + ai * 128 + m * 16) * ld + col0;
#pragma unroll
                for (int bj = 0; bj < 2; ++bj) { const pg8::f32x4 v0 = acc[ai][bj][m][0], v1 = acc[ai][bj][m][1];
                    uint4 wv; wv.x = pack2(v0[0], v0[1]); wv.y = pack2(v0[2], v0[3]); wv.z = pack2(v1[0], v1[1]); wv.w = pack2(v1[2], v1[3]);
                    *(uint4*)(rowp + bj * 128) = wv; } }
    }
};
__device__ __forceinline__ void wg_self_acquire() {
    asm volatile("s_waitcnt vmcnt(0)" ::: "memory");
    __syncthreads();
    if (threadIdx.x == 0) { __builtin_amdgcn_fence(__ATOMIC_ACQUIRE, "agent"); asm volatile("s_waitcnt vmcnt(0)" ::: "memory"); }
    __syncthreads();
}
__device__ __forceinline__ void phase_outproj8(const bf16_t* __restrict__ MERGED, const bf16_t* __restrict__ WTOUT, const float* __restrict__ x, const float* __restrict__ mod, bf16_t* x1, char* lds) {
    pg8::Gemm g{MERGED, WTOUT, NTOK, 1024, 1024};
    pg8::StaticOrder S; S.init(NTOK, 1024, (int)gridDim.x, (int)blockIdx.x);
    EpiOut8 E{x, mod, x1};
    pg8::gemm_phase<EpiOut8, pg8::StaticOrder>((PG8_LAS unsigned char*)lds, g, S, E, nullptr);
}
__device__ __forceinline__ void phase_merged8(const bf16_t* __restrict__ YA, const bf16_t* __restrict__ YB, const bf16_t* __restrict__ WTA, const bf16_t* __restrict__ WTB,
                                              const bf16_t* __restrict__ G, bf16_t* MERGED, char* lds) {
    pg8::StaticOrder S; S.init(NTOK, 1024, (int)gridDim.x, (int)blockIdx.x);
    { pg8::Gemm g{YB, WTB, NTOK, 1024, 512}; EpiMerged8<1> E{G, MERGED};
      pg8::gemm_phase<EpiMerged8<1>, pg8::StaticOrder>((PG8_LAS unsigned char*)lds, g, S, E, nullptr); }
    wg_self_acquire();
    { pg8::Gemm g{YA, WTA, NTOK, 1024, 512}; EpiMerged8<2> E{G, MERGED};
      pg8::gemm_phase<EpiMerged8<2>, pg8::StaticOrder>((PG8_LAS unsigned char*)lds, g, S, E, nullptr); }
}
__device__ __forceinline__ void phase_inproj8(const bf16_t* __restrict__ H, const bf16_t* __restrict__ WTIN, bf16_t* Q, bf16_t* Kb, bf16_t* V, bf16_t* U, bf16_t* SV, bf16_t* G, char* lds) {
    pg8::Gemm g{H, WTIN, NTOK, IN_COLS, 1024};
    pg8::StaticOrder S; S.init(NTOK, IN_COLS, (int)gridDim.x, (int)blockIdx.x);
    EpiInProj8 E{Q, Kb, V, U, SV, G};
    pg8::gemm_phase<EpiInProj8, pg8::StaticOrder>((PG8_LAS unsigned char*)lds, g, S, E, nullptr);
}


using f32x16 = __attribute__((ext_vector_type(16))) float;
typedef short v4i16_t __attribute__((ext_vector_type(4)));
#define ATT_TILE 16384
#define ATT_THR 6.0f
#define ATT_LDS_BYTES (4 * ATT_TILE)

__device__ __forceinline__ void att_dma(const bf16_t* __restrict__ Kb, const bf16_t* __restrict__ V, int b, int h, int kt, char* kl, char* vl, int lane, int w) {
    const int pc = lane & 15, rl = lane >> 4;
#pragma unroll
    for (int i = 0; i < 2; ++i) {
        const int n = w * 2 + i; const int row = 4 * n + rl;
        const size_t rowoff = ((size_t)(b * SEQ + kt * 64 + row)) * 512 + h * 128;
        __builtin_amdgcn_global_load_lds((const unsigned*)(Kb + rowoff + ((pc ^ (row & 15)) << 3)), (__attribute__((address_space(3))) unsigned*)(lds_ptr_t)(kl + n * 1024), 16, 0, 0);
        __builtin_amdgcn_global_load_lds((const unsigned*)(V + rowoff + ((pc ^ ((row & 3) << 2)) << 3)), (__attribute__((address_space(3))) unsigned*)(lds_ptr_t)(vl + n * 1024), 16, 0, 0);
    }
}
__device__ __forceinline__ void att_item(int b, int h, int cp, const bf16_t* __restrict__ Q, const bf16_t* __restrict__ Kb, const bf16_t* __restrict__ V,
                                         float lam, const float* __restrict__ head_g, bf16_t* __restrict__ YA, char* lds) {
    const int tid = threadIdx.x, lane = tid & 63;
    const int w = __builtin_amdgcn_readfirstlane(tid >> 6);
    const int i = w & 1, rq = w >> 1, r = lane & 31, hh = lane >> 5;
    const int tq = b * SEQ + cp * 128 + rq * 32 + r;
    bf16x8 qf[4];
#pragma unroll
    for (int s = 0; s < 4; ++s) qf[s] = *(const bf16x8*)(Q + (size_t)tq * 512 + h * 128 + i * 64 + 16 * s + 8 * hh);
    f32x16 O[4];
#pragma unroll
    for (int d = 0; d < 4; ++d)
#pragma unroll
        for (int e = 0; e < 16; ++e) O[d][e] = 0.f;
    float m = 0.f, l = 0.f;
    f32x16 negm;
#pragma unroll
    for (int e = 0; e < 16; ++e) negm[e] = 0.f;
    const int ntiles = 2 * cp + 2;
    const int ntiles_w = 2 * cp + (rq >> 1) + 1;
    int vb[4];
    { const int li = lane & 15, g = lane >> 4, q = li >> 2, x = 2 * (g & 1) + ((li & 3) >> 1);
#pragma unroll
      for (int d = 0; d < 4; ++d) vb[d] = (4 * hh + q) * 256 + ((((d ^ q) << 2) | x) << 4) + 8 * (li & 1); }
    att_dma(Kb, V, b, h, 0, lds, lds + ATT_TILE, lane, w);
    asm volatile("s_waitcnt vmcnt(0)" ::: "memory");
    __syncthreads();
    for (int kt = 0; kt < ntiles; ++kt) {
        const char* kl = lds + (kt & 1) * (2 * ATT_TILE); const char* vl = kl + ATT_TILE;
        if (kt + 1 < ntiles) { char* nl = lds + ((kt + 1) & 1) * (2 * ATT_TILE); att_dma(Kb, V, b, h, kt + 1, nl, nl + ATT_TILE, lane, w); }
        if (kt < ntiles_w) {
        f32x16 sacc[2];
        {
            bf16x8 kf[2][4];
#pragma unroll
            for (int k2 = 0; k2 < 2; ++k2)
#pragma unroll
                for (int s = 0; s < 4; ++s) {
                    const int krow = k2 * 32 + r; const int kch = i * 8 + 2 * s + hh;
                    kf[k2][s] = *(const bf16x8*)(kl + krow * 256 + ((kch ^ (krow & 15)) << 4));
                }
#pragma unroll
            for (int k2 = 0; k2 < 2; ++k2) {
                sacc[k2] = __builtin_amdgcn_mfma_f32_32x32x16_bf16(kf[k2][0], qf[0], negm, 0, 0, 0);
#pragma unroll
                for (int s = 1; s < 4; ++s) sacc[k2] = __builtin_amdgcn_mfma_f32_32x32x16_bf16(kf[k2][s], qf[s], sacc[k2], 0, 0, 0);
            }
        }
        float mx = sacc[0][0];
#pragma unroll
        for (int e = 1; e < 16; ++e) mx = fmaxf(mx, sacc[0][e]);
#pragma unroll
        for (int e = 0; e < 16; ++e) mx = fmaxf(mx, sacc[1][e]);
        if (kt == 0 || __any(mx > ATT_THR)) {
            mx = fmaxf(mx, __shfl_xor(mx, 32));
            const float dl = (kt == 0) ? mx : fmaxf(mx, 0.f);
            const float alpha = (kt == 0) ? 1.0f : __builtin_amdgcn_exp2f(-dl);
            m += dl; l *= alpha;
#pragma unroll
            for (int e = 0; e < 16; ++e) negm[e] = -m;
#pragma unroll
            for (int k2 = 0; k2 < 2; ++k2)
#pragma unroll
                for (int e = 0; e < 16; ++e) sacc[k2][e] -= dl;
#pragma unroll
            for (int d = 0; d < 4; ++d)
#pragma unroll
                for (int e = 0; e < 16; ++e) O[d][e] *= alpha;
        }
        float ls = 0.f;
#pragma unroll
        for (int k2 = 0; k2 < 2; ++k2)
#pragma unroll
            for (int e = 0; e < 16; ++e) { const float p = __builtin_amdgcn_exp2f(sacc[k2][e]); sacc[k2][e] = p; ls += p; }
        l += ls;
        bf16x8 pf[2][2];
#pragma unroll
        for (int k2 = 0; k2 < 2; ++k2)
#pragma unroll
            for (int s2 = 0; s2 < 2; ++s2) {
                union { uint4 u; bf16x8 v; } cp;
                cp.u = make_uint4(pack2(sacc[k2][8 * s2 + 0], sacc[k2][8 * s2 + 1]), pack2(sacc[k2][8 * s2 + 2], sacc[k2][8 * s2 + 3]),
                                  pack2(sacc[k2][8 * s2 + 4], sacc[k2][8 * s2 + 5]), pack2(sacc[k2][8 * s2 + 6], sacc[k2][8 * s2 + 7]));
                pf[k2][s2] = cp.v;
            }
#define ATT_VREAD(dst, st) { const lds_ptr_t vp_ = (lds_ptr_t)(vl + vb[(st) >> 2]); const int kb_ = (((st) >> 1) & 1) * 32 + ((st) & 1) * 16; \
            const v4i16_t lo_ = __builtin_amdgcn_ds_read_tr16_b64_v4i16((__attribute__((address_space(3))) v4i16_t*)(vp_ + kb_ * 256)); \
            const v4i16_t hi_ = __builtin_amdgcn_ds_read_tr16_b64_v4i16((__attribute__((address_space(3))) v4i16_t*)(vp_ + kb_ * 256 + 2048)); \
            dst = (bf16x8){lo_[0], lo_[1], lo_[2], lo_[3], hi_[0], hi_[1], hi_[2], hi_[3]}; }
        {
            bf16x8 vcur, vnxt;
            ATT_VREAD(vcur, 0)
#pragma unroll
            for (int st = 0; st < 16; ++st) {
                if (st + 1 < 16) ATT_VREAD(vnxt, st + 1)
                O[st >> 2] = __builtin_amdgcn_mfma_f32_32x32x16_bf16(vcur, pf[(st >> 1) & 1][st & 1], O[st >> 2], 0, 0, 0);
                vcur = vnxt;
            }
        }
        }
        asm volatile("s_waitcnt vmcnt(0)" ::: "memory");
        __syncthreads();
    }
    const float ltot = l + __shfl_xor(l, 32);
    const float inv = 1.0f / ltot;
    float* ex = (float*)lds;
    if (i == 1) {
        const float sc = inv * lam;
#pragma unroll
        for (int d = 0; d < 4; ++d)
#pragma unroll
            for (int e = 0; e < 16; ++e) { const int dv = d * 32 + (e & 3) + 8 * (e >> 2) + 4 * hh; ex[(rq * 128 + dv) * 32 + r] = O[d][e] * sc; }
    }
    __syncthreads();
    if (i == 0) {
        float ss = 0.f;
#pragma unroll
        for (int d = 0; d < 4; ++d)
#pragma unroll
            for (int e = 0; e < 16; ++e) { const int dv = d * 32 + (e & 3) + 8 * (e >> 2) + 4 * hh; const float o = O[d][e] * inv - ex[(rq * 128 + dv) * 32 + r]; O[d][e] = o; ss += o * o; }
        ss += __shfl_xor(ss, 32);
        const float rn = rsqrtf(ss * (1.0f / 128.0f) + EPS) * 0.8f;
#pragma unroll
        for (int d = 0; d < 4; ++d)
#pragma unroll
            for (int g = 0; g < 4; ++g) {
                const int dv = d * 32 + 8 * g + 4 * hh;
                const float4 hg = *(const float4*)(head_g + dv);
                *(uint2*)(YA + (size_t)tq * 512 + h * 128 + dv) = pack4(O[d][4 * g] * rn * hg.x, O[d][4 * g + 1] * rn * hg.y, O[d][4 * g + 2] * rn * hg.z, O[d][4 * g + 3] * rn * hg.w);
            }
    }
    __syncthreads();
}
__device__ __forceinline__ void phase_attn(const bf16_t* __restrict__ Q, const bf16_t* __restrict__ Kb, const bf16_t* __restrict__ V, const float* __restrict__ ctl,
                           const float* __restrict__ head_g, bf16_t* __restrict__ YA, char* lds) {
    const float lam = ctl[0];
    const int G = gridDim.x, bid = blockIdx.x;
    if (G == 256) {
        const int x = bid & 7, slot = bid >> 3; const int ph = x + 8 * (slot & 1); const int s = slot >> 1;
#pragma unroll 1
        for (int it = 0; it < 4; ++it) {
            const int cp = (it == 0) ? 63 - s : (it == 1) ? 32 + s : (it == 2) ? 31 - s : s;
            att_item(ph >> 2, ph & 3, cp, Q, Kb, V, lam, head_g, YA, lds);
        }
    } else {
#pragma unroll 1
        for (int it = 0;; ++it) {
            const int rho = (it & 1) ? it * G + (G - 1 - bid) : it * G + bid;
            if (rho >= 1024) { if (it * G >= 1024) break; else continue; }
            const int cp = 63 - (rho >> 4); const int ph = rho & 15;
            att_item(ph >> 2, ph & 3, cp, Q, Kb, V, lam, head_g, YA, lds);
        }
    }
}


#define SGU_LDS_BYTES (65536 + 1024)
__device__ __forceinline__ void phase_sgu(const bf16_t* __restrict__ U, const bf16_t* __restrict__ SV, const float* __restrict__ ln_g, const float* __restrict__ ln_b,
                          const float* __restrict__ sg_w, const float* __restrict__ sg_b, bf16_t* __restrict__ YB, char* lds) {
    const int tid = threadIdx.x, lane = tid & 63, w = tid >> 6, wm = w >> 1  , wn = w & 1  , lr = lane & 15, lq = lane >> 4;
    float* st_mu = (float*)(lds + 65536); float* st_rs = st_mu + 128;
    char* Wl = lds; char* Sl = lds + 32768;
    for (int nb = blockIdx.x; nb < NTOK / 128; nb += gridDim.x) {
        const int t0 = nb * 128;
        for (int r0 = 0; r0 < 16; r0 += 8) {
            uint4 v8[8];
#pragma unroll
            for (int u = 0; u < 8; ++u) v8[u] = *(const uint4*)(SV + (size_t)(t0 + w * 16 + r0 + u) * 512 + lane * 8);
#pragma unroll
            for (int u = 0; u < 8; ++u) {
                const int row = w * 16 + r0 + u; const uint4 v = v8[u];
                float f[8] = {__uint_as_float(v.x << 16), __uint_as_float(v.x & 0xffff0000u), __uint_as_float(v.y << 16), __uint_as_float(v.y & 0xffff0000u),
                              __uint_as_float(v.z << 16), __uint_as_float(v.z & 0xffff0000u), __uint_as_float(v.w << 16), __uint_as_float(v.w & 0xffff0000u)};
                float s = 0.f;
#pragma unroll
                for (int j = 0; j < 8; ++j) s += f[j];
                for (int o = 32; o > 0; o >>= 1) s += __shfl_xor(s, o);
                const float mu = s * (1.0f / 512.0f);
                float q = 0.f;
#pragma unroll
                for (int j = 0; j < 8; ++j) { const float d = f[j] - mu; q += d * d; }
                for (int o = 32; o > 0; o >>= 1) q += __shfl_xor(q, o);
                if (lane == 0) { st_mu[row] = mu; st_rs[row] = rsqrtf(q * (1.0f / 512.0f) + EPS); }
            }
        }
#pragma unroll 1
        for (int g = 0; g < 4; ++g) {
        { const int c16 = tid & 15, r0 = tid >> 4;
#pragma unroll
          for (int i = 0; i < 4; ++i) {
              const int p = r0 + 32 * i;
              const float* wp = sg_w + ((size_t)g * 128 + p) * 128 + c16 * 8;
              float4 a = *(const float4*)wp, b = *(const float4*)(wp + 4);
              if (p < 64 && c16 >= 8) { a = make_float4(0.f, 0.f, 0.f, 0.f); b = a; }
              *(uint4*)(Wl + p * 256 + ((c16 ^ (p & 15)) << 4)) = make_uint4(pack2(a.x, a.y), pack2(a.z, a.w), pack2(b.x, b.y), pack2(b.z, b.w));
          } }
        __syncthreads();
        { const int pr = tid & 63;
#pragma unroll
          for (int it = 0; it < 2; ++it) {
              const int ch = (tid >> 6) + 8 * it;
              const int q0 = 2 * pr;
              const uint4 va = *(const uint4*)(SV + (size_t)(t0 + q0) * 512 + g * 128 + ch * 8);
              const uint4 vb = *(const uint4*)(SV + (size_t)(t0 + q0 + 1) * 512 + g * 128 + ch * 8);
              const float mua = st_mu[q0], rsa = st_rs[q0], mub = st_mu[q0 + 1], rsb = st_rs[q0 + 1];
              const unsigned ua[4] = {va.x, va.y, va.z, va.w}, ub[4] = {vb.x, vb.y, vb.z, vb.w};
#pragma unroll
              for (int e = 0; e < 8; ++e) {
                  const int c = ch * 8 + e;
                  const float lg = ln_g[g * 128 + c], lb = ln_b[g * 128 + c];
                  const float xa = (e & 1) ? __uint_as_float(ua[e >> 1] & 0xffff0000u) : __uint_as_float(ua[e >> 1] << 16);
                  const float xb = (e & 1) ? __uint_as_float(ub[e >> 1] & 0xffff0000u) : __uint_as_float(ub[e >> 1] << 16);
                  const float na = (xa - mua) * rsa * lg + lb, nb2 = (xb - mub) * rsb * lg + lb;
                  *(unsigned*)(Sl + c * 256 + (((q0 >> 3) ^ (c & 15)) << 4) + (q0 & 7) * 2) = pack2(na, nb2);
              }
          } }
        __syncthreads();
        f32x4 acc[2][4];
#pragma unroll
        for (int i = 0; i < 2; ++i)
#pragma unroll
            for (int j = 0; j < 4; ++j) acc[i][j] = f32x4{0.f, 0.f, 0.f, 0.f};
        const int nks = (wm < 2) ? 2 : 4;
        for (int ks = 0; ks < nks; ++ks) {
            const int sw = (((ks * 4 + lq) ^ lr) << 4);
            bf16x8 a[2], b[4];
#pragma unroll
            for (int i = 0; i < 2; ++i) a[i] = *(const bf16x8*)(Wl + (wm * 32 + i * 16 + lr) * 256 + sw);
#pragma unroll
            for (int j = 0; j < 4; ++j) b[j] = *(const bf16x8*)(Sl + (wn * 64 + j * 16 + lr) * 256 + sw);
#pragma unroll
            for (int i = 0; i < 2; ++i)
#pragma unroll
                for (int j = 0; j < 4; ++j) acc[i][j] = __builtin_amdgcn_mfma_f32_16x16x32_bf16(b[j], a[i], acc[i][j], 0, 0, 0);
        }
#pragma unroll
        for (int i = 0; i < 2; ++i)
#pragma unroll
            for (int j = 0; j < 4; ++j) {
                const int p = wm * 32 + i * 16 + lr; const int c = wn * 64 + j * 16 + lq * 4;
                const float bias = sg_b[g * 128 + p];
                const size_t o = (size_t)(t0 + p) * 512 + g * 128 + c;
                const uint2 uu = *(const uint2*)(U + o);
                *(uint2*)(YB + o) = pack4(__uint_as_float(uu.x << 16) * (acc[i][j][0] + bias), __uint_as_float(uu.x & 0xffff0000u) * (acc[i][j][1] + bias),
                                          __uint_as_float(uu.y << 16) * (acc[i][j][2] + bias), __uint_as_float(uu.y & 0xffff0000u) * (acc[i][j][3] + bias));
            }
        __syncthreads();
        }
    }
}

#define CE_DESC(a, b) { const unsigned t_ = (a) > (b) ? (a) : (b); b = (a) > (b) ? (b) : (a); a = t_; }
__device__ __forceinline__ unsigned f2key(float f) { const unsigned u = __float_as_uint(f); return (u & 0x80000000u) ? ~u : (u | 0x80000000u); }
__device__ __forceinline__ float key2f(unsigned k) { const unsigned u = (k & 0x80000000u) ? (k & 0x7fffffffu) : ~k; return __uint_as_float(u); }
template <int N> __device__ __forceinline__ void bitonic_sort_desc(unsigned (&a)[N]) {
#pragma unroll
    for (int k = 2; k <= N; k <<= 1)
#pragma unroll
        for (int j = k >> 1; j > 0; j >>= 1)
#pragma unroll
            for (int i = 0; i < N; ++i) {
                const int l = i ^ j;
                if (l > i) { if ((i & k) == 0) { CE_DESC(a[i], a[l]) } else { CE_DESC(a[l], a[i]) } }
            }
}
template <int N> __device__ __forceinline__ void bitonic_merge_desc(unsigned (&a)[N]) {
#pragma unroll
    for (int j = N >> 1; j > 0; j >>= 1)
#pragma unroll
        for (int i = 0; i < N; ++i) { const int l = i ^ j; if (l > i) { CE_DESC(a[i], a[l]) } }
}
__device__ __forceinline__ void merge_top16(unsigned (&a)[16], const unsigned (&b)[16]) {
#pragma unroll
    for (int i = 0; i < 16; ++i) a[i] = a[i] > b[15 - i] ? a[i] : b[15 - i];
    bitonic_merge_desc<16>(a);
}
__device__ __forceinline__ void xlane_merge_top16(unsigned (&a)[16], int xmask) {
    unsigned b[16];
#pragma unroll
    for (int i = 0; i < 16; ++i) b[i] = (unsigned)__shfl_xor((int)a[i], xmask);
    merge_top16(a, b);
}
__device__ __forceinline__ void phase_peer_select8(const bf16_t* __restrict__ H2, const bf16_t* __restrict__ WTQ, const bf16_t* __restrict__ SUBK, bf16_t* QP,
                                   int* __restrict__ EIDX, float* __restrict__ GW, char* lds) {
    const int tid = threadIdx.x, lane = tid & 63, w = tid >> 6, wm = w >> 1, wn = w & 1, lr = lane & 15, lq = lane >> 4;
    pg8::StaticOrder S; S.init(NTOK, 2048, (int)gridDim.x, (int)blockIdx.x);
    { pg8::Gemm g{H2, WTQ, NTOK, 2048, 1024}; EpiPlain8 E{QP, 2048};
      pg8::gemm_phase<EpiPlain8, pg8::StaticOrder>((PG8_LAS unsigned char*)lds, g, S, E, nullptr); }
    wg_self_acquire();
    const int wu = __builtin_amdgcn_readfirstlane(w);
#define SEL_DMA(m0_, h_, p_) { const int pc = lane & 15, rl = lane >> 4; \
            _Pragma("unroll") for (int j = 0; j < 8; ++j) { const int n = wu * 8 + j; const int row = 4 * n + rl; \
                __builtin_amdgcn_global_load_lds((const unsigned*)(QP + (size_t)((m0_) + row) * 2048 + (h_) * 256 + (p_) * 128 + ((pc ^ (row & 15)) << 3)), \
                                                 (__attribute__((address_space(3))) unsigned*)(lds_ptr_t)(lds + n * 1024), 16, 0, 0); } \
            _Pragma("unroll") for (int j = 0; j < 4; ++j) { const int n = wu * 4 + j; const int row = 4 * n + rl; \
                __builtin_amdgcn_global_load_lds((const unsigned*)(SUBK + ((size_t)((h_) * 2 + (p_)) * 128 + row) * 128 + ((pc ^ (row & 15)) << 3)), \
                                                 (__attribute__((address_space(3))) unsigned*)(lds_ptr_t)(lds + 65536 + n * 1024), 16, 0, 0); } }
    pg8::Unit un, nxu; bool have = S.next(0, un);
    if (have) SEL_DMA(un.pm * 256, un.pn, 0)
    for (int ui = 0; have; ++ui) {
        const bool have_next = S.next(ui + 1, nxu);
        const int h = un.pn; const int m0 = un.pm * 256;
        unsigned* Ll = (unsigned*)(lds + 98304);
#pragma unroll 1
        for (int p = 0; p < 2; ++p) {
            asm volatile("s_waitcnt vmcnt(0)" ::: "memory");
            __syncthreads();
            f32x4 sc[2][8];
#pragma unroll
            for (int tt = 0; tt < 2; ++tt)
#pragma unroll
                for (int kt = 0; kt < 8; ++kt) sc[tt][kt] = f32x4{0.f, 0.f, 0.f, 0.f};
#pragma unroll
            for (int ks = 0; ks < 4; ++ks) {
                const int sw = (((ks * 4 + lq) ^ lr) << 4);
                bf16x8 qb[2], ka[8];
#pragma unroll
                for (int tt = 0; tt < 2; ++tt) qb[tt] = *(const bf16x8*)(lds + (w * 32 + tt * 16 + lr) * 256 + sw);
#pragma unroll
                for (int kt = 0; kt < 8; ++kt) ka[kt] = *(const bf16x8*)(lds + 65536 + (kt * 16 + lr) * 256 + sw);
#pragma unroll
                for (int tt = 0; tt < 2; ++tt)
#pragma unroll
                    for (int kt = 0; kt < 8; ++kt) sc[tt][kt] = __builtin_amdgcn_mfma_f32_16x16x32_bf16(ka[kt], qb[tt], sc[tt][kt], 0, 0, 0);
            }
            __syncthreads();
            if (p == 0) SEL_DMA(m0, h, 1) else if (have_next) SEL_DMA(nxu.pm * 256, nxu.pn, 0)
#pragma unroll
            for (int tt = 0; tt < 2; ++tt) {
                __builtin_amdgcn_sched_barrier(0);
                unsigned lo[16], hi[16];
#pragma unroll
                for (int kt = 0; kt < 4; ++kt)
#pragma unroll
                    for (int r = 0; r < 4; ++r) {
                        lo[kt * 4 + r] = (f2key(sc[tt][kt][r]) & ~0x7Fu) | (unsigned)(127 - (kt * 16 + lq * 4 + r));
                        hi[kt * 4 + r] = (f2key(sc[tt][kt + 4][r]) & ~0x7Fu) | (unsigned)(127 - ((kt + 4) * 16 + lq * 4 + r));
                    }
                bitonic_sort_desc<16>(lo); bitonic_sort_desc<16>(hi);
                merge_top16(lo, hi);
                xlane_merge_top16(lo, 16); xlane_merge_top16(lo, 32);
                if (lq == 0) {
                    uint4* dst = (uint4*)(Ll + (w * 32 + tt * 16 + lr) * 32 + p * 16);
                    dst[0] = make_uint4(lo[0], lo[1], lo[2], lo[3]); dst[1] = make_uint4(lo[4], lo[5], lo[6], lo[7]);
                    dst[2] = make_uint4(lo[8], lo[9], lo[10], lo[11]); dst[3] = make_uint4(lo[12], lo[13], lo[14], lo[15]);
                }
            }
        }
        __syncthreads();
#pragma unroll
        for (int tt = 0; tt < 2; ++tt) {
            __builtin_amdgcn_sched_barrier(0);
            const int tokl = w * 32 + tt * 16 + lr;
            float v0[16], v1[16];
            { const uint4* sp = (const uint4*)(Ll + tokl * 32);
#pragma unroll
              for (int q = 0; q < 4; ++q) {
                  const uint4 a = sp[q], b = sp[4 + q];
                  v0[q * 4] = key2f(a.x & ~0x7Fu); v0[q * 4 + 1] = key2f(a.y & ~0x7Fu); v0[q * 4 + 2] = key2f(a.z & ~0x7Fu); v0[q * 4 + 3] = key2f(a.w & ~0x7Fu);
                  v1[q * 4] = key2f(b.x & ~0x7Fu); v1[q * 4 + 1] = key2f(b.y & ~0x7Fu); v1[q * 4 + 2] = key2f(b.z & ~0x7Fu); v1[q * 4 + 3] = key2f(b.w & ~0x7Fu);
              } }
            unsigned c2[16];
#pragma unroll
            for (int r = 0; r < 16; ++r) c2[r] = 0u;
#define CAND(slot, a, b) c2[slot] = (f2key(v0[a] + v1[b]) & ~0xFFu) | (unsigned)(255 - ((a) * 16 + (b)))
            if (lq == 0) {
                CAND(0, 0, 0); CAND(1, 0, 1); CAND(2, 0, 2); CAND(3, 0, 3); CAND(4, 0, 4); CAND(5, 0, 5); CAND(6, 0, 6); CAND(7, 0, 7);
                CAND(8, 0, 8); CAND(9, 0, 9); CAND(10, 0, 10); CAND(11, 0, 11); CAND(12, 0, 12); CAND(13, 0, 13); CAND(14, 0, 14); CAND(15, 0, 15);
            } else if (lq == 1) {
                CAND(0, 8, 0); CAND(1, 9, 0); CAND(2, 10, 0); CAND(3, 11, 0); CAND(4, 12, 0); CAND(5, 13, 0); CAND(6, 14, 0); CAND(7, 15, 0);
                CAND(8, 1, 0); CAND(9, 1, 1); CAND(10, 1, 2); CAND(11, 1, 3); CAND(12, 1, 4); CAND(13, 1, 5); CAND(14, 1, 6); CAND(15, 1, 7);
            } else if (lq == 2) {
                CAND(0, 2, 0); CAND(1, 2, 1); CAND(2, 2, 2); CAND(3, 2, 3); CAND(4, 2, 4); CAND(5, 3, 0); CAND(6, 3, 1); CAND(7, 3, 2);
                CAND(8, 3, 3); CAND(9, 4, 0); CAND(10, 4, 1); CAND(11, 4, 2); CAND(12, 5, 0); CAND(13, 5, 1);
            } else {
                CAND(0, 6, 0); CAND(1, 6, 1); CAND(2, 7, 0); CAND(3, 7, 1);
            }
#undef CAND
            bitonic_sort_desc<16>(c2);
            xlane_merge_top16(c2, 16); xlane_merge_top16(c2, 32);
            if (lq == 0) {
                float s[16]; int ei[16];
#pragma unroll
                for (int r = 0; r < 16; ++r) {
                    const unsigned code = 255u - (c2[r] & 0xFFu);
                    const unsigned k0 = Ll[tokl * 32 + (code >> 4)], k1 = Ll[tokl * 32 + 16 + (code & 15u)];
                    s[r] = key2f(k0 & ~0x7Fu) + key2f(k1 & ~0x7Fu);
                    ei[r] = (int)((127u - (k0 & 0x7Fu)) * 128u + (127u - (k1 & 0x7Fu)));
                }
                float mx = s[0];
#pragma unroll
                for (int r = 1; r < 16; ++r) mx = fmaxf(mx, s[r]);
                float sum = 0.f;
#pragma unroll
                for (int r = 0; r < 16; ++r) { s[r] = __expf(s[r] - mx); sum += s[r]; }
                const float inv = 1.0f / sum;
                const size_t o = ((size_t)(m0 + tokl) * 8 + h) * 16;
#pragma unroll
                for (int r = 0; r < 16; r += 4) {
                    *(int4*)(EIDX + o + r) = make_int4(ei[r], ei[r + 1], ei[r + 2], ei[r + 3]);
                    *(float4*)(GW + o + r) = make_float4(s[r] * inv, s[r + 1] * inv, s[r + 2] * inv, s[r + 3] * inv);
                }
            }
        }
        __syncthreads();
        un = nxu; have = have_next;
    }
#undef SEL_DMA
}

#define DPP_ADD(r, ctrl) r += __builtin_bit_cast(float, __builtin_amdgcn_update_dpp(0, __builtin_bit_cast(int, r), ctrl, 0xf, 0xf, false))
__device__ __forceinline__ float dot8(const uint4& a, const uint4& b, float acc) {
    acc = __builtin_amdgcn_fdot2_f32_bf16(__builtin_bit_cast(bf16v2_t, a.x), __builtin_bit_cast(bf16v2_t, b.x), acc, false);
    acc = __builtin_amdgcn_fdot2_f32_bf16(__builtin_bit_cast(bf16v2_t, a.y), __builtin_bit_cast(bf16v2_t, b.y), acc, false);
    acc = __builtin_amdgcn_fdot2_f32_bf16(__builtin_bit_cast(bf16v2_t, a.z), __builtin_bit_cast(bf16v2_t, b.z), acc, false);
    acc = __builtin_amdgcn_fdot2_f32_bf16(__builtin_bit_cast(bf16v2_t, a.w), __builtin_bit_cast(bf16v2_t, b.w), acc, false);
    return acc;
}
typedef int v8i_t __attribute__((ext_vector_type(8)));
typedef int v2i_t __attribute__((ext_vector_type(2)));
#define PE_STAGE 16384
#define PE_WAVE_LDS (PE_STAGE + 1024)
__device__ __forceinline__ void phase_peer_expert(const unsigned char* __restrict__ HQ8, const float* __restrict__ HSC, const int* __restrict__ EIDX, const float* __restrict__ GW,
                                  const unsigned char* __restrict__ DOWN4, const unsigned char* __restrict__ UP4, const float* __restrict__ DSC, const float* __restrict__ USC,
                                  unsigned char* W8, const float* __restrict__ mod, const float* __restrict__ final_g, const bf16_t* __restrict__ x1src, bf16_t* X2, float* out, char* lds) {
    const int tid = threadIdx.x, lane = tid & 63, w = __builtin_amdgcn_readfirstlane(tid >> 6);
    const int n = lane & 15, g = lane >> 4, r8 = lane >> 3, cp8 = lane & 7;
    char* stage = lds + w * PE_WAVE_LDS; float* outbuf = (float*)(stage + PE_STAGE);
    const int nwaves = gridDim.x * NW;
    const int tpw = (NTOK + nwaves - 1) / nwaves;
    const int t_begin = (blockIdx.x * NW + w) * tpw;
    const int fn = (n >> 1) & 7;
#define PE_GATHER_HALF(TABLE, s_, ep_, hf_) { asm volatile("s_waitcnt lgkmcnt(0)" ::: "memory"); \
        _Pragma("unroll") for (int q = 8 * (hf_); q < 8 * (hf_) + 8; ++q) { \
            const int pk_ = __shfl((ep_), 8 * (q & 7) + r8); const int e_ = (q < 8) ? (pk_ & 0xFFFF) : (int)((unsigned)pk_ >> 16); \
            const int fj_ = (4 * (q & 1) + (r8 >> 1)) & 7; \
            __builtin_amdgcn_global_load_lds((const unsigned*)((TABLE) + (size_t)(s_) * (16384 * 128) + (size_t)e_ * 128 + ((cp8 ^ fj_) << 4)), \
                                             (__attribute__((address_space(3))) unsigned*)(lds_ptr_t)(stage + q * 1024), 16, 0, 0); } }
#define PE_GATHER(TABLE, s_, ep_) { PE_GATHER_HALF(TABLE, s_, ep_, 0) PE_GATHER_HALF(TABLE, s_, ep_, 1) }
#define PE_WAITV(n_) asm volatile("s_waitcnt vmcnt(" #n_ ")" ::: "memory")
    char* hbuf = (char*)outbuf;
#define PE_HDMA(t_, s_, par_) { if (lane < 16) __builtin_amdgcn_global_load_lds((const unsigned*)(HQ8 + (size_t)(t_) * 1024 + (s_) * 256 + lane * 16), \
                                             (__attribute__((address_space(3))) unsigned*)(lds_ptr_t)(hbuf + (par_) * 256), 16, 0, 0); }
    for (int base = 0; base < tpw; base += 16) {
        const int t0 = t_begin + base;
        int nt = tpw - base; if (nt > 16) nt = 16; if (t0 + nt > NTOK) nt = NTOK - t0; if (nt < 0) nt = 0;
        int eid[16];
#pragma unroll
        for (int i = 0; i < 16; ++i) { const int tc = (t0 + i < NTOK) ? t0 + i : NTOK - 1; eid[i] = EIDX[(size_t)tc * 128 + lane] | (EIDX[(size_t)tc * 128 + 64 + lane] << 16); }
        f32x4 P[16];
#pragma unroll
        for (int i = 0; i < 16; ++i) P[i] = f32x4{0.f, 0.f, 0.f, 0.f};
#define PE_DOWN_EG(eg_) { const char* rowp = stage + (16 * (eg_) + n) * 128; \
            const uint4 a0 = *(const uint4*)(rowp + ((g ^ fn) << 4)), a1 = *(const uint4*)(rowp + (((4 + g) ^ fn) << 4)); \
            const v8i_t av0 = {(int)a0.x, (int)a0.y, (int)a0.z, (int)a0.w, 0, 0, 0, 0}, av1 = {(int)a1.x, (int)a1.y, (int)a1.z, (int)a1.w, 0, 0, 0, 0}; \
            f32x4 acc = {0.f, 0.f, 0.f, 0.f}; \
            acc = __builtin_amdgcn_mfma_scale_f32_16x16x128_f8f6f4(av0, b0, acc, 4, 0, 0, 0x7F7F7F7F, 0, 0x7F7F7F7F); \
            acc = __builtin_amdgcn_mfma_scale_f32_16x16x128_f8f6f4(av1, b1, acc, 4, 0, 0, 0x7F7F7F7F, 0, 0x7F7F7F7F); \
            if (n == (eg_)) P[i] += acc; }
        int ntq = 16; asm volatile("" : "+s"(ntq));
        { const int tq = (t0 < NTOK) ? t0 : NTOK - 1; PE_HDMA(tq, 0, 0) PE_GATHER_HALF(DOWN4, 0, eid[0], 0) PE_GATHER_HALF(DOWN4, 0, eid[0], 1) }
#pragma unroll 1
        for (int s = 0; s < 4; ++s) {
#pragma unroll
            for (int i = 0; i < 16; ++i) if (i < ntq) {
                const bool has_next = (i < 15) || (s < 3);
                const int sn = (i < 15) ? s : s + 1, in = (i + 1) & 15;
                int epn = eid[in]; asm volatile("" : "+v"(epn));
                PE_WAITV(8);
                const char* hb = hbuf + (i & 1) * 256 + 16 * g;
                const uint4 h00 = *(const uint4*)(hb), h01 = *(const uint4*)(hb + 64), h10 = *(const uint4*)(hb + 128), h11 = *(const uint4*)(hb + 192);
                const v8i_t b0 = {(int)h00.x, (int)h00.y, (int)h00.z, (int)h00.w, (int)h01.x, (int)h01.y, (int)h01.z, (int)h01.w};
                const v8i_t b1 = {(int)h10.x, (int)h10.y, (int)h10.z, (int)h10.w, (int)h11.x, (int)h11.y, (int)h11.z, (int)h11.w};
#pragma unroll
                for (int eg = 0; eg < 4; ++eg) PE_DOWN_EG(eg)
                if (has_next) { int tq = (t0 + in < NTOK) ? t0 + in : NTOK - 1; asm volatile("" : "+v"(tq));
                                asm volatile("s_waitcnt lgkmcnt(0)" ::: "memory"); PE_HDMA(tq, sn, (i + 1) & 1) PE_GATHER_HALF(DOWN4, sn, epn, 0) PE_WAITV(9); }
                else PE_WAITV(0);
#pragma unroll
                for (int eg = 4; eg < 8; ++eg) PE_DOWN_EG(eg)
                if (has_next) PE_GATHER_HALF(DOWN4, sn, epn, 1)
            }
        }
#undef PE_DOWN_EG
#pragma unroll
        for (int i4 = 0; i4 < 16; i4 += 4) {
            const int j0 = 16 * (n & 7) + 4 * g;
            int4 e4[4]; float4 gw4[4]; float hs[4]; float dsc[4][4], usc[4][4];
#pragma unroll
            for (int u = 0; u < 4; ++u) { const int t = (i4 + u < nt) ? t0 + i4 + u : t0;
                e4[u] = *(const int4*)(EIDX + (size_t)t * 128 + j0); gw4[u] = *(const float4*)(GW + (size_t)t * 128 + j0); hs[u] = HSC[t]; }
#pragma unroll
            for (int u = 0; u < 4; ++u) { const int ee[4] = {e4[u].x, e4[u].y, e4[u].z, e4[u].w};
#pragma unroll
                for (int r = 0; r < 4; ++r) { dsc[u][r] = DSC[ee[r]]; usc[u][r] = USC[ee[r]]; } }
#pragma unroll
            for (int u = 0; u < 4; ++u) {
                const float gg[4] = {gw4[u].x, gw4[u].y, gw4[u].z, gw4[u].w};
                float wv[4];
#pragma unroll
                for (int r = 0; r < 4; ++r) { const float a = P[i4 + u][r] * hs[u] * dsc[u][r]; wv[r] = fminf(fmaxf(gg[r] * gelu_tanh(a) * usc[u][r] * 64.0f, -448.0f), 448.0f); }
                int ph = 0, pl = 0;
                ph = __builtin_amdgcn_cvt_pk_fp8_f32(wv[0], wv[1], ph, false); ph = __builtin_amdgcn_cvt_pk_fp8_f32(wv[2], wv[3], ph, true);
                const f32x2_t d01 = __builtin_amdgcn_cvt_pk_f32_fp8(ph, false), d23 = __builtin_amdgcn_cvt_pk_f32_fp8(ph, true);
                pl = __builtin_amdgcn_cvt_pk_fp8_f32(wv[0] - d01[0], wv[1] - d01[1], pl, false); pl = __builtin_amdgcn_cvt_pk_fp8_f32(wv[2] - d23[0], wv[3] - d23[1], pl, true);
                if (n < 8 && i4 + u < nt) { const size_t o = (size_t)(t0 + i4 + u) * 256 + j0; *(int*)(W8 + o) = ph; *(int*)(W8 + o + 128) = pl; }
            }
        }
        asm volatile("s_waitcnt vmcnt(0)" ::: "memory");
        float ssq[16];
#pragma unroll
        for (int i = 0; i < 16; ++i) ssq[i] = 0.f;
#pragma unroll 1
        for (int s = 0; s < 4; ++s) {
#pragma unroll
            for (int i = 0; i < 16; ++i) if (i < nt) {
                int t = t0 + i; asm volatile("" : "+v"(t));
                const int b = t / SEQ, c0 = s * 256 + 4 * lane;
                const uint2 xb2 = *(const uint2*)(x1src + (size_t)t * 1024 + c0); const float4 g2 = *(const float4*)(mod + b * 6144 + 5120 + c0);
                const float4 xv = make_float4(__uint_as_float(xb2.x << 16), __uint_as_float(xb2.x & 0xffff0000u), __uint_as_float(xb2.y << 16), __uint_as_float(xb2.y & 0xffff0000u));
                uint4 w0 = make_uint4(0u, 0u, 0u, 0u), w1 = w0;
                if (n < 2) { const unsigned char* wp = W8 + (size_t)t * 256 + n * 128 + 16 * g; w0 = *(const uint4*)wp; w1 = *(const uint4*)(wp + 64); }
                int epu = eid[i]; asm volatile("" : "+v"(epu));
                PE_GATHER(UP4, s, epu)
                const v8i_t av = {(int)w0.x, (int)w0.y, (int)w0.z, (int)w0.w, (int)w1.x, (int)w1.y, (int)w1.z, (int)w1.w};
                asm volatile("s_waitcnt vmcnt(0)" ::: "memory");
#pragma unroll
                for (int ch = 0; ch < 2; ++ch) {
                    v2i_t q0[8], q1[8];
#pragma unroll
                    for (int c8 = 0; c8 < 8; ++c8) { const int cg = ch * 8 + c8; const int off = ((((cg >> 1) ^ fn)) << 4) + (cg & 1) * 8;
                        q0[c8] = __builtin_amdgcn_ds_read_tr4_b64_v2i32((__attribute__((address_space(3))) v2i_t*)(lds_ptr_t)(stage + (32 * g + n) * 128 + off));
                        q1[c8] = __builtin_amdgcn_ds_read_tr4_b64_v2i32((__attribute__((address_space(3))) v2i_t*)(lds_ptr_t)(stage + (32 * g + 16 + n) * 128 + off)); }
                    float o8[8];
#pragma unroll
                    for (int c8 = 0; c8 < 8; ++c8) {
                        const v8i_t bv = {q0[c8][0], q0[c8][1], q1[c8][0], q1[c8][1], 0, 0, 0, 0};
                        f32x4 acc = {0.f, 0.f, 0.f, 0.f};
                        acc = __builtin_amdgcn_mfma_scale_f32_16x16x128_f8f6f4(av, bv, acc, 0, 4, 0, 0x7F7F7F7F, 0, 0x7F7F7F7F);
                        o8[c8] = acc[0] + acc[1];
                    }
                    if (g == 0) {
#pragma unroll
                        for (int c8 = 0; c8 < 8; ++c8) outbuf[(ch * 8 + c8) * 16 + n] = o8[c8]; }
                }
                asm volatile("s_waitcnt lgkmcnt(0)" ::: "memory");
                const float4 ov = *(const float4*)(outbuf + 4 * lane);
                float4 r; r.x = xv.x + g2.x * ov.x * (1.0f / 64.0f); r.y = xv.y + g2.y * ov.y * (1.0f / 64.0f); r.z = xv.z + g2.z * ov.z * (1.0f / 64.0f); r.w = xv.w + g2.w * ov.w * (1.0f / 64.0f);
                ssq[i] += r.x * r.x + r.y * r.y + r.z * r.z + r.w * r.w;
                *(uint2*)(X2 + (size_t)t * 1024 + c0) = pack4(r.x, r.y, r.z, r.w);
            }
        }
        asm volatile("s_waitcnt vmcnt(0)" ::: "memory");
#pragma unroll
        for (int i4 = 0; i4 < 16; i4 += 4) {
            uint2 xb[4][4]; float rn[4];
#pragma unroll
            for (int u = 0; u < 4; ++u) { const int t = (i4 + u < nt) ? t0 + i4 + u : t0;
#pragma unroll
                for (int q4 = 0; q4 < 4; ++q4) xb[u][q4] = *(const uint2*)(X2 + (size_t)t * 1024 + q4 * 256 + lane * 4); }
#pragma unroll
            for (int u = 0; u < 4; ++u) { float sq = ssq[i4 + u];
                for (int o = 32; o > 0; o >>= 1) sq += __shfl_xor(sq, o);
                rn[u] = rsqrtf(sq * (1.0f / 1024.0f) + EPS); }
#pragma unroll
            for (int u = 0; u < 4; ++u) if (i4 + u < nt) {
#pragma unroll
                for (int q4 = 0; q4 < 4; ++q4) {
                    const int c = q4 * 256 + lane * 4;
                    float4 xv; xv.x = __uint_as_float(xb[u][q4].x << 16); xv.y = __uint_as_float(xb[u][q4].x & 0xffff0000u); xv.z = __uint_as_float(xb[u][q4].y << 16); xv.w = __uint_as_float(xb[u][q4].y & 0xffff0000u);
                    const float4 fg = *(const float4*)(final_g + c);
                    float4 r; r.x = xv.x * rn[u] * fg.x; r.y = xv.y * rn[u] * fg.y; r.z = xv.z * rn[u] * fg.z; r.w = xv.w * rn[u] * fg.w;
                    *(float4*)(out + (size_t)(t0 + i4 + u) * 1024 + c) = r;
                }
            }
        }
    }
#undef PE_GATHER
#undef PE_GATHER_HALF
#undef PE_WAITV
#undef PE_HDMA
}


#define XB_TMO      128
#define XB_XCNT(j)  (256  + 64 * (j))
#define XB_XSUB(j)  (1280 + 64 * (j))
#define XB_XGEN(j)  (2304 + 64 * (j))
#define XB_TOP      3328
#define XB_TOPGEN   3392
#define XCD_BAR_WORDS 3456
#define XB_SPIN_CAP (1u << 22)
__device__ __forceinline__ unsigned xb_ld(unsigned* p)              { return __hip_atomic_load(p, __ATOMIC_RELAXED, __HIP_MEMORY_SCOPE_AGENT); }
__device__ __forceinline__ unsigned xb_add(unsigned* p, unsigned v) { return __hip_atomic_fetch_add(p, v, __ATOMIC_RELAXED, __HIP_MEMORY_SCOPE_AGENT); }
__device__ __forceinline__ unsigned xb_xcc_id() { return (unsigned)__builtin_amdgcn_s_getreg((3 << 11) | 20) & 0xFu; }
#define XB_SPIN(cond, bar) do { unsigned _sp = 0; while (cond) { __builtin_amdgcn_s_sleep(1); \
    if ((++_sp & 255u) == 0u) { if (xb_ld(&(bar)[XB_TMO])) break; if (_sp > XB_SPIN_CAP) { atomicAdd(&(bar)[XB_TMO], 1u); break; } } } } while (0)
struct XcdBarrier { unsigned* bar; unsigned x; unsigned nloc; unsigned nx; };
__device__ __forceinline__ void xcd_barrier_post(XcdBarrier& b, unsigned* bar) {
    b.bar = bar; b.x = xb_xcc_id(); b.nloc = 0u; b.nx = 0u;
    if (threadIdx.x == 0) (void)xb_add(&bar[XB_XCNT(b.x)], 1u);
}
__device__ __forceinline__ void xcd_barrier_complete(unsigned* bar, unsigned x, unsigned& nloc, unsigned& nx) {
    const unsigned G = gridDim.x;
    unsigned sum, cnt, mine, sp = 0u;
    for (;;) {
        sum = 0u; cnt = 0u; mine = 0u;
#pragma unroll
        for (unsigned j = 0; j < 16; ++j) { const unsigned c = xb_ld(&bar[XB_XCNT(j)]); sum += c; cnt += (c > 0u) ? 1u : 0u; mine = (j == x) ? c : mine; }
        if (sum == G) break;
        __builtin_amdgcn_s_sleep(1);
        if ((++sp & 255u) == 0u) { if (xb_ld(&bar[XB_TMO])) break; if (sp > XB_SPIN_CAP) { atomicAdd(&bar[XB_TMO], 1u); break; } }
    }
    nloc = mine > 0u ? mine : 1u; nx = cnt > 0u ? cnt : 1u;
}
__device__ __forceinline__ void xcd_barrier(XcdBarrier& b) {
    asm volatile("s_waitcnt vmcnt(0)" ::: "memory");
    __syncthreads();
    if (threadIdx.x == 0) {
        unsigned* bar = b.bar;
        __builtin_amdgcn_s_waitcnt(0);
        if (b.nloc == 0u) xcd_barrier_complete(bar, b.x, b.nloc, b.nx);
        const unsigned nloc = b.nloc, nx = b.nx;
        const unsigned old = xb_add(&bar[XB_XSUB(b.x)], 1u);
        const unsigned gen = old / nloc;
        if (old + 1u == (gen + 1u) * nloc) {
            __builtin_amdgcn_fence(__ATOMIC_RELEASE, "agent");
            asm volatile("s_waitcnt vmcnt(0)" ::: "memory");
            const unsigned og = xb_add(&bar[XB_TOP], 1u);
            const unsigned tg = og / nx;
            if (og + 1u == (tg + 1u) * nx) xb_add(&bar[XB_TOPGEN], 1u);
            else XB_SPIN(xb_ld(&bar[XB_TOPGEN]) == tg, bar);
            __builtin_amdgcn_fence(__ATOMIC_ACQUIRE, "agent");
            xb_add(&bar[XB_XGEN(b.x)], 1u);
            asm volatile("s_waitcnt vmcnt(0)" ::: "memory");
        } else {
            XB_SPIN(xb_ld(&bar[XB_XGEN(b.x)]) == gen, bar);
            __builtin_amdgcn_fence(__ATOMIC_ACQUIRE, "agent");
            asm volatile("s_waitcnt vmcnt(0)" ::: "memory");
        }
    }
    b.nloc = (unsigned)__builtin_amdgcn_readfirstlane((int)b.nloc); b.nx = (unsigned)__builtin_amdgcn_readfirstlane((int)b.nx);
    __syncthreads();
}

__device__ __forceinline__ void prep_convT(const float* __restrict__ srcp, bf16_t* __restrict__ dst, int K, int N, char* lds, int& cursor) {
    float (*tile)[32][33] = (float (*)[32][33])lds;
    const int tx = threadIdx.x & 31, ty = threadIdx.x >> 5;
    const int ntn = N / 32, ntiles = ntn * (K / 32);
    const int G = gridDim.x;
    const int first = ((int)blockIdx.x - cursor % G + G) % G;
    float rg[4][2];
#define CT_LOAD(t_) { _Pragma("unroll") for (int u = 0; u < 4; ++u) { const int tt = (t_) + u * G; \
            if (tt < ntiles) { const int n0 = (tt % ntn) * 32, k0 = (tt / ntn) * 32; \
                _Pragma("unroll") for (int i = 0; i < 2; ++i) rg[u][i] = srcp[(size_t)(k0 + ty + 16 * i) * N + n0 + tx]; } } }
    if (first < ntiles) CT_LOAD(first)
    for (int t = first; t < ntiles; t += 4 * G) {
#pragma unroll
        for (int u = 0; u < 4; ++u)
#pragma unroll
            for (int i = 0; i < 2; ++i) tile[u][ty + 16 * i][tx] = rg[u][i];
        __syncthreads();
        if (t + 4 * G < ntiles) CT_LOAD(t + 4 * G)
#pragma unroll
        for (int u = 0; u < 4; ++u) {
            const int tt = t + u * G;
            if (tt < ntiles) { const int n0 = (tt % ntn) * 32, k0 = (tt / ntn) * 32;
#pragma unroll
                for (int i = 0; i < 2; ++i) dst[(size_t)(n0 + ty + 16 * i) * K + k0 + tx] = f2bf(tile[u][tx][ty + 16 * i]); }
        }
        __syncthreads();
    }
#undef CT_LOAD
    cursor += ntiles;
}
__device__ __forceinline__ void prep_conv(const float* __restrict__ srcp, bf16_t* __restrict__ dst, size_t n8) {
    for (size_t i = (size_t)blockIdx.x * blockDim.x + threadIdx.x; i < n8; i += (size_t)gridDim.x * blockDim.x) {
        const float4 a = *(const float4*)(srcp + i * 8), b = *(const float4*)(srcp + i * 8 + 4);
        uint4 o; o.x = pack2(a.x, a.y); o.y = pack2(a.z, a.w); o.z = pack2(b.x, b.y); o.w = pack2(b.z, b.w);
        *(uint4*)(dst + i * 8) = o;
    }
}
__device__ __forceinline__ void prep_ada(const float* __restrict__ c, const float* __restrict__ w_ada, const float* __restrict__ b_ada, float* __restrict__ mod, char* lds) {
    float* sc = (float*)lds;
    float* part = (float*)(lds + 16384);
    const int tid = threadIdx.x, col = tid & 31, kq = tid >> 5;
    const int G = gridDim.x;
    for (int item = (int)blockIdx.x; item < 192; item += G) {
        __syncthreads();
        for (int i = tid; i < 4096; i += NTHR) { const float v = c[i]; sc[i] = v * sigmoidf_(v); }
        __syncthreads();
        const int e = item * 32 + col;
        float a0 = 0.f, a1 = 0.f, a2 = 0.f, a3 = 0.f;
#pragma unroll 16
        for (int d = kq * 64; d < kq * 64 + 64; ++d) {
            const float wv = w_ada[(size_t)d * 6144 + e];
            a0 += sc[d] * wv; a1 += sc[1024 + d] * wv; a2 += sc[2048 + d] * wv; a3 += sc[3072 + d] * wv;
        }
        part[(kq * 4 + 0) * 32 + col] = a0; part[(kq * 4 + 1) * 32 + col] = a1; part[(kq * 4 + 2) * 32 + col] = a2; part[(kq * 4 + 3) * 32 + col] = a3;
        __syncthreads();
        if (tid < 128) { const int b = tid >> 5;
          float s = 0.f;
#pragma unroll
          for (int k16 = 0; k16 < 16; ++k16) s += part[(k16 * 4 + b) * 32 + col];
          mod[b * 6144 + e] = s + b_ada[e]; }
    }
}

__device__ __forceinline__ void prep_quant(const float* __restrict__ srcp, unsigned char* __restrict__ dst, float* __restrict__ scales, int rows, int off) {
    const int lane = threadIdx.x & 63, w = threadIdx.x >> 6;
    const int nwaves = gridDim.x * NW;
    float4 nx[4][4];
    { const int rb0 = (blockIdx.x * NW + w) * 4;
      if (rb0 < rows) {
#pragma unroll
        for (int u = 0; u < 4; ++u)
#pragma unroll
            for (int j = 0; j < 4; ++j) nx[u][j] = *(const float4*)(srcp + (size_t)(rb0 + u) * 1024 + j * 256 + lane * 4); } }
    for (int rb = (blockIdx.x * NW + w) * 4; rb < rows; rb += nwaves * 4) {
        float4 v[4][4];
#pragma unroll
        for (int u = 0; u < 4; ++u)
#pragma unroll
            for (int j = 0; j < 4; ++j) v[u][j] = nx[u][j];
        if (rb + nwaves * 4 < rows) {
#pragma unroll
            for (int u = 0; u < 4; ++u)
#pragma unroll
                for (int j = 0; j < 4; ++j) nx[u][j] = *(const float4*)(srcp + (size_t)(rb + nwaves * 4 + u) * 1024 + j * 256 + lane * 4);
        }
#pragma unroll
        for (int u = 0; u < 4; ++u) {
            const int r = rb + u;
            float am = 0.f;
#pragma unroll
            for (int j = 0; j < 4; ++j) am = fmaxf(am, fmaxf(fmaxf(fabsf(v[u][j].x), fabsf(v[u][j].y)), fmaxf(fabsf(v[u][j].z), fabsf(v[u][j].w))));
            for (int o = 32; o > 0; o >>= 1) am = fmaxf(am, __shfl_xor(am, o));
            unsigned o4[4];
            if (off < 0) {
                float sq = 0.f;
#pragma unroll
                for (int j = 0; j < 4; ++j) sq += v[u][j].x * v[u][j].x + v[u][j].y * v[u][j].y + v[u][j].z * v[u][j].z + v[u][j].w * v[u][j].w;
                for (int o = 32; o > 0; o >>= 1) sq += __shfl_xor(sq, o);
                float unit = fmaxf(0.5f * sqrtf(sq * (1.0f / 1024.0f)), am * (1.0f / 8.0f));
                if (!(unit > 0.f)) unit = 1.0f;
                const float inv4 = 1.0f / unit;
                if (lane == 0) scales[r] = unit;
#pragma unroll
                for (int j = 0; j < 4; ++j) {
                    unsigned pb = 0;
                    pb = __builtin_amdgcn_cvt_scalef32_pk_fp4_f32(pb, v[u][j].x * inv4, v[u][j].y * inv4, 1.0f, 0);
                    pb = __builtin_amdgcn_cvt_scalef32_pk_fp4_f32(pb, v[u][j].z * inv4, v[u][j].w * inv4, 1.0f, 1);
                    *(unsigned short*)(dst + (size_t)j * ((size_t)rows * 128) + (size_t)r * 128 + lane * 2) = (unsigned short)pb;
                }
                continue;
            }
        }
    }
}
template <bool QUANT>
__device__ __forceinline__ void phase_norm(const void* __restrict__ xin, const float* __restrict__ g, const float* __restrict__ mod, int sh_off, int sc_off, bf16_t* __restrict__ H,
                                           unsigned char* __restrict__ HQ, float* __restrict__ HSC) {
    const int lane = threadIdx.x & 63, w = threadIdx.x >> 6;
    const int nwaves = gridDim.x * NW;
    for (int tb = (blockIdx.x * NW + w) * 2; tb < NTOK; tb += nwaves * 2) {
        float4 v[2][4];
        if (QUANT) {
#pragma unroll
            for (int u = 0; u < 2; ++u)
#pragma unroll
                for (int j = 0; j < 4; ++j) { const uint2 xb = *(const uint2*)((const bf16_t*)xin + (size_t)(tb + u) * 1024 + j * 256 + lane * 4);
                    v[u][j] = make_float4(__uint_as_float(xb.x << 16), __uint_as_float(xb.x & 0xffff0000u), __uint_as_float(xb.y << 16), __uint_as_float(xb.y & 0xffff0000u)); }
        } else {
#pragma unroll
            for (int u = 0; u < 2; ++u)
#pragma unroll
                for (int j = 0; j < 4; ++j) v[u][j] = *(const float4*)((const float*)xin + (size_t)(tb + u) * 1024 + j * 256 + lane * 4);
        }
#pragma unroll
        for (int u = 0; u < 2; ++u) {
            const int t = tb + u; const int b = t / SEQ;
            float ss = 0.f;
#pragma unroll
            for (int j = 0; j < 4; ++j) ss += v[u][j].x * v[u][j].x + v[u][j].y * v[u][j].y + v[u][j].z * v[u][j].z + v[u][j].w * v[u][j].w;
            for (int o = 32; o > 0; o >>= 1) ss += __shfl_xor(ss, o);
            const float r = rsqrtf(ss * (1.0f / 1024.0f) + EPS);
            float am = 0.f;
#pragma unroll
            for (int j = 0; j < 4; ++j) {
                const int c = j * 256 + lane * 4;
                const float4 gg = *(const float4*)(g + c), sc = *(const float4*)(mod + b * 6144 + sc_off + c), sh = *(const float4*)(mod + b * 6144 + sh_off + c);
                float4& vv = v[u][j];
                vv.x = vv.x * r * gg.x * (1.0f + sc.x) + sh.x; vv.y = vv.y * r * gg.y * (1.0f + sc.y) + sh.y;
                vv.z = vv.z * r * gg.z * (1.0f + sc.z) + sh.z; vv.w = vv.w * r * gg.w * (1.0f + sc.w) + sh.w;
                *(uint2*)(H + (size_t)t * 1024 + c) = pack4(vv.x, vv.y, vv.z, vv.w);
                if (QUANT) am = fmaxf(am, fmaxf(fmaxf(fabsf(vv.x), fabsf(vv.y)), fmaxf(fabsf(vv.z), fabsf(vv.w))));
            }
            if (QUANT) {
                for (int o = 32; o > 0; o >>= 1) am = fmaxf(am, __shfl_xor(am, o));
                const float inv = am > 0.f ? 448.0f / am : 0.f;
                if (lane == 0) HSC[t] = am > 0.f ? am * (1.0f / 448.0f) : 1.0f;
#pragma unroll
                for (int j = 0; j < 4; ++j) {
                    const float4 vv = v[u][j];
                    int p8 = 0;
                    p8 = __builtin_amdgcn_cvt_pk_fp8_f32(vv.x * inv, vv.y * inv, p8, false);
                    p8 = __builtin_amdgcn_cvt_pk_fp8_f32(vv.z * inv, vv.w * inv, p8, true);
                    *(int*)(HQ + (size_t)t * 1024 + j * 256 + lane * 4) = p8;
                }
            }
        }
    }
}
struct MegaParams {
    const float* in[24];
    float* out;
    char* ws;
    int use_cg; int pad;
};
#define MEGA_LDS_BYTES (NW * PE_WAVE_LDS)
#define W_CTL   ((float*)(ws + OFF_CTL))
#define W_MOD   ((float*)(ws + OFF_MOD))
#define W_WTIN  ((bf16_t*)(ws + OFF_WTIN))
#define W_WTA   ((bf16_t*)(ws + OFF_WTA))
#define W_WTB   ((bf16_t*)(ws + OFF_WTB))
#define W_WTOUT ((bf16_t*)(ws + OFF_WTOUT))
#define W_WTQ   ((bf16_t*)(ws + OFF_WTQ))
#define W_SUBK  ((bf16_t*)(ws + OFF_SUBK))
#define W_DOWN  ((bf16_t*)(ws + OFF_DOWN))
#define W_UP    ((bf16_t*)(ws + OFF_UP))
#define W_H     ((bf16_t*)(ws + OFF_H))
#define W_Q     ((bf16_t*)(ws + OFF_Q))
#define W_K     ((bf16_t*)(ws + OFF_K))
#define W_V     ((bf16_t*)(ws + OFF_VT))
#define W_U     ((bf16_t*)(ws + OFF_U))
#define W_SV    ((bf16_t*)(ws + OFF_SV))
#define W_GATES ((bf16_t*)(ws + OFF_GATES))
#define W_YA    ((bf16_t*)(ws + OFF_YA))
#define W_YB    ((bf16_t*)(ws + OFF_YB))
#define W_MERGED ((bf16_t*)(ws + OFF_MERGED))
#define W_EIDX  ((int*)(ws + OFF_EIDX))
#define W_GW    ((float*)(ws + OFF_GW))
__global__ __launch_bounds__(NTHR, 2) void k_mega(MegaParams P) {
    cg::grid_group grid = cg::this_grid();
    char* lds = dyn_lds; char* ws = P.ws;
    const float* x = P.in[0];
    XcdBarrier xb; xcd_barrier_post(xb, (unsigned*)(ws + OFF_BAR));
    prep_ada(P.in[1], P.in[2], P.in[3], W_MOD, lds);
    if (blockIdx.x == gridDim.x - 1 && threadIdx.x < 64) {
        const int i = threadIdx.x;
        float s1 = P.in[6][i] * P.in[7][i], s2 = P.in[8][i] * P.in[9][i];
        for (int o = 32; o > 0; o >>= 1) { s1 += __shfl_xor(s1, o); s2 += __shfl_xor(s2, o); }
        if (i == 0) W_CTL[0] = __expf(s1) - __expf(s2) + 0.2f;
    }
    { int cursor = 0;
      __syncthreads();
      prep_convT(P.in[5], W_WTIN, 1024, IN_COLS, lds, cursor);
      prep_convT(P.in[15], W_WTA, 512, 1024, lds, cursor);
      prep_convT(P.in[16], W_WTB, 512, 1024, lds, cursor);
      prep_convT(P.in[17], W_WTOUT, 1024, 1024, lds, cursor);
      prep_convT(P.in[19], W_WTQ, 1024, 2048, lds, cursor); }
    prep_conv(P.in[20], W_SUBK, (size_t)8 * 2 * 128 * 128 / 8);
    prep_quant(P.in[21], (unsigned char*)(ws + OFF_DOWN), (float*)(ws + OFF_DSC), 16384, -1);
    prep_quant(P.in[22], (unsigned char*)(ws + OFF_UP), (float*)(ws + OFF_USC), 16384, -1);
    if (P.use_cg) grid.sync(); else xcd_barrier(xb);
    phase_norm<false>(x, P.in[4], W_MOD, 0, 1024, W_H, nullptr, nullptr);
    xcd_barrier(xb);
    phase_inproj8(W_H, W_WTIN, W_Q, W_K, W_V, W_U, W_SV, W_GATES, lds);
    xcd_barrier(xb);
    phase_sgu(W_U, W_SV, P.in[11], P.in[12], P.in[13], P.in[14], W_YB, lds);
    phase_attn(W_Q, W_K, W_V, W_CTL, P.in[10], W_YA, lds);
    xcd_barrier(xb);
    phase_merged8(W_YA, W_YB, W_WTA, W_WTB, W_GATES, W_MERGED, lds);
    xcd_barrier(xb);
    phase_outproj8(W_MERGED, W_WTOUT, x, W_MOD, W_H, lds);
    xcd_barrier(xb);
    phase_norm<true>(W_H, P.in[18], W_MOD, 3072, 4096, W_MERGED, (unsigned char*)(ws + OFF_HQ), (float*)(ws + OFF_HSC));
    xcd_barrier(xb);
    phase_peer_select8(W_MERGED, W_WTQ, W_SUBK, W_GATES, W_EIDX, W_GW, lds);
    xcd_barrier(xb);
    phase_peer_expert((const unsigned char*)(ws + OFF_HQ), (const float*)(ws + OFF_HSC), W_EIDX, W_GW, (const unsigned char*)(ws + OFF_DOWN), (const unsigned char*)(ws + OFF_UP), (const float*)(ws + OFF_DSC), (const float*)(ws + OFF_USC),
                      (unsigned char*)(ws + OFF_YB), W_MOD, P.in[23], W_H, (bf16_t*)(ws + OFF_GATES), P.out, lds);
}

extern "C" void kernel_launch(void* const* d_in, const int* in_sizes, int n_in, void* d_out, int out_size, void* d_ws, size_t ws_size, hipStream_t stream) {
    if (ws_size < OFF_END || n_in < 24) return;
    static int grid_blocks = 0;
    if (!grid_blocks) {
        int dev = 0, cus = 0, per_cu = 0;
        hipGetDevice(&dev);
        hipDeviceGetAttribute(&cus, hipDeviceAttributeMultiprocessorCount, dev);
        hipFuncSetAttribute((const void*)k_mega, hipFuncAttributeMaxDynamicSharedMemorySize, MEGA_LDS_BYTES);
        hipOccupancyMaxActiveBlocksPerMultiprocessor(&per_cu, k_mega, NTHR, MEGA_LDS_BYTES);
        if (per_cu > 1) per_cu = 1;
        if (per_cu < 1) per_cu = 1;
        grid_blocks = cus * per_cu;
    }
    MegaParams P{};
    for (int i = 0; i < 24; ++i) P.in[i] = (const float*)d_in[i];
    P.out = (float*)d_out; P.ws = (char*)d_ws;
    hipMemsetAsync((char*)d_ws + OFF_BAR, 0, XCD_BAR_WORDS * 4, stream);
    void* args[] = {&P};
    hipError_t e = hipLaunchCooperativeKernel((void*)k_mega, dim3(grid_blocks), dim3(NTHR), args, MEGA_LDS_BYTES, stream);
    if (e != hipSuccess) fprintf(stderr, "cooperative launch failed: %s (grid %d)\n", hipGetErrorString(e), grid_blocks);
}
```

```cpp
#include <hip/hip_runtime.h>
#include <hip/hip_cooperative_groups.h>
#include <stdint.h>
#include <stdio.h>
namespace cg = cooperative_groups;

typedef unsigned short bf16_t;

#define D_MODEL 1024
#define BATCH 4
#define SEQ 8192
#define NTOK (BATCH * SEQ)
#define IN_COLS 4608
#define EPS 1e-6f
#define QSCALE 0.18033688011112042f

__device__ __forceinline__ float bf2f(bf16_t v) { return __uint_as_float(((unsigned)v) << 16); }
typedef __bf16 bf16v2_t __attribute__((ext_vector_type(2)));
__device__ __forceinline__ bf16_t f2bf(float f) { return __builtin_bit_cast(unsigned short, (__bf16)f); }
__device__ __forceinline__ unsigned pack2(float a, float b) { bf16v2_t v; v[0] = (__bf16)a; v[1] = (__bf16)b; return __builtin_bit_cast(unsigned, v); }
__device__ __forceinline__ float gelu_tanh(float x) {
    const float z2 = 1.5957691216057308f * (x + 0.044715f * x * x * x);
    return x * __builtin_amdgcn_rcpf(1.0f + __expf(-z2));
}
__device__ __forceinline__ float sigmoidf_(float x) { return __builtin_amdgcn_rcpf(1.0f + __expf(-x)); }

constexpr size_t OFF_CTL   = 0;
constexpr size_t OFF_BAR   = 4096;
constexpr size_t OFF_MOD   = 4096 + 16384;
constexpr size_t OFF_STATS = OFF_MOD + 4 * 6144 * 4;
constexpr size_t OFF_WTIN  = OFF_STATS + (size_t)NTOK * 2 * 4;
constexpr size_t OFF_WTA   = OFF_WTIN + (size_t)IN_COLS * 1024 * 2;
constexpr size_t OFF_WTB   = OFF_WTA + (size_t)1024 * 512 * 2;
constexpr size_t OFF_WTOUT = OFF_WTB + (size_t)1024 * 512 * 2;
constexpr size_t OFF_WTQ   = OFF_WTOUT + (size_t)1024 * 1024 * 2;
constexpr size_t OFF_SUBK  = OFF_WTQ + (size_t)2048 * 1024 * 2;
constexpr size_t OFF_DOWN  = OFF_SUBK + (size_t)8 * 2 * 128 * 128 * 2;
constexpr size_t OFF_UP    = OFF_DOWN + (size_t)16384 * 1024;
constexpr size_t OFF_DSC   = OFF_UP + (size_t)16384 * 1024;
constexpr size_t OFF_USC   = OFF_DSC + (size_t)16384 * 4;
constexpr size_t OFF_H     = OFF_USC + (size_t)16384 * 4;
constexpr size_t OFF_Q     = OFF_H + (size_t)NTOK * 1024 * 2;
constexpr size_t OFF_K     = OFF_Q + (size_t)NTOK * 512 * 2;
constexpr size_t OFF_VT    = OFF_K + (size_t)NTOK * 512 * 2;
constexpr size_t OFF_U     = OFF_VT + (size_t)NTOK * 512 * 2;
constexpr size_t OFF_SV    = OFF_U + (size_t)NTOK * 512 * 2;
constexpr size_t OFF_GATES = OFF_SV + (size_t)NTOK * 512 * 2;
constexpr size_t OFF_YA    = OFF_GATES + (size_t)NTOK * 2048 * 2;
constexpr size_t OFF_YB    = OFF_YA + (size_t)NTOK * 512 * 2;
constexpr size_t OFF_END   = OFF_YB + (size_t)NTOK * 512 * 2;
constexpr size_t OFF_MERGED = OFF_Q;
constexpr size_t OFF_EIDX  = OFF_U;
constexpr size_t OFF_GW    = OFF_SV;
constexpr size_t OFF_HQ    = OFF_YA;
constexpr size_t OFF_HSC   = OFF_STATS;

#define NW 8
#define NTHR (NW * 64)
extern __shared__ __attribute__((aligned(16))) char dyn_lds[];
using bf16x8 = __attribute__((ext_vector_type(8))) short;
using f32x4 = __attribute__((ext_vector_type(4))) float;
typedef float f32x2_t __attribute__((ext_vector_type(2)));
typedef _Float16 h2_t __attribute__((ext_vector_type(2)));
typedef __attribute__((address_space(3))) char* lds_ptr_t;
#define GEMM_LDS_BYTES 65536
#define SEL_LDS_BYTES 81920

__device__ __forceinline__ uint2 pack4(float a, float b, float c, float d) {
    uint2 r; r.x = pack2(a, b); r.y = pack2(c, d); return r;
}


namespace pg8 {
#define PG8_LAS __attribute__((address_space(3)))
typedef unsigned short bf16_t;
typedef short bf16x8 __attribute__((ext_vector_type(8)));
typedef float f32x4 __attribute__((ext_vector_type(4)));
typedef unsigned u32x4 __attribute__((ext_vector_type(4)));
constexpr int BM = 256, BK = 64, HALF = 128, HTB = HALF * BK * 2  , STAGE_BYTES = 8 * HTB, NXCD = 8, WGM = 8;

__host__ __device__ __forceinline__ int lds_byte(int r, int c) { const int st = (r >> 4) * 2 + (c >> 5), rr = r & 15, cc = c & 31, ob = rr * 64 + cc * 2; return st * 1024 + (ob ^ (((ob >> 9) & 1) << 5)); }
__host__ __device__ __forceinline__ void stage_rc(int b, int& R, int& C) { const int st = b / 1024, sb = b % 1024, swz = sb ^ (((sb >> 9) & 1) << 5); R = (st >> 1) * 16 + swz / 64; C = (st & 1) * 32 + (swz % 64) / 2; }
__host__ __device__ __forceinline__ int perm32(int rho) { const int n = rho >> 4, i = rho & 15; return 8 * (i >> 2) + 4 * n + (i & 3); }

struct Unit { int pm, pn, which; };
struct Gemm { const bf16_t* A; const bf16_t* Bt; int M, N, K; const bf16_t* A2; const bf16_t* Bt2; };

struct StaticOrder {
    int nM, nN, nwg, G, c;
    __host__ __device__ void init(int M, int N, int G_, int c_) { nM = M / BM; nN = N / BM; nwg = nM * nN; G = G_; c = c_; }
    __host__ __device__ bool next(int i, Unit& u) const {
        const long L = (long)i * G + c; if (L >= nwg) return false;
        int wgid = (int)L; { const int q = nwg / NXCD, r = nwg % NXCD, xcd = wgid % NXCD, off = wgid / NXCD; wgid = (xcd < r ? xcd * (q + 1) : r * (q + 1) + (xcd - r) * q) + off; }
        const int nig = WGM * nN, gid = wgid / nig, fm = gid * WGM, gsz = (nM - fm) < WGM ? (nM - fm) : WGM;
        u.pm = fm + ((wgid % nig) % gsz); u.pn = (wgid % nig) / gsz; u.which = 0; return true;
    }
    __device__ __forceinline__ void a_ready(const Unit&) const {}
    __device__ __forceinline__ void done(const Unit&) const {}
};

struct StaticOrder2 {
    StaticOrder base;
    __host__ __device__ void init(int M, int N, int G_, int c_) { base.init(M, N, G_, c_); }
    __host__ __device__ bool next(int i, Unit& u) const { const bool ok = base.next(i >> 1, u); u.which = i & 1; return ok; }
    __device__ __forceinline__ void a_ready(const Unit&) const {}
    __device__ __forceinline__ void done(const Unit&) const {}
};

template <class Epi, class Sched, bool STAMP = false>
__device__ __forceinline__ void gemm_phase(PG8_LAS unsigned char* lds, const Gemm g, const Sched& S, const Epi& E, unsigned long long* stamps) {
    const int tid = threadIdx.x, wid = __builtin_amdgcn_readfirstlane(tid >> 6), lane = tid & 63, wr = wid >> 2, wc = wid & 3, fr = lane & 15, fq = lane >> 4;
    const int K = g.K, nt = K / BK;
    int ts_lo = 0, ts_hi = 0, nts = 0; const unsigned long long rt_entry = STAMP ? (unsigned long long)wall_clock64() : 0ull;
#define PG8_STAMP() do { if (STAMP && wid == 0 && nts < 64) { const unsigned long long _c = (unsigned long long)clock64(); \
        ts_lo = (lane == nts) ? (int)(unsigned)_c : ts_lo; ts_hi = (lane == nts) ? (int)(unsigned)(_c >> 32) : ts_hi; ++nts; } } while (0)
    PG8_STAMP();
    unsigned voffA[2], voffB[2];
#pragma unroll
    for (int i = 0; i < 2; ++i) { int R, C; stage_rc(tid * 16 + i * 8192, R, C); const int Rb = Epi::PERM ? ((R & ~31) + perm32(R & 31)) : R;
        voffA[i] = (unsigned)(R * K + C) * 2u; voffB[i] = (unsigned)(Rb * K + C) * 2u; }
    const size_t kstep = (size_t)(BK * 2);
    const size_t hstep = (size_t)HALF * K * 2;
    const size_t tstep = 2 * hstep;
    const unsigned ldsw = (unsigned)wid * 1024u;
    const int aoff = lds_byte(wr * 64 + fr, fq * 8), boff = lds_byte(wc * 32 + fr, fq * 8);
#define PG8_SA(b, h) (((b) * 2 + (h)) * HTB)
#define PG8_SB(b, h) ((4 + (b) * 2 + (h)) * HTB)
#define PG8_STAGE(bufoff, gbase, voff) do { _Pragma("unroll") for (int _i = 0; _i < 2; ++_i) \
        __builtin_amdgcn_global_load_lds((const unsigned*)((const char*)(gbase) + (voff)[_i]), (PG8_LAS unsigned*)(lds + (bufoff) + ldsw + _i * 8192), 16, 0, 0); } while (0)
#define PG8_LDA(dst, b, h) do { _Pragma("unroll") for (int m = 0; m < 4; ++m) _Pragma("unroll") for (int k = 0; k < 2; ++k) dst[m][k] = *(const PG8_LAS bf16x8*)(lds + PG8_SA(b, h) + aoff + m * 2048 + k * 1024); } while (0)
#define PG8_LDB(dst, b, h) do { _Pragma("unroll") for (int n = 0; n < 2; ++n) _Pragma("unroll") for (int k = 0; k < 2; ++k) dst[n][k] = *(const PG8_LAS bf16x8*)(lds + PG8_SB(b, h) + boff + n * 2048 + k * 1024); } while (0)
#define PG8_MMA(ai, bj, At, Bt) do { __builtin_amdgcn_s_setprio(1); _Pragma("unroll") for (int m = 0; m < 4; ++m) _Pragma("unroll") for (int n = 0; n < 2; ++n) _Pragma("unroll") for (int k = 0; k < 2; ++k) \
        acc[ai][bj][m][n] = __builtin_amdgcn_mfma_f32_16x16x32_bf16(Bt[n][k], At[m][k], acc[ai][bj][m][n], 0, 0, 0); __builtin_amdgcn_s_setprio(0); } while (0)
#define PG8_WAIT_V(n) asm volatile("s_waitcnt vmcnt(" #n ")" ::: "memory")
#define PG8_WAIT_L(n) asm volatile("s_waitcnt lgkmcnt(" #n ")" ::: "memory")
#define PG8_BAR __builtin_amdgcn_s_barrier()
#define PG8_SCHED __builtin_amdgcn_sched_barrier(0)
    Unit cur, nxt; int ui = 0;
    if (!S.next(0, cur)) return;
    f32x4 acc[2][2][4][2];
#pragma unroll
    for (int a = 0; a < 2; ++a)
#pragma unroll
        for (int b = 0; b < 2; ++b)
#pragma unroll
            for (int m = 0; m < 4; ++m)
#pragma unroll
                for (int n = 0; n < 2; ++n) acc[a][b][m][n] = (f32x4){0.f, 0.f, 0.f, 0.f};
    bf16x8 At[4][2], B0[2][2], B1[2][2];
    const char* cA = (const char*)(cur.which ? g.A2 : g.A) + (size_t)cur.pm * tstep; const char* cB = (const char*)(cur.which ? g.Bt2 : g.Bt) + (size_t)cur.pn * tstep;
    S.a_ready(cur);
    PG8_STAGE(PG8_SB(0, 0), cB, voffB); PG8_STAGE(PG8_SA(0, 0), cA, voffA); PG8_STAGE(PG8_SB(0, 1), cB + hstep, voffB); PG8_STAGE(PG8_SA(0, 1), cA + hstep, voffA);
    if (wr == 1) PG8_BAR;
    PG8_WAIT_V(4); PG8_BAR;
    PG8_STAGE(PG8_SB(1, 0), cB + kstep, voffB); PG8_STAGE(PG8_SA(1, 0), cA + kstep, voffA); PG8_STAGE(PG8_SB(1, 1), cB + hstep + kstep, voffB);
    PG8_WAIT_V(6); PG8_BAR;
    PG8_STAMP();
    for (;;) {
        const bool has_next = S.next(ui + 1, nxt);
        const char* nA = has_next ? (const char*)(nxt.which ? g.A2 : g.A) + (size_t)nxt.pm * tstep : cA; const char* nB = has_next ? (const char*)(nxt.which ? g.Bt2 : g.Bt) + (size_t)nxt.pn * tstep : cB;
        for (int t = 0; t < nt; t += 2) {
            const bool last = (t == nt - 2);
            const char* a1 = cA + (size_t)(t + 1) * kstep;
            const char* a2 = last ? nA : cA + (size_t)(t + 2) * kstep; const char* b2 = last ? nB : cB + (size_t)(t + 2) * kstep;
            const char* a3 = a2 + kstep; const char* b3 = b2 + kstep;
            if (last && has_next) S.a_ready(nxt);
            PG8_LDB(B0, 0, 0); PG8_SCHED; PG8_LDA(At, 0, 0); PG8_STAGE(PG8_SA(1, 1), a1 + hstep, voffA);
            PG8_WAIT_L(8); PG8_BAR; PG8_WAIT_L(0); PG8_MMA(0, 0, At, B0); PG8_BAR; PG8_SCHED;
            PG8_LDB(B1, 0, 1); PG8_STAGE(PG8_SB(0, 0), b2, voffB);
            PG8_BAR; PG8_WAIT_L(0); PG8_MMA(0, 1, At, B1); PG8_BAR;
            PG8_LDA(At, 0, 1); PG8_STAGE(PG8_SA(0, 0), a2, voffA);
            PG8_BAR; PG8_WAIT_L(0); PG8_MMA(1, 0, At, B0); PG8_BAR; PG8_SCHED;
            PG8_STAGE(PG8_SB(0, 1), b2 + hstep, voffB);
            PG8_WAIT_V(6); PG8_BAR; PG8_MMA(1, 1, At, B1); PG8_BAR;
            PG8_LDB(B0, 1, 0); PG8_SCHED; PG8_LDA(At, 1, 0); PG8_STAGE(PG8_SA(0, 1), a2 + hstep, voffA);
            PG8_WAIT_L(8); PG8_BAR; PG8_WAIT_L(0); PG8_MMA(0, 0, At, B0); PG8_BAR; PG8_SCHED;
            PG8_LDB(B1, 1, 1); PG8_STAGE(PG8_SB(1, 0), b3, voffB);
            PG8_BAR; PG8_WAIT_L(0); PG8_MMA(0, 1, At, B1); PG8_BAR;
            PG8_LDA(At, 1, 1); PG8_STAGE(PG8_SA(1, 0), a3, voffA);
            PG8_BAR; PG8_WAIT_L(0); PG8_MMA(1, 0, At, B0); PG8_BAR; PG8_SCHED;
            PG8_STAGE(PG8_SB(1, 1), b3 + hstep, voffB);
            PG8_WAIT_V(6); PG8_BAR; PG8_MMA(1, 1, At, B1); PG8_BAR;
        }
        PG8_STAMP();
        bool keep_acc = false;
        if constexpr (Epi::TWO_PASS) { if (cur.which == 0) { E.mid(acc, cur, wr, wc, fr, fq); keep_acc = true; } else { E(acc, cur, wr, wc, fr, fq); S.done(cur); } }
        else if constexpr (!Epi::AFTER_DRAIN) { E(acc, cur, wr, wc, fr, fq); S.done(cur); }
        PG8_STAMP();
        if (!has_next) break;
        if (!keep_acc) {
#pragma unroll
        for (int a = 0; a < 2; ++a)
#pragma unroll
            for (int b = 0; b < 2; ++b)
#pragma unroll
                for (int m = 0; m < 4; ++m)
#pragma unroll
                    for (int n = 0; n < 2; ++n) acc[a][b][m][n] = (f32x4){0.f, 0.f, 0.f, 0.f};
        }
        cur = nxt; cA = nA; cB = nB; ++ui;
    }
    PG8_WAIT_V(0);
    if (wr == 0) PG8_BAR;
    PG8_BAR;
    if constexpr (Epi::AFTER_DRAIN) { E.fused(acc, cur, wr, wc, fr, fq, lds, wid, lane); S.done(cur); }
    PG8_STAMP();
    if (STAMP && wid == 0) { stamps[lane] = lane < nts ? (((unsigned long long)(unsigned)ts_hi << 32) | (unsigned)ts_lo) : 0ull;
        if (lane == 62) stamps[62] = rt_entry; if (lane == 63) stamps[63] = (unsigned long long)wall_clock64(); }
#undef PG8_STAMP
#undef PG8_SA
#undef PG8_SB
#undef PG8_STAGE
#undef PG8_LDA
#undef PG8_LDB
#undef PG8_MMA
#undef PG8_WAIT_V
#undef PG8_WAIT_L
#undef PG8_BAR
#undef PG8_SCHED
}
}

struct EpiInProj8 {
    static constexpr bool PERM = true, AFTER_DRAIN = false, TWO_PASS = false;
    bf16_t *Q, *Kb, *V, *U, *SV, *G;
    __device__ __forceinline__ void operator()(const pg8::f32x4 (&acc)[2][2][4][2], const pg8::Unit& u, int wr, int wc, int fr, int fq) const {
        const int row0 = u.pm * 256 + wr * 64 + fr; const int colt = u.pn * 256;
        bf16_t* base; int ld, cl, act;
        if (colt < 512) { base = Q; ld = 512; cl = colt; act = 1; }
        else if (colt < 1024) { base = Kb; ld = 512; cl = colt - 512; act = 0; }
        else if (colt < 1536) { base = V; ld = 512; cl = colt - 1024; act = 0; }
        else if (colt < 2048) { base = U; ld = 512; cl = colt - 1536; act = 2; }
        else if (colt < 2560) { base = SV; ld = 512; cl = colt - 2048; act = 2; }
        else { base = G; ld = 2048; cl = colt - 2560; act = 3; }
        const int col0 = cl + wc * 32 + 8 * fq;
#pragma unroll
        for (int ai = 0; ai < 2; ++ai)
#pragma unroll
            for (int m = 0; m < 4; ++m) { bf16_t* rowp = base + (size_t)(row0 + ai * 128 + m * 16) * ld + col0;
#pragma unroll
                for (int bj = 0; bj < 2; ++bj) { pg8::f32x4 v0 = acc[ai][bj][m][0], v1 = acc[ai][bj][m][1];
                    if (act == 1) { v0 *= QSCALE; v1 *= QSCALE; }
                    else if (act == 2) {
#pragma unroll
                        for (int j = 0; j < 4; ++j) { v0[j] = gelu_tanh(v0[j]); v1[j] = gelu_tanh(v1[j]); } }
                    else if (act == 3) {
#pragma unroll
                        for (int j = 0; j < 4; ++j) { v0[j] = sigmoidf_(v0[j]); v1[j] = sigmoidf_(v1[j]); } }
                    uint4 wv; wv.x = pack2(v0[0], v0[1]); wv.y = pack2(v0[2], v0[3]); wv.z = pack2(v1[0], v1[1]); wv.w = pack2(v1[2], v1[3]);
                    *(uint4*)(rowp + bj * 128) = wv; } }
    }
};

struct EpiOut8 {
    static constexpr bool PERM = true, AFTER_DRAIN = false, TWO_PASS = false;
    const float* x; const float* mod; bf16_t* x1;
    __device__ __forceinline__ void operator()(const pg8::f32x4 (&acc)[2][2][4][2], const pg8::Unit& u, int wr, int wc, int fr, int fq) const {
        const int row0 = u.pm * 256 + wr * 64 + fr, col0 = u.pn * 256 + wc * 32 + 8 * fq;
        const int b = (u.pm * 256) / SEQ;
        pg8::f32x4 g1[2][2];
#pragma unroll
        for (int bj = 0; bj < 2; ++bj)
#pragma unroll
            for (int n = 0; n < 2; ++n) g1[bj][n] = *(const pg8::f32x4*)(mod + b * 6144 + 2048 + col0 + bj * 128 + n * 4);
#pragma unroll
        for (int ai = 0; ai < 2; ++ai)
#pragma unroll
            for (int m = 0; m < 4; ++m) { const size_t ro = (size_t)(row0 + ai * 128 + m * 16) * 1024 + col0;
#pragma unroll
                for (int bj = 0; bj < 2; ++bj) {
                    const pg8::f32x4 xa = *(const pg8::f32x4*)(x + ro + bj * 128), xb = *(const pg8::f32x4*)(x + ro + bj * 128 + 4);
                    const pg8::f32x4 v0 = xa + g1[bj][0] * acc[ai][bj][m][0], v1 = xb + g1[bj][1] * acc[ai][bj][m][1];
                    uint4 wv; wv.x = pack2(v0[0], v0[1]); wv.y = pack2(v0[2], v0[3]); wv.z = pack2(v1[0], v1[1]); wv.w = pack2(v1[2], v1[3]);
                    *(uint4*)(x1 + ro + bj * 128) = wv; } }
    }
};
struct EpiMerged2 {
    static constexpr bool PERM = true, AFTER_DRAIN = false, TWO_PASS = true;
    const bf16_t* G; bf16_t* MERGED;
    __device__ __forceinline__ void mid(pg8::f32x4 (&acc)[2][2][4][2], const pg8::Unit& u, int wr, int wc, int fr, int fq) const {
        const int row0 = u.pm * 256 + wr * 64 + fr, col0 = u.pn * 256 + wc * 32 + 8 * fq;
#pragma unroll
        for (int ai = 0; ai < 2; ++ai)
#pragma unroll
            for (int m = 0; m < 4; ++m) { const int row = row0 + ai * 128 + m * 16;
#pragma unroll
                for (int bj = 0; bj < 2; ++bj) { const int col = col0 + bj * 128;
                    const uint4 ga4 = *(const uint4*)(G + (size_t)row * 2048 + col), gb4 = *(const uint4*)(G + (size_t)row * 2048 + 1024 + col);
                    const unsigned gaw[4] = {ga4.x, ga4.y, ga4.z, ga4.w}, gbw[4] = {gb4.x, gb4.y, gb4.z, gb4.w};
#pragma unroll
                    for (int j = 0; j < 4; ++j) {
                        const float r0 = __uint_as_float(gbw[j] << 16) * __builtin_amdgcn_rcpf(fmaxf(__uint_as_float(gaw[j] << 16), 1e-20f));
                        const float r1 = __uint_as_float(gbw[j] & 0xffff0000u) * __builtin_amdgcn_rcpf(fmaxf(__uint_as_float(gaw[j] & 0xffff0000u), 1e-20f));
                        if (j < 2) { acc[ai][bj][m][0][2 * j] *= r0; acc[ai][bj][m][0][2 * j + 1] *= r1; } else { acc[ai][bj][m][1][2 * (j - 2)] *= r0; acc[ai][bj][m][1][2 * (j - 2) + 1] *= r1; }
                    } } }
    }
    __device__ __forceinline__ void operator()(const pg8::f32x4 (&acc)[2][2][4][2], const pg8::Unit& u, int wr, int wc, int fr, int fq) const {
        const int row0 = u.pm * 256 + wr * 64 + fr, col0 = u.pn * 256 + wc * 32 + 8 * fq;
#pragma unroll
        for (int ai = 0; ai < 2; ++ai)
#pragma unroll
            for (int m = 0; m < 4; ++m) { const int row = row0 + ai * 128 + m * 16;
#pragma unroll
                for (int bj = 0; bj < 2; ++bj) { const int col = col0 + bj * 128;
                    const uint4 ga4 = *(const uint4*)(G + (size_t)row * 2048 + col);
                    const unsigned gaw[4] = {ga4.x, ga4.y, ga4.z, ga4.w};
                    const pg8::f32x4 v0 = acc[ai][bj][m][0], v1 = acc[ai][bj][m][1];
                    float o[8];
#pragma unroll
                    for (int j = 0; j < 4; ++j) {
                        const float glo = fmaxf(__uint_as_float(gaw[j] << 16), 1e-20f), ghi = fmaxf(__uint_as_float(gaw[j] & 0xffff0000u), 1e-20f);
                        const float a0 = (j < 2) ? v0[2 * j] : v1[2 * (j - 2)], a1 = (j < 2) ? v0[2 * j + 1] : v1[2 * (j - 2) + 1];
                        o[2 * j] = glo * a0; o[2 * j + 1] = ghi * a1;
                    }
                    uint4 wv; wv.x = pack2(o[0], o[1]); wv.y = pack2(o[2], o[3]); wv.z = pack2(o[4], o[5]); wv.w = pack2(o[6], o[7]);
                    *(uint4*)(MERGED + (size_t)row * 1024 + col) = wv; } }
    }
};
struct EpiPlain8 {
    static constexpr bool PERM = true, AFTER_DRAIN = false, TWO_PASS = false;
    bf16_t* O; int ld;
    __device__ __forceinline__ void operator()(const pg8::f32x4 (&acc)[2][2][4][2], const pg8::Unit& u, int wr, int wc, int fr, int fq) const {
        const int row0 = u.pm * 256 + wr * 64 + fr, col0 = u.pn * 256 + wc * 32 + 8 * fq;
#pragma unroll
        for (int ai = 0; ai < 2; ++ai)
#pragma unroll
            for (int m = 0; m < 4; ++m) { bf16_t* rowp = O + (size_t)(row0 + ai * 128 + m * 16) * ld + col0;
#pragma unroll
                for (int bj = 0; bj < 2; ++bj) { const pg8::f32x4 v0 = acc[ai][bj][m][0], v1 = acc[ai][bj][m][1];
                    uint4 wv; wv.x = pack2(v0[0], v0[1]); wv.y = pack2(v0[2], v0[3]); wv.z = pack2(v1[0], v1[1]); wv.w = pack2(v1[2], v1[3]);
                    *(uint4*)(rowp + bj * 128) = wv; } }
    }
};
__device__ __forceinline__ void wg_self_acquire() {
    asm volatile("s_waitcnt vmcnt(0)" ::: "memory");
    __syncthreads();
    if (threadIdx.x == 0) { __builtin_amdgcn_fence(__ATOMIC_ACQUIRE, "agent"); asm volatile("s_waitcnt vmcnt(0)" ::: "memory"); }
    __syncthreads();
}
__device__ __forceinline__ void phase_outproj8(const bf16_t* __restrict__ MERGED, const bf16_t* __restrict__ WTOUT, const float* __restrict__ x, const float* __restrict__ mod, bf16_t* x1, char* lds) {
    pg8::Gemm g{MERGED, WTOUT, NTOK, 1024, 1024};
    pg8::StaticOrder S; S.init(NTOK, 1024, (int)gridDim.x, (int)blockIdx.x);
    EpiOut8 E{x, mod, x1};
    pg8::gemm_phase<EpiOut8, pg8::StaticOrder>((PG8_LAS unsigned char*)lds, g, S, E, nullptr);
}
__device__ __forceinline__ void phase_merged8(const bf16_t* __restrict__ YA, const bf16_t* __restrict__ YB, const bf16_t* __restrict__ WTA, const bf16_t* __restrict__ WTB,
                                              const bf16_t* __restrict__ G, bf16_t* MERGED, char* lds) {
    pg8::StaticOrder2 S; S.init(NTOK, 1024, (int)gridDim.x, (int)blockIdx.x);
    pg8::Gemm g{YB, WTB, NTOK, 1024, 512, YA, WTA}; EpiMerged2 E{G, MERGED};
    pg8::gemm_phase<EpiMerged2, pg8::StaticOrder2>((PG8_LAS unsigned char*)lds, g, S, E, nullptr);
}
__device__ __forceinline__ void phase_inproj8(const bf16_t* __restrict__ H, const bf16_t* __restrict__ WTIN, bf16_t* Q, bf16_t* Kb, bf16_t* V, bf16_t* U, bf16_t* SV, bf16_t* G, char* lds) {
    pg8::Gemm g{H, WTIN, NTOK, IN_COLS, 1024};
    pg8::StaticOrder S; S.init(NTOK, IN_COLS, (int)gridDim.x, (int)blockIdx.x);
    EpiInProj8 E{Q, Kb, V, U, SV, G};
    pg8::gemm_phase<EpiInProj8, pg8::StaticOrder>((PG8_LAS unsigned char*)lds, g, S, E, nullptr);
}


using f32x16 = __attribute__((ext_vector_type(16))) float;
typedef short v4i16_t __attribute__((ext_vector_type(4)));
#define ATT_TILE 16384
#define ATT_THR 6.0f
#define ATT_LDS_BYTES (4 * ATT_TILE)

__device__ __forceinline__ void att_dma(const bf16_t* __restrict__ Kb, const bf16_t* __restrict__ V, int b, int h, int kt, char* kl, char* vl, int lane, int w) {
    const int pc = lane & 15, rl = lane >> 4;
#pragma unroll
    for (int i = 0; i < 2; ++i) {
        const int n = w * 2 + i; const int row = 4 * n + rl;
        const size_t rowoff = ((size_t)(b * SEQ + kt * 64 + row)) * 512 + h * 128;
        __builtin_amdgcn_global_load_lds((const unsigned*)(Kb + rowoff + ((pc ^ (row & 15)) << 3)), (__attribute__((address_space(3))) unsigned*)(lds_ptr_t)(kl + n * 1024), 16, 0, 0);
        __builtin_amdgcn_global_load_lds((const unsigned*)(V + rowoff + ((pc ^ ((row & 3) << 2)) << 3)), (__attribute__((address_space(3))) unsigned*)(lds_ptr_t)(vl + n * 1024), 16, 0, 0);
    }
}
__device__ __forceinline__ void att_item(int b, int h, int cp, const bf16_t* __restrict__ Q, const bf16_t* __restrict__ Kb, const bf16_t* __restrict__ V,
                                         float lam, const float* __restrict__ head_g, bf16_t* __restrict__ YA, char* lds) {
    const int tid = threadIdx.x, lane = tid & 63;
    const int w = __builtin_amdgcn_readfirstlane(tid >> 6);
    const int i = w & 1, rq = w >> 1, r = lane & 31, hh = lane >> 5;
    const int tq = b * SEQ + cp * 128 + rq * 32 + r;
    bf16x8 qf[4];
#pragma unroll
    for (int s = 0; s < 4; ++s) qf[s] = *(const bf16x8*)(Q + (size_t)tq * 512 + h * 128 + i * 64 + 16 * s + 8 * hh);
    f32x16 O[4];
#pragma unroll
    for (int d = 0; d < 4; ++d)
#pragma unroll
        for (int e = 0; e < 16; ++e) O[d][e] = 0.f;
    float m = 0.f, l = 0.f;
    f32x16 negm;
#pragma unroll
    for (int e = 0; e < 16; ++e) negm[e] = 0.f;
    const int ntiles = 2 * cp + 2;
    const int ntiles_w = 2 * cp + (rq >> 1) + 1;
    int vb[4];
    { const int li = lane & 15, g = lane >> 4, q = li >> 2, x = 2 * (g & 1) + ((li & 3) >> 1);
#pragma unroll
      for (int d = 0; d < 4; ++d) vb[d] = (4 * hh + q) * 256 + ((((d ^ q) << 2) | x) << 4) + 8 * (li & 1); }
    att_dma(Kb, V, b, h, 0, lds, lds + ATT_TILE, lane, w);
    asm volatile("s_waitcnt vmcnt(0)" ::: "memory");
    __syncthreads();
    for (int kt = 0; kt < ntiles; ++kt) {
        const char* kl = lds + (kt & 1) * (2 * ATT_TILE); const char* vl = kl + ATT_TILE;
        if (kt + 1 < ntiles) { char* nl = lds + ((kt + 1) & 1) * (2 * ATT_TILE); att_dma(Kb, V, b, h, kt + 1, nl, nl + ATT_TILE, lane, w); }
        if (kt < ntiles_w) {
        f32x16 sacc[2];
        {
            bf16x8 kf[2][4];
#pragma unroll
            for (int k2 = 0; k2 < 2; ++k2)
#pragma unroll
                for (int s = 0; s < 4; ++s) {
                    const int krow = k2 * 32 + r; const int kch = i * 8 + 2 * s + hh;
                    kf[k2][s] = *(const bf16x8*)(kl + krow * 256 + ((kch ^ (krow & 15)) << 4));
                }
#pragma unroll
            for (int k2 = 0; k2 < 2; ++k2) {
                sacc[k2] = __builtin_amdgcn_mfma_f32_32x32x16_bf16(kf[k2][0], qf[0], negm, 0, 0, 0);
#pragma unroll
                for (int s = 1; s < 4; ++s) sacc[k2] = __builtin_amdgcn_mfma_f32_32x32x16_bf16(kf[k2][s], qf[s], sacc[k2], 0, 0, 0);
            }
        }
        float mx = sacc[0][0];
#pragma unroll
        for (int e = 1; e < 16; ++e) mx = fmaxf(mx, sacc[0][e]);
#pragma unroll
        for (int e = 0; e < 16; ++e) mx = fmaxf(mx, sacc[1][e]);
        if (kt == 0 || __any(mx > ATT_THR)) {
            mx = fmaxf(mx, __shfl_xor(mx, 32));
            const float dl = (kt == 0) ? mx : fmaxf(mx, 0.f);
            const float alpha = (kt == 0) ? 1.0f : __builtin_amdgcn_exp2f(-dl);
            m += dl; l *= alpha;
#pragma unroll
            for (int e = 0; e < 16; ++e) negm[e] = -m;
#pragma unroll
            for (int k2 = 0; k2 < 2; ++k2)
#pragma unroll
                for (int e = 0; e < 16; ++e) sacc[k2][e] -= dl;
#pragma unroll
            for (int d = 0; d < 4; ++d)
#pragma unroll
                for (int e = 0; e < 16; ++e) O[d][e] *= alpha;
        }
        float ls = 0.f;
#pragma unroll
        for (int k2 = 0; k2 < 2; ++k2)
#pragma unroll
            for (int e = 0; e < 16; ++e) { const float p = __builtin_amdgcn_exp2f(sacc[k2][e]); sacc[k2][e] = p; ls += p; }
        l += ls;
        bf16x8 pf[2][2];
#pragma unroll
        for (int k2 = 0; k2 < 2; ++k2)
#pragma unroll
            for (int s2 = 0; s2 < 2; ++s2) {
                union { uint4 u; bf16x8 v; } cp;
                cp.u = make_uint4(pack2(sacc[k2][8 * s2 + 0], sacc[k2][8 * s2 + 1]), pack2(sacc[k2][8 * s2 + 2], sacc[k2][8 * s2 + 3]),
                                  pack2(sacc[k2][8 * s2 + 4], sacc[k2][8 * s2 + 5]), pack2(sacc[k2][8 * s2 + 6], sacc[k2][8 * s2 + 7]));
                pf[k2][s2] = cp.v;
            }
#define ATT_VREAD(dst, st) { const lds_ptr_t vp_ = (lds_ptr_t)(vl + vb[(st) >> 2]); const int kb_ = (((st) >> 1) & 1) * 32 + ((st) & 1) * 16; \
            const v4i16_t lo_ = __builtin_amdgcn_ds_read_tr16_b64_v4i16((__attribute__((address_space(3))) v4i16_t*)(vp_ + kb_ * 256)); \
            const v4i16_t hi_ = __builtin_amdgcn_ds_read_tr16_b64_v4i16((__attribute__((address_space(3))) v4i16_t*)(vp_ + kb_ * 256 + 2048)); \
            dst = (bf16x8){lo_[0], lo_[1], lo_[2], lo_[3], hi_[0], hi_[1], hi_[2], hi_[3]}; }
        {
            bf16x8 vcur, vnxt;
            ATT_VREAD(vcur, 0)
#pragma unroll
            for (int st = 0; st < 16; ++st) {
                if (st + 1 < 16) ATT_VREAD(vnxt, st + 1)
                O[st >> 2] = __builtin_amdgcn_mfma_f32_32x32x16_bf16(vcur, pf[(st >> 1) & 1][st & 1], O[st >> 2], 0, 0, 0);
                vcur = vnxt;
            }
        }
        }
        asm volatile("s_waitcnt vmcnt(0)" ::: "memory");
        __syncthreads();
    }
    const float ltot = l + __shfl_xor(l, 32);
    const float inv = 1.0f / ltot;
    float* ex = (float*)lds;
    if (i == 1) {
        const float sc = inv * lam;
#pragma unroll
        for (int d = 0; d < 4; ++d)
#pragma unroll
            for (int e = 0; e < 16; ++e) { const int dv = d * 32 + (e & 3) + 8 * (e >> 2) + 4 * hh; ex[(rq * 128 + dv) * 32 + r] = O[d][e] * sc; }
    }
    __syncthreads();
    if (i == 0) {
        float ss = 0.f;
#pragma unroll
        for (int d = 0; d < 4; ++d)
#pragma unroll
            for (int e = 0; e < 16; ++e) { const int dv = d * 32 + (e & 3) + 8 * (e >> 2) + 4 * hh; const float o = O[d][e] * inv - ex[(rq * 128 + dv) * 32 + r]; O[d][e] = o; ss += o * o; }
        ss += __shfl_xor(ss, 32);
        const float rn = rsqrtf(ss * (1.0f / 128.0f) + EPS) * 0.8f;
#pragma unroll
        for (int d = 0; d < 4; ++d)
#pragma unroll
            for (int g = 0; g < 4; ++g) {
                const int dv = d * 32 + 8 * g + 4 * hh;
                const float4 hg = *(const float4*)(head_g + dv);
                *(uint2*)(YA + (size_t)tq * 512 + h * 128 + dv) = pack4(O[d][4 * g] * rn * hg.x, O[d][4 * g + 1] * rn * hg.y, O[d][4 * g + 2] * rn * hg.z, O[d][4 * g + 3] * rn * hg.w);
            }
    }
    __syncthreads();
}
__device__ __forceinline__ void phase_attn(const bf16_t* __restrict__ Q, const bf16_t* __restrict__ Kb, const bf16_t* __restrict__ V, const float* __restrict__ ctl,
                           const float* __restrict__ head_g, bf16_t* __restrict__ YA, char* lds) {
    const float lam = ctl[0];
    const int G = gridDim.x, bid = blockIdx.x;
    if (G == 256) {
        const int x = bid & 7, slot = bid >> 3; const int ph = x + 8 * (slot & 1); const int s = slot >> 1;
#pragma unroll 1
        for (int it = 0; it < 4; ++it) {
            const int cp = (it == 0) ? 63 - s : (it == 1) ? 32 + s : (it == 2) ? 31 - s : s;
            att_item(ph >> 2, ph & 3, cp, Q, Kb, V, lam, head_g, YA, lds);
        }
    } else {
#pragma unroll 1
        for (int it = 0;; ++it) {
            const int rho = (it & 1) ? it * G + (G - 1 - bid) : it * G + bid;
            if (rho >= 1024) { if (it * G >= 1024) break; else continue; }
            const int cp = 63 - (rho >> 4); const int ph = rho & 15;
            att_item(ph >> 2, ph & 3, cp, Q, Kb, V, lam, head_g, YA, lds);
        }
    }
}


#define SGU_LDS_BYTES (65536 + 1024)
__device__ __forceinline__ void phase_sgu(const bf16_t* __restrict__ U, const bf16_t* __restrict__ SV, const float* __restrict__ ln_g, const float* __restrict__ ln_b,
                          const float* __restrict__ sg_w, const float* __restrict__ sg_b, bf16_t* __restrict__ YB, char* lds) {
    const int tid = threadIdx.x, lane = tid & 63, w = tid >> 6, wm = w >> 1  , wn = w & 1  , lr = lane & 15, lq = lane >> 4;
    float* st_mu = (float*)(lds + 65536); float* st_rs = st_mu + 128;
    char* Wl = lds; char* Sl = lds + 32768;
    for (int nb = blockIdx.x; nb < NTOK / 128; nb += gridDim.x) {
        const int t0 = nb * 128;
        for (int r0 = 0; r0 < 16; r0 += 8) {
            uint4 v8[8];
#pragma unroll
            for (int u = 0; u < 8; ++u) v8[u] = *(const uint4*)(SV + (size_t)(t0 + w * 16 + r0 + u) * 512 + lane * 8);
#pragma unroll
            for (int u = 0; u < 8; ++u) {
                const int row = w * 16 + r0 + u; const uint4 v = v8[u];
                float f[8] = {__uint_as_float(v.x << 16), __uint_as_float(v.x & 0xffff0000u), __uint_as_float(v.y << 16), __uint_as_float(v.y & 0xffff0000u),
                              __uint_as_float(v.z << 16), __uint_as_float(v.z & 0xffff0000u), __uint_as_float(v.w << 16), __uint_as_float(v.w & 0xffff0000u)};
                float s = 0.f;
#pragma unroll
                for (int j = 0; j < 8; ++j) s += f[j];
                for (int o = 32; o > 0; o >>= 1) s += __shfl_xor(s, o);
                const float mu = s * (1.0f / 512.0f);
                float q = 0.f;
#pragma unroll
                for (int j = 0; j < 8; ++j) { const float d = f[j] - mu; q += d * d; }
                for (int o = 32; o > 0; o >>= 1) q += __shfl_xor(q, o);
                if (lane == 0) { st_mu[row] = mu; st_rs[row] = rsqrtf(q * (1.0f / 512.0f) + EPS); }
            }
        }
#pragma unroll 1
        for (int g = 0; g < 4; ++g) {
        { const int c16 = tid & 15, r0 = tid >> 4;
#pragma unroll
          for (int i = 0; i < 4; ++i) {
              const int p = r0 + 32 * i;
              const float* wp = sg_w + ((size_t)g * 128 + p) * 128 + c16 * 8;
              float4 a = *(const float4*)wp, b = *(const float4*)(wp + 4);
              if (p < 64 && c16 >= 8) { a = make_float4(0.f, 0.f, 0.f, 0.f); b = a; }
              *(uint4*)(Wl + p * 256 + ((c16 ^ (p & 15)) << 4)) = make_uint4(pack2(a.x, a.y), pack2(a.z, a.w), pack2(b.x, b.y), pack2(b.z, b.w));
          } }
        __syncthreads();
        { const int pr = tid & 63;
#pragma unroll
          for (int it = 0; it < 2; ++it) {
              const int ch = (tid >> 6) + 8 * it;
              const int q0 = 2 * pr;
              const uint4 va = *(const uint4*)(SV + (size_t)(t0 + q0) * 512 + g * 128 + ch * 8);
              const uint4 vb = *(const uint4*)(SV + (size_t)(t0 + q0 + 1) * 512 + g * 128 + ch * 8);
              const float mua = st_mu[q0], rsa = st_rs[q0], mub = st_mu[q0 + 1], rsb = st_rs[q0 + 1];
              const unsigned ua[4] = {va.x, va.y, va.z, va.w}, ub[4] = {vb.x, vb.y, vb.z, vb.w};
#pragma unroll
              for (int e = 0; e < 8; ++e) {
                  const int c = ch * 8 + e;
                  const float lg = ln_g[g * 128 + c], lb = ln_b[g * 128 + c];
                  const float xa = (e & 1) ? __uint_as_float(ua[e >> 1] & 0xffff0000u) : __uint_as_float(ua[e >> 1] << 16);
                  const float xb = (e & 1) ? __uint_as_float(ub[e >> 1] & 0xffff0000u) : __uint_as_float(ub[e >> 1] << 16);
                  const float na = (xa - mua) * rsa * lg + lb, nb2 = (xb - mub) * rsb * lg + lb;
                  *(unsigned*)(Sl + c * 256 + (((q0 >> 3) ^ (c & 15)) << 4) + (q0 & 7) * 2) = pack2(na, nb2);
              }
          } }
        __syncthreads();
        f32x4 acc[2][4];
#pragma unroll
        for (int i = 0; i < 2; ++i)
#pragma unroll
            for (int j = 0; j < 4; ++j) acc[i][j] = f32x4{0.f, 0.f, 0.f, 0.f};
        const int nks = (wm < 2) ? 2 : 4;
        for (int ks = 0; ks < nks; ++ks) {
            const int sw = (((ks * 4 + lq) ^ lr) << 4);
            bf16x8 a[2], b[4];
#pragma unroll
            for (int i = 0; i < 2; ++i) a[i] = *(const bf16x8*)(Wl + (wm * 32 + i * 16 + lr) * 256 + sw);
#pragma unroll
            for (int j = 0; j < 4; ++j) b[j] = *(const bf16x8*)(Sl + (wn * 64 + j * 16 + lr) * 256 + sw);
#pragma unroll
            for (int i = 0; i < 2; ++i)
#pragma unroll
                for (int j = 0; j < 4; ++j) acc[i][j] = __builtin_amdgcn_mfma_f32_16x16x32_bf16(b[j], a[i], acc[i][j], 0, 0, 0);
        }
#pragma unroll
        for (int i = 0; i < 2; ++i)
#pragma unroll
            for (int j = 0; j < 4; ++j) {
                const int p = wm * 32 + i * 16 + lr; const int c = wn * 64 + j * 16 + lq * 4;
                const float bias = sg_b[g * 128 + p];
                const size_t o = (size_t)(t0 + p) * 512 + g * 128 + c;
                const uint2 uu = *(const uint2*)(U + o);
                *(uint2*)(YB + o) = pack4(__uint_as_float(uu.x << 16) * (acc[i][j][0] + bias), __uint_as_float(uu.x & 0xffff0000u) * (acc[i][j][1] + bias),
                                          __uint_as_float(uu.y << 16) * (acc[i][j][2] + bias), __uint_as_float(uu.y & 0xffff0000u) * (acc[i][j][3] + bias));
            }
        __syncthreads();
        }
    }
}

#define CE_DESC(a, b) { const unsigned t_ = (a) > (b) ? (a) : (b); b = (a) > (b) ? (b) : (a); a = t_; }
__device__ __forceinline__ unsigned f2key(float f) { const unsigned u = __float_as_uint(f); return (u & 0x80000000u) ? ~u : (u | 0x80000000u); }
__device__ __forceinline__ float key2f(unsigned k) { const unsigned u = (k & 0x80000000u) ? (k & 0x7fffffffu) : ~k; return __uint_as_float(u); }
template <int N> __device__ __forceinline__ void bitonic_sort_desc(unsigned (&a)[N]) {
#pragma unroll
    for (int k = 2; k <= N; k <<= 1)
#pragma unroll
        for (int j = k >> 1; j > 0; j >>= 1)
#pragma unroll
            for (int i = 0; i < N; ++i) {
                const int l = i ^ j;
                if (l > i) { if ((i & k) == 0) { CE_DESC(a[i], a[l]) } else { CE_DESC(a[l], a[i]) } }
            }
}
template <int N> __device__ __forceinline__ void bitonic_merge_desc(unsigned (&a)[N]) {
#pragma unroll
    for (int j = N >> 1; j > 0; j >>= 1)
#pragma unroll
        for (int i = 0; i < N; ++i) { const int l = i ^ j; if (l > i) { CE_DESC(a[i], a[l]) } }
}
__device__ __forceinline__ void merge_top16(unsigned (&a)[16], const unsigned (&b)[16]) {
#pragma unroll
    for (int i = 0; i < 16; ++i) a[i] = a[i] > b[15 - i] ? a[i] : b[15 - i];
    bitonic_merge_desc<16>(a);
}
__device__ __forceinline__ void xlane_merge_top16(unsigned (&a)[16], int xmask) {
    unsigned b[16];
#pragma unroll
    for (int i = 0; i < 16; ++i) b[i] = (unsigned)__shfl_xor((int)a[i], xmask);
    merge_top16(a, b);
}
__device__ __forceinline__ void phase_peer_select8(const bf16_t* __restrict__ H2, const bf16_t* __restrict__ WTQ, const bf16_t* __restrict__ SUBK, bf16_t* QP,
                                   int* __restrict__ EIDX, float* __restrict__ GW, char* lds) {
    const int tid = threadIdx.x, lane = tid & 63, w = tid >> 6, wm = w >> 1, wn = w & 1, lr = lane & 15, lq = lane >> 4;
    pg8::StaticOrder S; S.init(NTOK, 2048, (int)gridDim.x, (int)blockIdx.x);
    { pg8::Gemm g{H2, WTQ, NTOK, 2048, 1024}; EpiPlain8 E{QP, 2048};
      pg8::gemm_phase<EpiPlain8, pg8::StaticOrder>((PG8_LAS unsigned char*)lds, g, S, E, nullptr); }
    wg_self_acquire();
    const int wu = __builtin_amdgcn_readfirstlane(w);
#define SEL_DMA(m0_, h_, p_) { const int pc = lane & 15, rl = lane >> 4; \
            _Pragma("unroll") for (int j = 0; j < 8; ++j) { const int n = wu * 8 + j; const int row = 4 * n + rl; \
                __builtin_amdgcn_global_load_lds((const unsigned*)(QP + (size_t)((m0_) + row) * 2048 + (h_) * 256 + (p_) * 128 + ((pc ^ (row & 15)) << 3)), \
                                                 (__attribute__((address_space(3))) unsigned*)(lds_ptr_t)(lds + n * 1024), 16, 0, 0); } \
            _Pragma("unroll") for (int j = 0; j < 4; ++j) { const int n = wu * 4 + j; const int row = 4 * n + rl; \
                __builtin_amdgcn_global_load_lds((const unsigned*)(SUBK + ((size_t)((h_) * 2 + (p_)) * 128 + row) * 128 + ((pc ^ (row & 15)) << 3)), \
                                                 (__attribute__((address_space(3))) unsigned*)(lds_ptr_t)(lds + 65536 + n * 1024), 16, 0, 0); } }
    pg8::Unit un, nxu; bool have = S.next(0, un);
    if (have) SEL_DMA(un.pm * 256, un.pn, 0)
    for (int ui = 0; have; ++ui) {
        const bool have_next = S.next(ui + 1, nxu);
        const int h = un.pn; const int m0 = un.pm * 256;
        unsigned* Ll = (unsigned*)(lds + 98304);
#pragma unroll 1
        for (int p = 0; p < 2; ++p) {
            asm volatile("s_waitcnt vmcnt(0)" ::: "memory");
            __syncthreads();
            f32x4 sc[2][8];
#pragma unroll
            for (int tt = 0; tt < 2; ++tt)
#pragma unroll
                for (int kt = 0; kt < 8; ++kt) sc[tt][kt] = f32x4{0.f, 0.f, 0.f, 0.f};
#pragma unroll
            for (int ks = 0; ks < 4; ++ks) {
                const int sw = (((ks * 4 + lq) ^ lr) << 4);
                bf16x8 qb[2], ka[8];
#pragma unroll
                for (int tt = 0; tt < 2; ++tt) qb[tt] = *(const bf16x8*)(lds + (w * 32 + tt * 16 + lr) * 256 + sw);
#pragma unroll
                for (int kt = 0; kt < 8; ++kt) ka[kt] = *(const bf16x8*)(lds + 65536 + (kt * 16 + lr) * 256 + sw);
#pragma unroll
                for (int tt = 0; tt < 2; ++tt)
#pragma unroll
                    for (int kt = 0; kt < 8; ++kt) sc[tt][kt] = __builtin_amdgcn_mfma_f32_16x16x32_bf16(ka[kt], qb[tt], sc[tt][kt], 0, 0, 0);
            }
            __syncthreads();
            if (p == 0) SEL_DMA(m0, h, 1) else if (have_next) SEL_DMA(nxu.pm * 256, nxu.pn, 0)
#pragma unroll
            for (int tt = 0; tt < 2; ++tt) {
                __builtin_amdgcn_sched_barrier(0);
                unsigned lo[16], hi[16];
#pragma unroll
                for (int kt = 0; kt < 4; ++kt)
#pragma unroll
                    for (int r = 0; r < 4; ++r) {
                        lo[kt * 4 + r] = (f2key(sc[tt][kt][r]) & ~0x7Fu) | (unsigned)(127 - (kt * 16 + lq * 4 + r));
                        hi[kt * 4 + r] = (f2key(sc[tt][kt + 4][r]) & ~0x7Fu) | (unsigned)(127 - ((kt + 4) * 16 + lq * 4 + r));
                    }
                bitonic_sort_desc<16>(lo); bitonic_sort_desc<16>(hi);
                merge_top16(lo, hi);
                xlane_merge_top16(lo, 16); xlane_merge_top16(lo, 32);
                if (lq == 0) {
                    uint4* dst = (uint4*)(Ll + (w * 32 + tt * 16 + lr) * 32 + p * 16);
                    dst[0] = make_uint4(lo[0], lo[1], lo[2], lo[3]); dst[1] = make_uint4(lo[4], lo[5], lo[6], lo[7]);
                    dst[2] = make_uint4(lo[8], lo[9], lo[10], lo[11]); dst[3] = make_uint4(lo[12], lo[13], lo[14], lo[15]);
                }
            }
        }
        __syncthreads();
#pragma unroll
        for (int tt = 0; tt < 2; ++tt) {
            __builtin_amdgcn_sched_barrier(0);
            const int tokl = w * 32 + tt * 16 + lr;
            float v0[16], v1[16];
            { const uint4* sp = (const uint4*)(Ll + tokl * 32);
#pragma unroll
              for (int q = 0; q < 4; ++q) {
                  const uint4 a = sp[q], b = sp[4 + q];
                  v0[q * 4] = key2f(a.x & ~0x7Fu); v0[q * 4 + 1] = key2f(a.y & ~0x7Fu); v0[q * 4 + 2] = key2f(a.z & ~0x7Fu); v0[q * 4 + 3] = key2f(a.w & ~0x7Fu);
                  v1[q * 4] = key2f(b.x & ~0x7Fu); v1[q * 4 + 1] = key2f(b.y & ~0x7Fu); v1[q * 4 + 2] = key2f(b.z & ~0x7Fu); v1[q * 4 + 3] = key2f(b.w & ~0x7Fu);
              } }
            unsigned c2[16];
#pragma unroll
            for (int r = 0; r < 16; ++r) c2[r] = 0u;
#define CAND(slot, a, b) c2[slot] = (f2key(v0[a] + v1[b]) & ~0xFFu) | (unsigned)(255 - ((a) * 16 + (b)))
            if (lq == 0) {
                CAND(0, 0, 0); CAND(1, 0, 1); CAND(2, 0, 2); CAND(3, 0, 3); CAND(4, 0, 4); CAND(5, 0, 5); CAND(6, 0, 6); CAND(7, 0, 7);
                CAND(8, 0, 8); CAND(9, 0, 9); CAND(10, 0, 10); CAND(11, 0, 11); CAND(12, 0, 12); CAND(13, 0, 13); CAND(14, 0, 14); CAND(15, 0, 15);
            } else if (lq == 1) {
                CAND(0, 8, 0); CAND(1, 9, 0); CAND(2, 10, 0); CAND(3, 11, 0); CAND(4, 12, 0); CAND(5, 13, 0); CAND(6, 14, 0); CAND(7, 15, 0);
                CAND(8, 1, 0); CAND(9, 1, 1); CAND(10, 1, 2); CAND(11, 1, 3); CAND(12, 1, 4); CAND(13, 1, 5); CAND(14, 1, 6); CAND(15, 1, 7);
            } else if (lq == 2) {
                CAND(0, 2, 0); CAND(1, 2, 1); CAND(2, 2, 2); CAND(3, 2, 3); CAND(4, 2, 4); CAND(5, 3, 0); CAND(6, 3, 1); CAND(7, 3, 2);
                CAND(8, 3, 3); CAND(9, 4, 0); CAND(10, 4, 1); CAND(11, 4, 2); CAND(12, 5, 0); CAND(13, 5, 1);
            } else {
                CAND(0, 6, 0); CAND(1, 6, 1); CAND(2, 7, 0); CAND(3, 7, 1);
            }
#undef CAND
            bitonic_sort_desc<16>(c2);
            xlane_merge_top16(c2, 16); xlane_merge_top16(c2, 32);
            if (lq == 0) {
                float s[16]; int ei[16];
#pragma unroll
                for (int r = 0; r < 16; ++r) {
                    const unsigned code = 255u - (c2[r] & 0xFFu);
                    const unsigned k0 = Ll[tokl * 32 + (code >> 4)], k1 = Ll[tokl * 32 + 16 + (code & 15u)];
                    s[r] = key2f(k0 & ~0x7Fu) + key2f(k1 & ~0x7Fu);
                    ei[r] = (int)((127u - (k0 & 0x7Fu)) * 128u + (127u - (k1 & 0x7Fu)));
                }
                float mx = s[0];
#pragma unroll
                for (int r = 1; r < 16; ++r) mx = fmaxf(mx, s[r]);
                float sum = 0.f;
#pragma unroll
                for (int r = 0; r < 16; ++r) { s[r] = __expf(s[r] - mx); sum += s[r]; }
                const float inv = 1.0f / sum;
                const size_t o = ((size_t)(m0 + tokl) * 8 + h) * 16;
#pragma unroll
                for (int r = 0; r < 16; r += 4) {
                    *(int4*)(EIDX + o + r) = make_int4(ei[r], ei[r + 1], ei[r + 2], ei[r + 3]);
                    *(float4*)(GW + o + r) = make_float4(s[r] * inv, s[r + 1] * inv, s[r + 2] * inv, s[r + 3] * inv);
                }
            }
        }
        __syncthreads();
        un = nxu; have = have_next;
    }
#undef SEL_DMA
}

#define DPP_ADD(r, ctrl) r += __builtin_bit_cast(float, __builtin_amdgcn_update_dpp(0, __builtin_bit_cast(int, r), ctrl, 0xf, 0xf, false))
__device__ __forceinline__ float dot8(const uint4& a, const uint4& b, float acc) {
    acc = __builtin_amdgcn_fdot2_f32_bf16(__builtin_bit_cast(bf16v2_t, a.x), __builtin_bit_cast(bf16v2_t, b.x), acc, false);
    acc = __builtin_amdgcn_fdot2_f32_bf16(__builtin_bit_cast(bf16v2_t, a.y), __builtin_bit_cast(bf16v2_t, b.y), acc, false);
    acc = __builtin_amdgcn_fdot2_f32_bf16(__builtin_bit_cast(bf16v2_t, a.z), __builtin_bit_cast(bf16v2_t, b.z), acc, false);
    acc = __builtin_amdgcn_fdot2_f32_bf16(__builtin_bit_cast(bf16v2_t, a.w), __builtin_bit_cast(bf16v2_t, b.w), acc, false);
    return acc;
}
typedef int v8i_t __attribute__((ext_vector_type(8)));
typedef int v2i_t __attribute__((ext_vector_type(2)));
#define PE_STAGE 16384
#define PE_WAVE_LDS (PE_STAGE + 1024)
__device__ __forceinline__ void phase_peer_expert(const unsigned char* __restrict__ HQ8, const float* __restrict__ HSC, const int* __restrict__ EIDX, const float* __restrict__ GW,
                                  const unsigned char* __restrict__ DOWN4, const unsigned char* __restrict__ UP4, const float* __restrict__ DSC, const float* __restrict__ USC,
                                  unsigned char* W8, const float* __restrict__ mod, const float* __restrict__ final_g, const bf16_t* __restrict__ x1src, bf16_t* X2, float* out, char* lds) {
    const int tid = threadIdx.x, lane = tid & 63, w = __builtin_amdgcn_readfirstlane(tid >> 6);
    const int n = lane & 15, g = lane >> 4, r8 = lane >> 3, cp8 = lane & 7;
    char* stage = lds + w * PE_WAVE_LDS; float* outbuf = (float*)(stage + PE_STAGE);
    const int nwaves = gridDim.x * NW;
    const int tpw = (NTOK + nwaves - 1) / nwaves;
    const int t_begin = (blockIdx.x * NW + w) * tpw;
    const int fn = (n >> 1) & 7;
#define PE_GATHER_HALF(TABLE, s_, ep_, hf_) { asm volatile("s_waitcnt lgkmcnt(0)" ::: "memory"); \
        _Pragma("unroll") for (int q = 8 * (hf_); q < 8 * (hf_) + 8; ++q) { \
            const int pk_ = __shfl((ep_), 8 * (q & 7) + r8); const int e_ = (q < 8) ? (pk_ & 0xFFFF) : (int)((unsigned)pk_ >> 16); \
            const int fj_ = (4 * (q & 1) + (r8 >> 1)) & 7; \
            __builtin_amdgcn_global_load_lds((const unsigned*)((TABLE) + (size_t)(s_) * (16384 * 128) + (size_t)e_ * 128 + ((cp8 ^ fj_) << 4)), \
                                             (__attribute__((address_space(3))) unsigned*)(lds_ptr_t)(stage + q * 1024), 16, 0, 0); } }
#define PE_GATHER(TABLE, s_, ep_) { PE_GATHER_HALF(TABLE, s_, ep_, 0) PE_GATHER_HALF(TABLE, s_, ep_, 1) }
#define PE_WAITV(n_) asm volatile("s_waitcnt vmcnt(" #n_ ")" ::: "memory")
    char* hbuf = (char*)outbuf;
#define PE_HDMA(t_, s_, par_) { if (lane < 16) __builtin_amdgcn_global_load_lds((const unsigned*)(HQ8 + (size_t)(t_) * 1024 + (s_) * 256 + lane * 16), \
                                             (__attribute__((address_space(3))) unsigned*)(lds_ptr_t)(hbuf + (par_) * 256), 16, 0, 0); }
    for (int base = 0; base < tpw; base += 16) {
        const int t0 = t_begin + base;
        int nt = tpw - base; if (nt > 16) nt = 16; if (t0 + nt > NTOK) nt = NTOK - t0; if (nt < 0) nt = 0;
        int eid[16];
#pragma unroll
        for (int i = 0; i < 16; ++i) { const int tc = (t0 + i < NTOK) ? t0 + i : NTOK - 1; eid[i] = EIDX[(size_t)tc * 128 + lane] | (EIDX[(size_t)tc * 128 + 64 + lane] << 16); }
        f32x4 P[16];
#pragma unroll
        for (int i = 0; i < 16; ++i) P[i] = f32x4{0.f, 0.f, 0.f, 0.f};
#define PE_DOWN_EG(eg_) { const char* rowp = stage + (16 * (eg_) + n) * 128; \
            const uint4 a0 = *(const uint4*)(rowp + ((g ^ fn) << 4)), a1 = *(const uint4*)(rowp + (((4 + g) ^ fn) << 4)); \
            const v8i_t av0 = {(int)a0.x, (int)a0.y, (int)a0.z, (int)a0.w, 0, 0, 0, 0}, av1 = {(int)a1.x, (int)a1.y, (int)a1.z, (int)a1.w, 0, 0, 0, 0}; \
            f32x4 acc = {0.f, 0.f, 0.f, 0.f}; \
            acc = __builtin_amdgcn_mfma_scale_f32_16x16x128_f8f6f4(av0, b0, acc, 4, 0, 0, 0x7F7F7F7F, 0, 0x7F7F7F7F); \
            acc = __builtin_amdgcn_mfma_scale_f32_16x16x128_f8f6f4(av1, b1, acc, 4, 0, 0, 0x7F7F7F7F, 0, 0x7F7F7F7F); \
            if (n == (eg_)) P[i] += acc; }
        int ntq = 16; asm volatile("" : "+s"(ntq));
        { const int tq = (t0 < NTOK) ? t0 : NTOK - 1; PE_HDMA(tq, 0, 0) PE_GATHER_HALF(DOWN4, 0, eid[0], 0) PE_GATHER_HALF(DOWN4, 0, eid[0], 1) }
#pragma unroll 1
        for (int s = 0; s < 4; ++s) {
#pragma unroll
            for (int i = 0; i < 16; ++i) if (i < ntq) {
                const bool has_next = (i < 15) || (s < 3);
                const int sn = (i < 15) ? s : s + 1, in = (i + 1) & 15;
                int epn = eid[in]; asm volatile("" : "+v"(epn));
                PE_WAITV(8);
                const char* hb = hbuf + (i & 1) * 256 + 16 * g;
                const uint4 h00 = *(const uint4*)(hb), h01 = *(const uint4*)(hb + 64), h10 = *(const uint4*)(hb + 128), h11 = *(const uint4*)(hb + 192);
                const v8i_t b0 = {(int)h00.x, (int)h00.y, (int)h00.z, (int)h00.w, (int)h01.x, (int)h01.y, (int)h01.z, (int)h01.w};
                const v8i_t b1 = {(int)h10.x, (int)h10.y, (int)h10.z, (int)h10.w, (int)h11.x, (int)h11.y, (int)h11.z, (int)h11.w};
#pragma unroll
                for (int eg = 0; eg < 4; ++eg) PE_DOWN_EG(eg)
                if (has_next) { int tq = (t0 + in < NTOK) ? t0 + in : NTOK - 1; asm volatile("" : "+v"(tq));
                                asm volatile("s_waitcnt lgkmcnt(0)" ::: "memory"); PE_HDMA(tq, sn, (i + 1) & 1) PE_GATHER_HALF(DOWN4, sn, epn, 0) PE_WAITV(9); }
                else PE_WAITV(0);
#pragma unroll
                for (int eg = 4; eg < 8; ++eg) PE_DOWN_EG(eg)
                if (has_next) PE_GATHER_HALF(DOWN4, sn, epn, 1)
            }
        }
#undef PE_DOWN_EG
#pragma unroll
        for (int i4 = 0; i4 < 16; i4 += 4) {
            const int j0 = 16 * (n & 7) + 4 * g;
            int4 e4[4]; float4 gw4[4]; float hs[4]; float dsc[4][4], usc[4][4];
#pragma unroll
            for (int u = 0; u < 4; ++u) { const int t = (i4 + u < nt) ? t0 + i4 + u : t0;
                e4[u] = *(const int4*)(EIDX + (size_t)t * 128 + j0); gw4[u] = *(const float4*)(GW + (size_t)t * 128 + j0); hs[u] = HSC[t]; }
#pragma unroll
            for (int u = 0; u < 4; ++u) { const int ee[4] = {e4[u].x, e4[u].y, e4[u].z, e4[u].w};
#pragma unroll
                for (int r = 0; r < 4; ++r) { dsc[u][r] = DSC[ee[r]]; usc[u][r] = USC[ee[r]]; } }
#pragma unroll
            for (int u = 0; u < 4; ++u) {
                const float gg[4] = {gw4[u].x, gw4[u].y, gw4[u].z, gw4[u].w};
                float wv[4];
#pragma unroll
                for (int r = 0; r < 4; ++r) { const float a = P[i4 + u][r] * hs[u] * dsc[u][r]; wv[r] = fminf(fmaxf(gg[r] * gelu_tanh(a) * usc[u][r] * 64.0f, -448.0f), 448.0f); }
                int ph = 0, pl = 0;
                ph = __builtin_amdgcn_cvt_pk_fp8_f32(wv[0], wv[1], ph, false); ph = __builtin_amdgcn_cvt_pk_fp8_f32(wv[2], wv[3], ph, true);
                const f32x2_t d01 = __builtin_amdgcn_cvt_pk_f32_fp8(ph, false), d23 = __builtin_amdgcn_cvt_pk_f32_fp8(ph, true);
                pl = __builtin_amdgcn_cvt_pk_fp8_f32(wv[0] - d01[0], wv[1] - d01[1], pl, false); pl = __builtin_amdgcn_cvt_pk_fp8_f32(wv[2] - d23[0], wv[3] - d23[1], pl, true);
                if (n < 8 && i4 + u < nt) { const size_t o = (size_t)(t0 + i4 + u) * 256 + j0; *(int*)(W8 + o) = ph; *(int*)(W8 + o + 128) = pl; }
            }
        }
        asm volatile("s_waitcnt vmcnt(0)" ::: "memory");
        float ssq[16];
#pragma unroll
        for (int i = 0; i < 16; ++i) ssq[i] = 0.f;
#pragma unroll 1
        for (int s = 0; s < 4; ++s) {
#pragma unroll
            for (int i = 0; i < 16; ++i) if (i < nt) {
                int t = t0 + i; asm volatile("" : "+v"(t));
                const int b = t / SEQ, c0 = s * 256 + 4 * lane;
                const uint2 xb2 = *(const uint2*)(x1src + (size_t)t * 1024 + c0); const float4 g2 = *(const float4*)(mod + b * 6144 + 5120 + c0);
                const float4 xv = make_float4(__uint_as_float(xb2.x << 16), __uint_as_float(xb2.x & 0xffff0000u), __uint_as_float(xb2.y << 16), __uint_as_float(xb2.y & 0xffff0000u));
                uint4 w0 = make_uint4(0u, 0u, 0u, 0u), w1 = w0;
                if (n < 2) { const unsigned char* wp = W8 + (size_t)t * 256 + n * 128 + 16 * g; w0 = *(const uint4*)wp; w1 = *(const uint4*)(wp + 64); }
                int epu = eid[i]; asm volatile("" : "+v"(epu));
                PE_GATHER(UP4, s, epu)
                const v8i_t av = {(int)w0.x, (int)w0.y, (int)w0.z, (int)w0.w, (int)w1.x, (int)w1.y, (int)w1.z, (int)w1.w};
                asm volatile("s_waitcnt vmcnt(0)" ::: "memory");
#pragma unroll
                for (int ch = 0; ch < 2; ++ch) {
                    v2i_t q0[8], q1[8];
#pragma unroll
                    for (int c8 = 0; c8 < 8; ++c8) { const int cg = ch * 8 + c8; const int off = ((((cg >> 1) ^ fn)) << 4) + (cg & 1) * 8;
                        q0[c8] = __builtin_amdgcn_ds_read_tr4_b64_v2i32((__attribute__((address_space(3))) v2i_t*)(lds_ptr_t)(stage + (32 * g + n) * 128 + off));
                        q1[c8] = __builtin_amdgcn_ds_read_tr4_b64_v2i32((__attribute__((address_space(3))) v2i_t*)(lds_ptr_t)(stage + (32 * g + 16 + n) * 128 + off)); }
                    float o8[8];
#pragma unroll
                    for (int c8 = 0; c8 < 8; ++c8) {
                        const v8i_t bv = {q0[c8][0], q0[c8][1], q1[c8][0], q1[c8][1], 0, 0, 0, 0};
                        f32x4 acc = {0.f, 0.f, 0.f, 0.f};
                        acc = __builtin_amdgcn_mfma_scale_f32_16x16x128_f8f6f4(av, bv, acc, 0, 4, 0, 0x7F7F7F7F, 0, 0x7F7F7F7F);
                        o8[c8] = acc[0] + acc[1];
                    }
                    if (g == 0) {
#pragma unroll
                        for (int c8 = 0; c8 < 8; ++c8) outbuf[(ch * 8 + c8) * 16 + n] = o8[c8]; }
                }
                asm volatile("s_waitcnt lgkmcnt(0)" ::: "memory");
                const float4 ov = *(const float4*)(outbuf + 4 * lane);
                float4 r; r.x = xv.x + g2.x * ov.x * (1.0f / 64.0f); r.y = xv.y + g2.y * ov.y * (1.0f / 64.0f); r.z = xv.z + g2.z * ov.z * (1.0f / 64.0f); r.w = xv.w + g2.w * ov.w * (1.0f / 64.0f);
                ssq[i] += r.x * r.x + r.y * r.y + r.z * r.z + r.w * r.w;
                *(uint2*)(X2 + (size_t)t * 1024 + c0) = pack4(r.x, r.y, r.z, r.w);
            }
        }
        asm volatile("s_waitcnt vmcnt(0)" ::: "memory");
#pragma unroll
        for (int i4 = 0; i4 < 16; i4 += 4) {
            uint2 xb[4][4]; float rn[4];
#pragma unroll
            for (int u = 0; u < 4; ++u) { const int t = (i4 + u < nt) ? t0 + i4 + u : t0;
#pragma unroll
                for (int q4 = 0; q4 < 4; ++q4) xb[u][q4] = *(const uint2*)(X2 + (size_t)t * 1024 + q4 * 256 + lane * 4); }
#pragma unroll
            for (int u = 0; u < 4; ++u) { float sq = ssq[i4 + u];
                for (int o = 32; o > 0; o >>= 1) sq += __shfl_xor(sq, o);
                rn[u] = rsqrtf(sq * (1.0f / 1024.0f) + EPS); }
#pragma unroll
            for (int u = 0; u < 4; ++u) if (i4 + u < nt) {
#pragma unroll
                for (int q4 = 0; q4 < 4; ++q4) {
                    const int c = q4 * 256 + lane * 4;
                    float4 xv; xv.x = __uint_as_float(xb[u][q4].x << 16); xv.y = __uint_as_float(xb[u][q4].x & 0xffff0000u); xv.z = __uint_as_float(xb[u][q4].y << 16); xv.w = __uint_as_float(xb[u][q4].y & 0xffff0000u);
                    const float4 fg = *(const float4*)(final_g + c);
                    float4 r; r.x = xv.x * rn[u] * fg.x; r.y = xv.y * rn[u] * fg.y; r.z = xv.z * rn[u] * fg.z; r.w = xv.w * rn[u] * fg.w;
                    *(float4*)(out + (size_t)(t0 + i4 + u) * 1024 + c) = r;
                }
            }
        }
    }
#undef PE_GATHER
#undef PE_GATHER_HALF
#undef PE_WAITV
#undef PE_HDMA
}


#define XB_TMO      128
#define XB_XCNT(j)  (256  + 64 * (j))
#define XB_XSUB(j)  (1280 + 64 * (j))
#define XB_XGEN(j)  (2304 + 64 * (j))
#define XB_TOP      3328
#define XB_TOPGEN   3392
#define XCD_BAR_WORDS 3456
#define XB_SPIN_CAP (1u << 22)
__device__ __forceinline__ unsigned xb_ld(unsigned* p)              { return __hip_atomic_load(p, __ATOMIC_RELAXED, __HIP_MEMORY_SCOPE_AGENT); }
__device__ __forceinline__ unsigned xb_add(unsigned* p, unsigned v) { return __hip_atomic_fetch_add(p, v, __ATOMIC_RELAXED, __HIP_MEMORY_SCOPE_AGENT); }
__device__ __forceinline__ unsigned xb_xcc_id() { return (unsigned)__builtin_amdgcn_s_getreg((3 << 11) | 20) & 0xFu; }
#define XB_SPIN(cond, bar) do { unsigned _sp = 0; while (cond) { __builtin_amdgcn_s_sleep(1); \
    if ((++_sp & 255u) == 0u) { if (xb_ld(&(bar)[XB_TMO])) break; if (_sp > XB_SPIN_CAP) { atomicAdd(&(bar)[XB_TMO], 1u); break; } } } } while (0)
struct XcdBarrier { unsigned* bar; unsigned x; unsigned nloc; unsigned nx; };
__device__ __forceinline__ void xcd_barrier_post(XcdBarrier& b, unsigned* bar) {
    b.bar = bar; b.x = xb_xcc_id(); b.nloc = 0u; b.nx = 0u;
    if (threadIdx.x == 0) (void)xb_add(&bar[XB_XCNT(b.x)], 1u);
}
__device__ __forceinline__ void xcd_barrier_complete(unsigned* bar, unsigned x, unsigned& nloc, unsigned& nx) {
    const unsigned G = gridDim.x;
    unsigned sum, cnt, mine, sp = 0u;
    for (;;) {
        sum = 0u; cnt = 0u; mine = 0u;
#pragma unroll
        for (unsigned j = 0; j < 16; ++j) { const unsigned c = xb_ld(&bar[XB_XCNT(j)]); sum += c; cnt += (c > 0u) ? 1u : 0u; mine = (j == x) ? c : mine; }
        if (sum == G) break;
        __builtin_amdgcn_s_sleep(1);
        if ((++sp & 255u) == 0u) { if (xb_ld(&bar[XB_TMO])) break; if (sp > XB_SPIN_CAP) { atomicAdd(&bar[XB_TMO], 1u); break; } }
    }
    nloc = mine > 0u ? mine : 1u; nx = cnt > 0u ? cnt : 1u;
}
__device__ __forceinline__ void xcd_barrier(XcdBarrier& b) {
    asm volatile("s_waitcnt vmcnt(0)" ::: "memory");
    __syncthreads();
    if (threadIdx.x == 0) {
        unsigned* bar = b.bar;
        __builtin_amdgcn_s_waitcnt(0);
        if (b.nloc == 0u) xcd_barrier_complete(bar, b.x, b.nloc, b.nx);
        const unsigned nloc = b.nloc, nx = b.nx;
        const unsigned old = xb_add(&bar[XB_XSUB(b.x)], 1u);
        const unsigned gen = old / nloc;
        if (old + 1u == (gen + 1u) * nloc) {
            __builtin_amdgcn_fence(__ATOMIC_RELEASE, "agent");
            asm volatile("s_waitcnt vmcnt(0)" ::: "memory");
            const unsigned og = xb_add(&bar[XB_TOP], 1u);
            const unsigned tg = og / nx;
            if (og + 1u == (tg + 1u) * nx) xb_add(&bar[XB_TOPGEN], 1u);
            else XB_SPIN(xb_ld(&bar[XB_TOPGEN]) == tg, bar);
            __builtin_amdgcn_fence(__ATOMIC_ACQUIRE, "agent");
            xb_add(&bar[XB_XGEN(b.x)], 1u);
            asm volatile("s_waitcnt vmcnt(0)" ::: "memory");
        } else {
            XB_SPIN(xb_ld(&bar[XB_XGEN(b.x)]) == gen, bar);
            __builtin_amdgcn_fence(__ATOMIC_ACQUIRE, "agent");
            asm volatile("s_waitcnt vmcnt(0)" ::: "memory");
        }
    }
    b.nloc = (unsigned)__builtin_amdgcn_readfirstlane((int)b.nloc); b.nx = (unsigned)__builtin_amdgcn_readfirstlane((int)b.nx);
    __syncthreads();
}

__device__ __forceinline__ void prep_convT(const float* __restrict__ srcp, bf16_t* __restrict__ dst, int K, int N, char* lds, int& cursor) {
    float (*tile)[32][33] = (float (*)[32][33])lds;
    const int tx = threadIdx.x & 31, ty = threadIdx.x >> 5;
    const int ntn = N / 32, ntiles = ntn * (K / 32);
    const int G = gridDim.x;
    const int first = ((int)blockIdx.x - cursor % G + G) % G;
    float rg[4][2];
#define CT_LOAD(t_) { _Pragma("unroll") for (int u = 0; u < 4; ++u) { const int tt = (t_) + u * G; \
            if (tt < ntiles) { const int n0 = (tt % ntn) * 32, k0 = (tt / ntn) * 32; \
                _Pragma("unroll") for (int i = 0; i < 2; ++i) rg[u][i] = srcp[(size_t)(k0 + ty + 16 * i) * N + n0 + tx]; } } }
    if (first < ntiles) CT_LOAD(first)
    for (int t = first; t < ntiles; t += 4 * G) {
#pragma unroll
        for (int u = 0; u < 4; ++u)
#pragma unroll
            for (int i = 0; i < 2; ++i) tile[u][ty + 16 * i][tx] = rg[u][i];
        __syncthreads();
        if (t + 4 * G < ntiles) CT_LOAD(t + 4 * G)
#pragma unroll
        for (int u = 0; u < 4; ++u) {
            const int tt = t + u * G;
            if (tt < ntiles) { const int n0 = (tt % ntn) * 32, k0 = (tt / ntn) * 32;
#pragma unroll
                for (int i = 0; i < 2; ++i) dst[(size_t)(n0 + ty + 16 * i) * K + k0 + tx] = f2bf(tile[u][tx][ty + 16 * i]); }
        }
        __syncthreads();
    }
#undef CT_LOAD
    cursor += ntiles;
}
__device__ __forceinline__ void prep_conv(const float* __restrict__ srcp, bf16_t* __restrict__ dst, size_t n8) {
    for (size_t i = (size_t)blockIdx.x * blockDim.x + threadIdx.x; i < n8; i += (size_t)gridDim.x * blockDim.x) {
        const float4 a = *(const float4*)(srcp + i * 8), b = *(const float4*)(srcp + i * 8 + 4);
        uint4 o; o.x = pack2(a.x, a.y); o.y = pack2(a.z, a.w); o.z = pack2(b.x, b.y); o.w = pack2(b.z, b.w);
        *(uint4*)(dst + i * 8) = o;
    }
}
__device__ __forceinline__ void prep_ada(const float* __restrict__ c, const float* __restrict__ w_ada, const float* __restrict__ b_ada, float* __restrict__ mod, char* lds) {
    float* sc = (float*)lds;
    float* part = (float*)(lds + 16384);
    const int tid = threadIdx.x, col = tid & 31, kq = tid >> 5;
    const int G = gridDim.x;
    for (int item = (int)blockIdx.x; item < 192; item += G) {
        __syncthreads();
        for (int i = tid; i < 4096; i += NTHR) { const float v = c[i]; sc[i] = v * sigmoidf_(v); }
        __syncthreads();
        const int e = item * 32 + col;
        float a0 = 0.f, a1 = 0.f, a2 = 0.f, a3 = 0.f;
#pragma unroll 16
        for (int d = kq * 64; d < kq * 64 + 64; ++d) {
            const float wv = w_ada[(size_t)d * 6144 + e];
            a0 += sc[d] * wv; a1 += sc[1024 + d] * wv; a2 += sc[2048 + d] * wv; a3 += sc[3072 + d] * wv;
        }
        part[(kq * 4 + 0) * 32 + col] = a0; part[(kq * 4 + 1) * 32 + col] = a1; part[(kq * 4 + 2) * 32 + col] = a2; part[(kq * 4 + 3) * 32 + col] = a3;
        __syncthreads();
        if (tid < 128) { const int b = tid >> 5;
          float s = 0.f;
#pragma unroll
          for (int k16 = 0; k16 < 16; ++k16) s += part[(k16 * 4 + b) * 32 + col];
          mod[b * 6144 + e] = s + b_ada[e]; }
    }
}

__device__ __forceinline__ void prep_quant(const float* __restrict__ srcp, unsigned char* __restrict__ dst, float* __restrict__ scales, int rows, int off) {
    const int lane = threadIdx.x & 63, w = threadIdx.x >> 6;
    const int nwaves = gridDim.x * NW;
    float4 nx[4][4];
    { const int rb0 = (blockIdx.x * NW + w) * 4;
      if (rb0 < rows) {
#pragma unroll
        for (int u = 0; u < 4; ++u)
#pragma unroll
            for (int j = 0; j < 4; ++j) nx[u][j] = *(const float4*)(srcp + (size_t)(rb0 + u) * 1024 + j * 256 + lane * 4); } }
    for (int rb = (blockIdx.x * NW + w) * 4; rb < rows; rb += nwaves * 4) {
        float4 v[4][4];
#pragma unroll
        for (int u = 0; u < 4; ++u)
#pragma unroll
            for (int j = 0; j < 4; ++j) v[u][j] = nx[u][j];
        if (rb + nwaves * 4 < rows) {
#pragma unroll
            for (int u = 0; u < 4; ++u)
#pragma unroll
                for (int j = 0; j < 4; ++j) nx[u][j] = *(const float4*)(srcp + (size_t)(rb + nwaves * 4 + u) * 1024 + j * 256 + lane * 4);
        }
#pragma unroll
        for (int u = 0; u < 4; ++u) {
            const int r = rb + u;
            float am = 0.f;
#pragma unroll
            for (int j = 0; j < 4; ++j) am = fmaxf(am, fmaxf(fmaxf(fabsf(v[u][j].x), fabsf(v[u][j].y)), fmaxf(fabsf(v[u][j].z), fabsf(v[u][j].w))));
            for (int o = 32; o > 0; o >>= 1) am = fmaxf(am, __shfl_xor(am, o));
            unsigned o4[4];
            if (off < 0) {
                float sq = 0.f;
#pragma unroll
                for (int j = 0; j < 4; ++j) sq += v[u][j].x * v[u][j].x + v[u][j].y * v[u][j].y + v[u][j].z * v[u][j].z + v[u][j].w * v[u][j].w;
                for (int o = 32; o > 0; o >>= 1) sq += __shfl_xor(sq, o);
                float unit = fmaxf(0.5f * sqrtf(sq * (1.0f / 1024.0f)), am * (1.0f / 8.0f));
                if (!(unit > 0.f)) unit = 1.0f;
                const float inv4 = 1.0f / unit;
                if (lane == 0) scales[r] = unit;
#pragma unroll
                for (int j = 0; j < 4; ++j) {
                    unsigned pb = 0;
                    pb = __builtin_amdgcn_cvt_scalef32_pk_fp4_f32(pb, v[u][j].x * inv4, v[u][j].y * inv4, 1.0f, 0);
                    pb = __builtin_amdgcn_cvt_scalef32_pk_fp4_f32(pb, v[u][j].z * inv4, v[u][j].w * inv4, 1.0f, 1);
                    *(unsigned short*)(dst + (size_t)j * ((size_t)rows * 128) + (size_t)r * 128 + lane * 2) = (unsigned short)pb;
                }
                continue;
            }
        }
    }
}
template <bool QUANT>
__device__ __forceinline__ void phase_norm(const void* __restrict__ xin, const float* __restrict__ g, const float* __restrict__ mod, int sh_off, int sc_off, bf16_t* __restrict__ H,
                                           unsigned char* __restrict__ HQ, float* __restrict__ HSC) {
    const int lane = threadIdx.x & 63, w = threadIdx.x >> 6;
    const int nwaves = gridDim.x * NW;
    for (int tb = (blockIdx.x * NW + w) * 2; tb < NTOK; tb += nwaves * 2) {
        float4 v[2][4];
        if (QUANT) {
#pragma unroll
            for (int u = 0; u < 2; ++u)
#pragma unroll
                for (int j = 0; j < 4; ++j) { const uint2 xb = *(const uint2*)((const bf16_t*)xin + (size_t)(tb + u) * 1024 + j * 256 + lane * 4);
                    v[u][j] = make_float4(__uint_as_float(xb.x << 16), __uint_as_float(xb.x & 0xffff0000u), __uint_as_float(xb.y << 16), __uint_as_float(xb.y & 0xffff0000u)); }
        } else {
#pragma unroll
            for (int u = 0; u < 2; ++u)
#pragma unroll
                for (int j = 0; j < 4; ++j) v[u][j] = *(const float4*)((const float*)xin + (size_t)(tb + u) * 1024 + j * 256 + lane * 4);
        }
#pragma unroll
        for (int u = 0; u < 2; ++u) {
            const int t = tb + u; const int b = t / SEQ;
            float ss = 0.f;
#pragma unroll
            for (int j = 0; j < 4; ++j) ss += v[u][j].x * v[u][j].x + v[u][j].y * v[u][j].y + v[u][j].z * v[u][j].z + v[u][j].w * v[u][j].w;
            for (int o = 32; o > 0; o >>= 1) ss += __shfl_xor(ss, o);
            const float r = rsqrtf(ss * (1.0f / 1024.0f) + EPS);
            float am = 0.f;
#pragma unroll
            for (int j = 0; j < 4; ++j) {
                const int c = j * 256 + lane * 4;
                const float4 gg = *(const float4*)(g + c), sc = *(const float4*)(mod + b * 6144 + sc_off + c), sh = *(const float4*)(mod + b * 6144 + sh_off + c);
                float4& vv = v[u][j];
                vv.x = vv.x * r * gg.x * (1.0f + sc.x) + sh.x; vv.y = vv.y * r * gg.y * (1.0f + sc.y) + sh.y;
                vv.z = vv.z * r * gg.z * (1.0f + sc.z) + sh.z; vv.w = vv.w * r * gg.w * (1.0f + sc.w) + sh.w;
                *(uint2*)(H + (size_t)t * 1024 + c) = pack4(vv.x, vv.y, vv.z, vv.w);
                if (QUANT) am = fmaxf(am, fmaxf(fmaxf(fabsf(vv.x), fabsf(vv.y)), fmaxf(fabsf(vv.z), fabsf(vv.w))));
            }
            if (QUANT) {
                for (int o = 32; o > 0; o >>= 1) am = fmaxf(am, __shfl_xor(am, o));
                const float inv = am > 0.f ? 448.0f / am : 0.f;
                if (lane == 0) HSC[t] = am > 0.f ? am * (1.0f / 448.0f) : 1.0f;
#pragma unroll
                for (int j = 0; j < 4; ++j) {
                    const float4 vv = v[u][j];
                    int p8 = 0;
                    p8 = __builtin_amdgcn_cvt_pk_fp8_f32(vv.x * inv, vv.y * inv, p8, false);
                    p8 = __builtin_amdgcn_cvt_pk_fp8_f32(vv.z * inv, vv.w * inv, p8, true);
                    *(int*)(HQ + (size_t)t * 1024 + j * 256 + lane * 4) = p8;
                }
            }
        }
    }
}
struct MegaParams {
    const float* in[24];
    float* out;
    char* ws;
    int use_cg; int pad;
};
#define MEGA_LDS_BYTES (NW * PE_WAVE_LDS)
#define W_CTL   ((float*)(ws + OFF_CTL))
#define W_MOD   ((float*)(ws + OFF_MOD))
#define W_WTIN  ((bf16_t*)(ws + OFF_WTIN))
#define W_WTA   ((bf16_t*)(ws + OFF_WTA))
#define W_WTB   ((bf16_t*)(ws + OFF_WTB))
#define W_WTOUT ((bf16_t*)(ws + OFF_WTOUT))
#define W_WTQ   ((bf16_t*)(ws + OFF_WTQ))
#define W_SUBK  ((bf16_t*)(ws + OFF_SUBK))
#define W_DOWN  ((bf16_t*)(ws + OFF_DOWN))
#define W_UP    ((bf16_t*)(ws + OFF_UP))
#define W_H     ((bf16_t*)(ws + OFF_H))
#define W_Q     ((bf16_t*)(ws + OFF_Q))
#define W_K     ((bf16_t*)(ws + OFF_K))
#define W_V     ((bf16_t*)(ws + OFF_VT))
#define W_U     ((bf16_t*)(ws + OFF_U))
#define W_SV    ((bf16_t*)(ws + OFF_SV))
#define W_GATES ((bf16_t*)(ws + OFF_GATES))
#define W_YA    ((bf16_t*)(ws + OFF_YA))
#define W_YB    ((bf16_t*)(ws + OFF_YB))
#define W_MERGED ((bf16_t*)(ws + OFF_MERGED))
#define W_EIDX  ((int*)(ws + OFF_EIDX))
#define W_GW    ((float*)(ws + OFF_GW))
__global__ __launch_bounds__(NTHR, 2) void k_mega(MegaParams P) {
    cg::grid_group grid = cg::this_grid();
    char* lds = dyn_lds; char* ws = P.ws;
    const float* x = P.in[0];
    XcdBarrier xb; xcd_barrier_post(xb, (unsigned*)(ws + OFF_BAR));
    prep_ada(P.in[1], P.in[2], P.in[3], W_MOD, lds);
    if (blockIdx.x == gridDim.x - 1 && threadIdx.x < 64) {
        const int i = threadIdx.x;
        float s1 = P.in[6][i] * P.in[7][i], s2 = P.in[8][i] * P.in[9][i];
        for (int o = 32; o > 0; o >>= 1) { s1 += __shfl_xor(s1, o); s2 += __shfl_xor(s2, o); }
        if (i == 0) W_CTL[0] = __expf(s1) - __expf(s2) + 0.2f;
    }
    { int cursor = 0;
      __syncthreads();
      prep_convT(P.in[5], W_WTIN, 1024, IN_COLS, lds, cursor);
      prep_convT(P.in[15], W_WTA, 512, 1024, lds, cursor);
      prep_convT(P.in[16], W_WTB, 512, 1024, lds, cursor);
      prep_convT(P.in[17], W_WTOUT, 1024, 1024, lds, cursor);
      prep_convT(P.in[19], W_WTQ, 1024, 2048, lds, cursor); }
    prep_conv(P.in[20], W_SUBK, (size_t)8 * 2 * 128 * 128 / 8);
    prep_quant(P.in[21], (unsigned char*)(ws + OFF_DOWN), (float*)(ws + OFF_DSC), 16384, -1);
    prep_quant(P.in[22], (unsigned char*)(ws + OFF_UP), (float*)(ws + OFF_USC), 16384, -1);
    if (P.use_cg) grid.sync(); else xcd_barrier(xb);
    phase_norm<false>(x, P.in[4], W_MOD, 0, 1024, W_H, nullptr, nullptr);
    xcd_barrier(xb);
    phase_inproj8(W_H, W_WTIN, W_Q, W_K, W_V, W_U, W_SV, W_GATES, lds);
    xcd_barrier(xb);
    phase_sgu(W_U, W_SV, P.in[11], P.in[12], P.in[13], P.in[14], W_YB, lds);
    phase_attn(W_Q, W_K, W_V, W_CTL, P.in[10], W_YA, lds);
    xcd_barrier(xb);
    phase_merged8(W_YA, W_YB, W_WTA, W_WTB, W_GATES, W_MERGED, lds);
    xcd_barrier(xb);
    phase_outproj8(W_MERGED, W_WTOUT, x, W_MOD, W_H, lds);
    xcd_barrier(xb);
    phase_norm<true>(W_H, P.in[18], W_MOD, 3072, 4096, W_MERGED, (unsigned char*)(ws + OFF_HQ), (float*)(ws + OFF_HSC));
    xcd_barrier(xb);
    phase_peer_select8(W_MERGED, W_WTQ, W_SUBK, W_GATES, W_EIDX, W_GW, lds);
    xcd_barrier(xb);
    phase_peer_expert((const unsigned char*)(ws + OFF_HQ), (const float*)(ws + OFF_HSC), W_EIDX, W_GW, (const unsigned char*)(ws + OFF_DOWN), (const unsigned char*)(ws + OFF_UP), (const float*)(ws + OFF_DSC), (const float*)(ws + OFF_USC),
                      (unsigned char*)(ws + OFF_YB), W_MOD, P.in[23], W_H, (bf16_t*)(ws + OFF_GATES), P.out, lds);
}

extern "C" void kernel_launch(void* const* d_in, const int* in_sizes, int n_in, void* d_out, int out_size, void* d_ws, size_t ws_size, hipStream_t stream) {
    if (ws_size < OFF_END || n_in < 24) return;
    static int grid_blocks = 0;
    if (!grid_blocks) {
        int dev = 0, cus = 0, per_cu = 0;
        hipGetDevice(&dev);
        hipDeviceGetAttribute(&cus, hipDeviceAttributeMultiprocessorCount, dev);
        hipFuncSetAttribute((const void*)k_mega, hipFuncAttributeMaxDynamicSharedMemorySize, MEGA_LDS_BYTES);
        hipOccupancyMaxActiveBlocksPerMultiprocessor(&per_cu, k_mega, NTHR, MEGA_LDS_BYTES);
        if (per_cu > 1) per_cu = 1;
        if (per_cu < 1) per_cu = 1;
        grid_blocks = cus * per_cu;
    }
    MegaParams P{};
    for (int i = 0; i < 24; ++i) P.in[i] = (const float*)d_in[i];
    P.out = (float*)d_out; P.ws = (char*)d_ws;
    hipMemsetAsync((char*)d_ws + OFF_BAR, 0, XCD_BAR_WORDS * 4, stream);
    void* args[] = {&P};
    hipError_t e = hipLaunchCooperativeKernel((void*)k_mega, dim3(grid_blocks), dim3(NTHR), args, MEGA_LDS_BYTES, stream);
    if (e != hipSuccess) fprintf(stderr, "cooperative launch failed: %s (grid %d)\n", hipGetErrorString(e), grid_blocks);
}
```
